# Optimizing an MI355X kernel written in HIP

```python
import math
import jax
import jax.numpy as jnp
from jax import lax
import numpy as np

D_MODEL = 1024
BATCH = 1
SEQ = 16384
DEPTH = 2

HEAD_DIM = 64
GRID_W = 64
Q_BLOCK = 128
EPS = 1e-6
NEG_INF = -1e30
ROPE_THETA = 10000.0

A_HEADS = 4
A_KV_HEADS = 2
A_HALF_WINDOW = 128
B_PATTERNS = ((128, 1), (512, 4), (2048, 16))
B_GROUPS = 3
B_HEADS = 4
C_HEADS = 4
C_Q_RANK = 256
C_KV_RANK = 128
C_NOPE = 64
C_ROPE = 32
C_QK_DIM = C_NOPE + C_ROPE
C_V = 64
D_HEADS = 4
D_KV_HEADS = 2

N_BRANCHES = 4
BRANCH_WIDTH = 4 * HEAD_DIM

REL_BUCKETS = 32
REL_MAX_DIST = 1024
REL_HEADS = A_HEADS + B_GROUPS * B_HEADS

PEER_HEADS = 8
PEER_N_KEYS = 128
PEER_N_EXPERTS = PEER_N_KEYS * PEER_N_KEYS
PEER_KEY_DIM = 128
PEER_TOPK = 16
PEER_TOKEN_BLOCK = 128

IN_SPLITS = (
    A_HEADS * HEAD_DIM, A_KV_HEADS * HEAD_DIM, A_KV_HEADS * HEAD_DIM,
    B_GROUPS * B_HEADS * HEAD_DIM, B_GROUPS * B_HEADS * HEAD_DIM, B_GROUPS * B_HEADS * HEAD_DIM,
    C_Q_RANK, C_KV_RANK, C_ROPE,
    D_HEADS * HEAD_DIM, D_KV_HEADS * HEAD_DIM, D_KV_HEADS * HEAD_DIM,
    N_BRANCHES * D_MODEL,
)
IN_WIDTH = sum(IN_SPLITS)

kernel_name = 'hybrid_gated_four_mixer_peer_encoder'


def rms_norm(x, gain):
    x32 = x.astype(jnp.float32)
    y = x32 * lax.rsqrt(jnp.mean(x32 * x32, axis=-1, keepdims=True) + EPS)
    return (y * gain.astype(jnp.float32)).astype(x.dtype)


def rope(x, pos):
    half = x.shape[-1] // 2
    freqs = ROPE_THETA ** (-jnp.arange(half, dtype=jnp.float32) / half)
    ang = pos.astype(jnp.float32)[:, None] * freqs[None, :]
    cos = jnp.cos(ang)[:, None, :]
    sin = jnp.sin(ang)[:, None, :]
    x32 = x.astype(jnp.float32)
    x1, x2 = x32[..., :half], x32[..., half:]
    return jnp.concatenate([x1 * cos - x2 * sin, x1 * sin + x2 * cos], axis=-1).astype(x.dtype)


def axial_rope(x, row, col):
    half = x.shape[-1] // 2
    return jnp.concatenate([rope(x[..., :half], row), rope(x[..., half:], col)], axis=-1)


def rel_bucket(rel):
    nb = REL_BUCKETS // 2
    max_exact = nb // 2
    ret = jnp.where(rel > 0, nb, 0)
    n = jnp.abs(rel)
    nf = jnp.maximum(n, 1).astype(jnp.float32)
    large = max_exact + (jnp.log(nf / max_exact) / math.log(REL_MAX_DIST / max_exact)
                         * (nb - max_exact)).astype(jnp.int32)
    large = jnp.minimum(large, nb - 1)
    return ret + jnp.where(n < max_exact, n, large)


def banded_attention(q, k, v, half_w, dilation, rel_table, sink):
    f32 = jnp.float32
    N, L, H, Dh = q.shape
    Hk = k.shape[2]
    G = H // Hk
    blk = min(Q_BLOCK, L)
    nb = -(-L // blk)
    Lp = nb * blk
    span = blk + 2 * half_w
    qp = jnp.pad(q.astype(f32), ((0, 0), (0, Lp - L), (0, 0), (0, 0)))
    kv_pad = ((0, 0), (half_w, Lp - L + half_w), (0, 0), (0, 0))
    kp = jnp.pad(k.astype(f32), kv_pad)
    vp = jnp.pad(v.astype(f32), kv_pad)
    kidx = jnp.arange(nb)[:, None] * blk + jnp.arange(span)[None, :]
    kb = kp[:, kidx]
    vb = vp[:, kidx]
    qb = qp.reshape(N, nb, blk, Hk, G, Dh)
    s = jnp.einsum('nbqkgd,nbskd->nbkgqs', qb, kb) * (Dh ** -0.5)
    rel = jnp.arange(span)[None, :] - half_w - jnp.arange(blk)[:, None]
    bias = rel_table.astype(f32)[rel_bucket(rel * dilation)]
    bias = bias.transpose(2, 0, 1).reshape(Hk, G, blk, span)
    kpos = kidx - half_w
    valid = (jnp.abs(rel) <= half_w)[None] & ((kpos >= 0) & (kpos < L))[:, None, :]
    s = jnp.where(valid[None, :, None, None], s + bias, NEG_INF)
    m = jnp.max(s, axis=-1, keepdims=True)
    if sink is not None:
        sk = sink.astype(f32).reshape(Hk, G, 1, 1)
        m = jnp.maximum(m, sk)
    p = jnp.exp(s - m)
    denom = jnp.sum(p, axis=-1, keepdims=True)
    if sink is not None:
        denom = denom + jnp.exp(sk - m)
    out = jnp.einsum('nbkgqs,nbskd->nbqkgd', p / denom, vb).reshape(N, Lp, H, Dh)[:, :L]
    lse = (m + jnp.log(denom))[..., 0].transpose(0, 1, 4, 2, 3).reshape(N, Lp, H)[:, :L]
    return out.astype(v.dtype), lse


def dense_attention(q, k, v):
    f32 = jnp.float32
    Bn, S, H, Dq = q.shape
    Hk, Dv = k.shape[2], v.shape[3]
    G = H // Hk
    nb = S // Q_BLOCK
    qb = q.astype(f32).reshape(Bn, nb, Q_BLOCK, Hk, G, Dq).swapaxes(0, 1)
    k32, v32 = k.astype(f32), v.astype(f32)
    scale = Dq ** -0.5

    def block(qblk):
        s = jnp.einsum('bqkgd,bskd->bkgqs', qblk, k32) * scale
        p = jax.nn.softmax(s, axis=-1)
        return jnp.einsum('bkgqs,bskd->bqkgd', p, v32)

    out = lax.map(block, qb)
    return out.swapaxes(0, 1).reshape(Bn, S, H, Dv).astype(v.dtype)


def to_strided(t, dil):
    Bn, S = t.shape[:2]
    return t.reshape(Bn, S // dil, dil, *t.shape[2:]).swapaxes(1, 2).reshape(Bn * dil, S // dil, *t.shape[2:])


def from_strided(t, dil, Bn):
    L = t.shape[1]
    return t.reshape(Bn, dil, L, *t.shape[2:]).swapaxes(1, 2).reshape(Bn, dil * L, *t.shape[2:])


def mixer_a(q, k, v, q_gain, k_gain, rel_table, sink):
    q = rms_norm(q, q_gain)
    k = rms_norm(k, k_gain)
    out, _ = banded_attention(q, k, v, A_HALF_WINDOW, 1, rel_table, sink)
    return out


def mixer_b(q, k, v, q_gain, k_gain, rel_table):
    Bn = q.shape[0]
    outs, lses = [], []
    for g, (window, dil) in enumerate(B_PATTERNS):
        half = window // (2 * dil)
        qg = rms_norm(q[:, :, g], q_gain[g])
        kg = rms_norm(k[:, :, g], k_gain[g])
        o, lse = banded_attention(to_strided(qg, dil), to_strided(kg, dil), to_strided(v[:, :, g], dil),
                                  half, dil, rel_table[:, g * B_HEADS:(g + 1) * B_HEADS], None)
        outs.append(from_strided(o, dil, Bn).astype(jnp.float32))
        lses.append(from_strided(lse, dil, Bn))
    w = jax.nn.softmax(jnp.stack(lses, axis=0), axis=0)
    return jnp.einsum('gbsh,gbshd->bshd', w, jnp.stack(outs, axis=0)).astype(v.dtype)


def mixer_c(cq, ckv, kpe, cq_lat_gain, ckv_lat_gain, w_uq, w_ukv, q_gain, k_gain, pos):
    Bn, S = cq.shape[:2]
    q = (rms_norm(cq, cq_lat_gain) @ w_uq).reshape(Bn, S, C_HEADS, C_QK_DIM)
    kv = (rms_norm(ckv, ckv_lat_gain) @ w_ukv).reshape(Bn, S, C_HEADS, C_NOPE + C_V)
    k_nope, v = kv[..., :C_NOPE], kv[..., C_NOPE:]
    q_nope = rms_norm(q[..., :C_NOPE], q_gain[:C_NOPE])
    q_pe = rope(rms_norm(q[..., C_NOPE:], q_gain[C_NOPE:]), pos)
    k_nope = rms_norm(k_nope, k_gain[:C_NOPE])
    k_pe = rope(rms_norm(kpe[:, :, None, :], k_gain[C_NOPE:]), pos)
    qf = jnp.concatenate([q_nope, q_pe], axis=-1)
    kf = jnp.concatenate([k_nope, jnp.broadcast_to(k_pe, (Bn, S, C_HEADS, C_ROPE))], axis=-1)
    return dense_attention(qf, kf, v)


def mixer_d(q, k, v, q_gain, k_gain, row, col):
    q = axial_rope(rms_norm(q, q_gain), row, col)
    k = axial_rope(rms_norm(k, k_gain), row, col)
    return dense_attention(q, k, v)


def peer_ffn(x, w_q, sub_keys, w_u, w_v):
    Bn, S, D = x.shape
    T = Bn * S
    xt = x.reshape(T, D)
    half = PEER_KEY_DIM // 2
    kk = PEER_TOPK * PEER_TOPK
    q = (xt @ w_q).reshape(T, PEER_HEADS, 2, half).astype(jnp.float32)
    scores = jnp.einsum('thcd,hcnd->thcn', q, sub_keys.astype(jnp.float32))
    s_half, i_half = lax.top_k(scores, PEER_TOPK)
    cand_s = (s_half[:, :, 0, :, None] + s_half[:, :, 1, None, :]).reshape(T, PEER_HEADS, kk)
    cand_i = (i_half[:, :, 0, :, None] * PEER_N_KEYS + i_half[:, :, 1, None, :]).reshape(T, PEER_HEADS, kk)
    top_s, top_pos = lax.top_k(cand_s, PEER_TOPK)
    idx = jnp.take_along_axis(cand_i, top_pos, axis=-1)
    gate = jax.nn.softmax(top_s, axis=-1)
    nb = T // PEER_TOKEN_BLOCK
    E = PEER_HEADS * PEER_TOPK

    def block(args):
        xb, ib, gb = args
        act = jax.nn.gelu(jnp.einsum('td,ted->te', xb, w_u[ib]).astype(jnp.float32), approximate=False)
        return jnp.einsum('te,ted->td', (act * gb).astype(xb.dtype), w_v[ib])

    out = lax.map(block, (xt.reshape(nb, PEER_TOKEN_BLOCK, D),
                          idx.reshape(nb, PEER_TOKEN_BLOCK, E),
                          gate.reshape(nb, PEER_TOKEN_BLOCK, E)))
    return out.reshape(Bn, S, D)


def setup_inputs(seed: int = 0) -> dict:
    key = jax.random.key(seed)
    ks = jax.random.split(key, 26)
    f32 = jnp.float32

    def nrm(k, shape, scale):
        return jax.random.normal(k, shape, f32) * scale

    def gain(k, shape):
        return 1.0 + 0.02 * jax.random.normal(k, shape, f32)

    L = DEPTH
    return {
        'x': nrm(ks[0], (BATCH, SEQ, D_MODEL), 1.0),
        'rel_bias': nrm(ks[1], (REL_BUCKETS, REL_HEADS), 0.5),
        'norm1_gain': gain(ks[2], (L, D_MODEL)),
        'w_in': nrm(ks[3], (L, D_MODEL, IN_WIDTH), D_MODEL ** -0.5),
        'gate_bias': nrm(ks[4], (L, N_BRANCHES * D_MODEL), 0.01),
        'a_q_gain': gain(ks[5], (L, HEAD_DIM)),
        'a_k_gain': gain(ks[6], (L, HEAD_DIM)),
        'a_sink': nrm(ks[7], (L, A_HEADS), 0.5),
        'b_q_gain': gain(ks[8], (L, B_GROUPS, HEAD_DIM)),
        'b_k_gain': gain(ks[9], (L, B_GROUPS, HEAD_DIM)),
        'c_q_lat_gain': gain(ks[10], (L, C_Q_RANK)),
        'c_kv_lat_gain': gain(ks[11], (L, C_KV_RANK)),
        'c_w_uq': nrm(ks[12], (L, C_Q_RANK, C_HEADS * C_QK_DIM), C_Q_RANK ** -0.5),
        'c_w_ukv': nrm(ks[13], (L, C_KV_RANK, C_HEADS * (C_NOPE + C_V)), C_KV_RANK ** -0.5),
        'c_q_gain': gain(ks[14], (L, C_QK_DIM)),
        'c_k_gain': gain(ks[15], (L, C_QK_DIM)),
        'd_q_gain': gain(ks[16], (L, HEAD_DIM)),
        'd_k_gain': gain(ks[17], (L, HEAD_DIM)),
        'w_branch': nrm(ks[18], (L, N_BRANCHES, BRANCH_WIDTH, D_MODEL), BRANCH_WIDTH ** -0.5),
        'w_out': nrm(ks[19], (L, D_MODEL, D_MODEL), D_MODEL ** -0.5),
        'norm2_gain': gain(ks[20], (L, D_MODEL)),
        'peer_w_q': nrm(ks[21], (L, D_MODEL, PEER_HEADS * PEER_KEY_DIM), D_MODEL ** -0.5),
        'peer_sub_keys': nrm(ks[22], (L, PEER_HEADS, 2, PEER_N_KEYS, PEER_KEY_DIM // 2), (PEER_KEY_DIM // 2) ** -0.5),
        'peer_w_u': nrm(ks[23], (L, PEER_N_EXPERTS, D_MODEL), D_MODEL ** -0.5),
        'peer_w_v': nrm(ks[24], (L, PEER_N_EXPERTS, D_MODEL), PEER_HEADS ** -0.5),
    }


def reference(x, rel_bias, norm1_gain, w_in, gate_bias, a_q_gain, a_k_gain, a_sink, b_q_gain, b_k_gain,
              c_q_lat_gain, c_kv_lat_gain, c_w_uq, c_w_ukv, c_q_gain, c_k_gain, d_q_gain, d_k_gain,
              w_branch, w_out, norm2_gain, peer_w_q, peer_sub_keys, peer_w_u, peer_w_v):
    Bn, S, D = x.shape
    rows = S // GRID_W
    pos = jnp.arange(S, dtype=jnp.int32)
    row = jnp.broadcast_to(jnp.arange(rows, dtype=jnp.int32)[:, None], (rows, GRID_W)).reshape(S)
    col = jnp.broadcast_to(jnp.arange(GRID_W, dtype=jnp.int32)[None, :], (rows, GRID_W)).reshape(S)
    offsets = [int(o) for o in np.cumsum(IN_SPLITS)[:-1]]

    def heads(t, n):
        return t.reshape(Bn, S, n, HEAD_DIM)

    def groups(t):
        return t.reshape(Bn, S, B_GROUPS, B_HEADS, HEAD_DIM)

    h = x
    for l in range(DEPTH):
        hn = rms_norm(h, norm1_gain[l])
        proj = hn @ w_in[l]
        (aq, ak, av, bq, bk, bv, cq, ckv, ckr, dq, dk, dv, gpre) = jnp.split(proj, offsets, axis=-1)
        ya = mixer_a(heads(aq, A_HEADS), heads(ak, A_KV_HEADS), heads(av, A_KV_HEADS),
                     a_q_gain[l], a_k_gain[l], rel_bias[:, :A_HEADS], a_sink[l])
        yb = mixer_b(groups(bq), groups(bk), groups(bv), b_q_gain[l], b_k_gain[l], rel_bias[:, A_HEADS:])
        yc = mixer_c(cq, ckv, ckr, c_q_lat_gain[l], c_kv_lat_gain[l], c_w_uq[l], c_w_ukv[l],
                     c_q_gain[l], c_k_gain[l], pos)
        yd = mixer_d(heads(dq, D_HEADS), heads(dk, D_KV_HEADS), heads(dv, D_KV_HEADS),
                     d_q_gain[l], d_k_gain[l], row, col)
        ys = jnp.stack([ya.reshape(Bn, S, BRANCH_WIDTH), yb.reshape(Bn, S, BRANCH_WIDTH),
                        yc.reshape(Bn, S, BRANCH_WIDTH), yd.reshape(Bn, S, BRANCH_WIDTH)], axis=2)
        branches = jnp.einsum('bsnc,ncd->bsnd', ys, w_branch[l])
        gates = jax.nn.sigmoid(gpre.reshape(Bn, S, N_BRANCHES, D) + gate_bias[l].reshape(N_BRANCHES, D))
        merged = jnp.einsum('bsnd,bsnd->bsd', gates, branches)
        h = h + merged @ w_out[l]
        h = h + peer_ffn(rms_norm(h, norm2_gain[l]), peer_w_q[l], peer_sub_keys[l], peer_w_u[l], peer_w_v[l])
    return h
```

```cpp
#include <hip/hip_runtime.h>
#include <hip/hip_cooperative_groups.h>
#include <stdint.h>
#include <stdio.h>
namespace cg = cooperative_groups;

#ifndef MULTI_LAUNCH
#define MULTI_LAUNCH 1
#endif

#define DEVI __device__ __forceinline__
#define LAS __attribute__((address_space(3)))
typedef unsigned short bf16_t;
typedef short bf16x8 __attribute__((ext_vector_type(8)));
typedef short s16x4 __attribute__((ext_vector_type(4)));
typedef float f32x16 __attribute__((ext_vector_type(16)));
typedef float f32x4 __attribute__((ext_vector_type(4)));
typedef float f32x2 __attribute__((ext_vector_type(2)));
typedef unsigned u32x4 __attribute__((ext_vector_type(4)));
typedef unsigned u32x2 __attribute__((ext_vector_type(2)));
typedef LAS char lchar;

constexpr int S = 16384, DM = 1024, NLAYER = 2;
constexpr int INW = 7840, INP = 7936, PW = 3840, GW = 4096, NGATE0 = 3744;
constexpr int O_AQ = 0, O_AK = 256, O_AV = 384, O_BQ = 512, O_BK = 1280, O_BV = 2048, O_CQ = 2816, O_CKV = 3072, O_CKR = 3200,
              O_DQ = 3232, O_DK = 3488, O_DV = 3616;
constexpr float EPS = 1e-6f;
constexpr float LOG2E = 1.4426950408889634f;
constexpr int NTHREADS = 512, NWAVES = 8;
constexpr int LDS_BYTES = 81920;

constexpr size_t MiB = 1u << 20;
constexpr size_t WS_CTL = 0;
constexpr size_t WS_WIN = 1 * MiB;
constexpr size_t WS_WUQ = 32 * MiB;
constexpr size_t WS_WUKV = 32 * MiB + 512 * 1024;
constexpr size_t WS_WBR = 33 * MiB;
constexpr size_t WS_WOUT = 37 * MiB;
constexpr size_t WS_WPQ = 41 * MiB;
constexpr size_t WS_KEYS = 45 * MiB;
constexpr size_t WS_CQN = 46 * MiB;
constexpr size_t WS_CKVN = 54 * MiB;
constexpr size_t WS_HN = 58 * MiB;
constexpr size_t WS_P = 90 * MiB;
constexpr size_t WS_G = 210 * MiB;
constexpr size_t WS_QKV = 338 * MiB;
constexpr size_t WS_END = 474 * MiB;
constexpr size_t WS_CQRAW = WS_P;
constexpr size_t WS_CKVRAW = WS_P + 12 * MiB;
constexpr size_t WS_OB = WS_P + 28 * MiB;
constexpr size_t WS_LSE = WS_P + 52 * MiB;
constexpr size_t WS_Y = WS_P + 53 * MiB;
constexpr size_t WS_MERGED = WS_P + 85 * MiB;
constexpr size_t WS_PQ = WS_P;
constexpr size_t WS_IDX = WS_P + 32 * MiB;
constexpr size_t WS_GATE = WS_P + 40 * MiB;
constexpr size_t WS_SCORES = WS_G;
constexpr size_t Q_QA = 0, Q_KA = 8 * MiB, Q_VAT = 12 * MiB, Q_QB = 16 * MiB, Q_KB = 40 * MiB, Q_VBT = 64 * MiB, Q_QC = 88 * MiB,
                 Q_KC = 100 * MiB, Q_VCT = 112 * MiB, Q_QD = 120 * MiB, Q_KD = 128 * MiB, Q_VDT = 132 * MiB;
constexpr size_t WS_PU = WS_QKV, WS_PV = WS_QKV + 32 * MiB;

struct Params {
    const float* in[25];
    float* out;
    unsigned char* ws;
    int ph_lo, ph_hi;
};

DEVI unsigned pk2(float lo, float hi) {
    typedef __bf16 bf2 __attribute__((ext_vector_type(2)));
    f32x2 v = {lo, hi};
    bf2 b = __builtin_convertvector(v, bf2);
    return __builtin_bit_cast(unsigned, b);
}
DEVI unsigned short f2bf(float f) { return (unsigned short)(pk2(f, 0.f) & 0xffffu); }
DEVI float bf2f(unsigned short b) { return __uint_as_float(((unsigned)b) << 16); }
DEVI float bflo(unsigned w) { return __uint_as_float(w << 16); }
DEVI float bfhi(unsigned w) { return __uint_as_float(w & 0xffff0000u); }
DEVI float wave_sum(float v) {
#pragma unroll
    for (int o = 1; o < 64; o <<= 1) v += __shfl_xor(v, o);
    return v;
}
DEVI float wave_max(float v) {
#pragma unroll
    for (int o = 1; o < 64; o <<= 1) v = fmaxf(v, __shfl_xor(v, o));
    return v;
}
DEVI int crow(int reg, int h) { return (reg & 3) + 8 * (reg >> 2) + 4 * h; }
DEVI float fast_exp2(float x) { return __builtin_amdgcn_exp2f(x); }

DEVI void transpose_item(const float* W, int ldn, int K, bf16_t* WT, int k0, int n0, int drow0, LAS float* scr, int lane) {
#pragma unroll 8
    for (int i = 0; i < 32; ++i) {
        const int kk = 2 * i + (lane >> 5);
        scr[kk * 33 + (lane & 31)] = W[(size_t)(k0 + kk) * ldn + n0 + (lane & 31)];
    }
    asm volatile("s_waitcnt lgkmcnt(0)" ::: "memory");
    const int c = lane & 7;
#pragma unroll
    for (int j = 0; j < 4; ++j) {
        const int n = (lane >> 3) + 8 * j;
        const LAS float* s = scr + (8 * c) * 33 + n;
        u32x4 o;
        o.x = pk2(s[0 * 33], s[1 * 33]); o.y = pk2(s[2 * 33], s[3 * 33]); o.z = pk2(s[4 * 33], s[5 * 33]); o.w = pk2(s[6 * 33], s[7 * 33]);
        *(u32x4*)(WT + (size_t)(drow0 + n) * K + k0 + 8 * c) = o;
    }
    asm volatile("s_waitcnt lgkmcnt(0)" ::: "memory");
}
DEVI void transpose_matrix(const float* W, int K, int N, bf16_t* WT, bool remap, LAS float* scr, int gw, int ngw, int lane) {
    const int nblk = N / 32, items = (K / 64) * nblk;
    for (int it = gw; it < items; it += ngw) {
        const int kb = it / nblk, nb = it % nblk, n0 = 32 * nb;
        int drow0 = n0;
        if (remap) drow0 = (n0 >= NGATE0) ? (n0 - NGATE0) : (n0 + GW);
        transpose_item(W, N, K, WT, 64 * kb, n0, drow0, scr, lane);
    }
}
DEVI void convert_f32_bf16(const float* src, bf16_t* dst, size_t n, size_t gtid, size_t gthreads) {
    for (size_t i = gtid * 4; i < n; i += gthreads * 4) {
        const f32x4 v = *(const f32x4*)(src + i);
        u32x2 o; o.x = pk2(v.x, v.y); o.y = pk2(v.z, v.w);
        *(u32x2*)(dst + i) = o;
    }
}
DEVI void phase_prep(const Params& p, lchar* lds) {
    const int tid = threadIdx.x, lane = tid & 63, wid = tid >> 6;
    const int gw = blockIdx.x * NWAVES + wid, ngw = gridDim.x * NWAVES;
    LAS float* scr = (LAS float*)(lds + wid * 8704);
    unsigned char* ws = p.ws;
    for (int l = 0; l < NLAYER; ++l) {
        bf16_t* win = (bf16_t*)(ws + WS_WIN) + (size_t)l * INP * DM;
        transpose_matrix(p.in[3] + (size_t)l * DM * INW, DM, INW, win, true, scr, gw, ngw, lane);
        for (int i = gw * 64 + lane; i < (INP - INW) * DM / 8; i += ngw * 64) *(u32x4*)(win + (size_t)INW * DM + (size_t)i * 8) = (u32x4){0u, 0u, 0u, 0u};
        transpose_matrix(p.in[12] + (size_t)l * 256 * 384, 256, 384, (bf16_t*)(ws + WS_WUQ) + (size_t)l * 384 * 256, false, scr, gw, ngw, lane);
        transpose_matrix(p.in[13] + (size_t)l * 128 * 512, 128, 512, (bf16_t*)(ws + WS_WUKV) + (size_t)l * 512 * 128, false, scr, gw, ngw, lane);
        for (int n = 0; n < 4; ++n)
            transpose_matrix(p.in[18] + ((size_t)l * 4 + n) * 256 * 1024, 256, 1024, (bf16_t*)(ws + WS_WBR) + ((size_t)l * 4 + n) * 1024 * 256, false, scr, gw, ngw, lane);
        transpose_matrix(p.in[19] + (size_t)l * DM * DM, DM, DM, (bf16_t*)(ws + WS_WOUT) + (size_t)l * DM * DM, false, scr, gw, ngw, lane);
        transpose_matrix(p.in[21] + (size_t)l * DM * DM, DM, DM, (bf16_t*)(ws + WS_WPQ) + (size_t)l * DM * DM, false, scr, gw, ngw, lane);
    }
    convert_f32_bf16(p.in[22], (bf16_t*)(ws + WS_KEYS), (size_t)NLAYER * 16 * 128 * 64, (size_t)blockIdx.x * NTHREADS + tid, (size_t)gridDim.x * NTHREADS);
}

DEVI void phase_rownorm(const float* h, const float* gain, bf16_t* hn) {
    const int tid = threadIdx.x, lane = tid & 63, wid = tid >> 6;
    const int gw = blockIdx.x * NWAVES + wid, ngw = gridDim.x * NWAVES;
    f32x4 g[4];
#pragma unroll
    for (int j = 0; j < 4; ++j) g[j] = *(const f32x4*)(gain + 4 * lane + 256 * j);
    for (int row = gw; row < S; row += ngw) {
        const float* xr = h + (size_t)row * DM;
        f32x4 v[4]; float ss = 0.f;
#pragma unroll
        for (int j = 0; j < 4; ++j) { v[j] = *(const f32x4*)(xr + 4 * lane + 256 * j); ss += (v[j].x * v[j].x + v[j].y * v[j].y) + (v[j].z * v[j].z + v[j].w * v[j].w); }
        const float rstd = rsqrtf(wave_sum(ss) * (1.f / DM) + EPS);
        bf16_t* orow = hn + (size_t)row * DM;
#pragma unroll
        for (int j = 0; j < 4; ++j) {
            u32x2 o; o.x = pk2(v[j].x * rstd * g[j].x, v[j].y * rstd * g[j].y); o.y = pk2(v[j].z * rstd * g[j].z, v[j].w * rstd * g[j].w);
            *(u32x2*)(orow + 4 * lane + 256 * j) = o;
        }
    }
}

constexpr int GROW = 144;
template <int NT>
DEVI void gemm_kloop(f32x16 (&acc)[4][NT], const bf16_t* A, int lda, const bf16_t* B, int ldb, int K, lchar* lds) {
    const int tid = threadIdx.x, lane = tid & 63, wid = tid >> 6, wm = wid >> 2, wn = wid & 3, r = lane & 31, h = lane >> 5;
    lchar* As = lds; lchar* Bs = lds + 256 * GROW;
    constexpr int NB = 2 * NT;
    u32x4 ra[4], rb[NB];
    const int crow_ = tid >> 3, ccol = tid & 7;
    const bf16_t* ap = A + (size_t)crow_ * lda + ccol * 8;
    const bf16_t* bp = B + (size_t)crow_ * ldb + ccol * 8;
#pragma unroll
    for (int i = 0; i < 4; ++i) ra[i] = *(const u32x4*)(ap + (size_t)(64 * i) * lda);
#pragma unroll
    for (int i = 0; i < NB; ++i) rb[i] = *(const u32x4*)(bp + (size_t)(64 * i) * ldb);
    const int nk = K / 64;
    for (int kt = 0; kt < nk; ++kt) {
        __syncthreads();
#pragma unroll
        for (int i = 0; i < 4; ++i) *(LAS u32x4*)(As + (crow_ + 64 * i) * GROW + ccol * 16) = ra[i];
#pragma unroll
        for (int i = 0; i < NB; ++i) *(LAS u32x4*)(Bs + (crow_ + 64 * i) * GROW + ccol * 16) = rb[i];
        __syncthreads();
        if (kt + 1 < nk) {
#pragma unroll
            for (int i = 0; i < 4; ++i) ra[i] = *(const u32x4*)(ap + (size_t)(64 * i) * lda + (kt + 1) * 64);
#pragma unroll
            for (int i = 0; i < NB; ++i) rb[i] = *(const u32x4*)(bp + (size_t)(64 * i) * ldb + (kt + 1) * 64);
        }
#pragma unroll
        for (int ks = 0; ks < 4; ++ks) {
            bf16x8 xf[4], wf[NT];
#pragma unroll
            for (int mt = 0; mt < 4; ++mt) xf[mt] = *(const LAS bf16x8*)(As + (wm * 128 + mt * 32 + r) * GROW + (2 * ks + h) * 16);
#pragma unroll
            for (int nt = 0; nt < NT; ++nt) wf[nt] = *(const LAS bf16x8*)(Bs + (wn * 32 * NT + nt * 32 + r) * GROW + (2 * ks + h) * 16);
#pragma unroll
            for (int mt = 0; mt < 4; ++mt)
#pragma unroll
                for (int nt = 0; nt < NT; ++nt) acc[mt][nt] = __builtin_amdgcn_mfma_f32_32x32x16_bf16(wf[nt], xf[mt], acc[mt][nt], 0, 0, 0);
        }
    }
}
template <int NT> DEVI void acc_zero(f32x16 (&acc)[4][NT]) {
#pragma unroll
    for (int mt = 0; mt < 4; ++mt)
#pragma unroll
        for (int nt = 0; nt < NT; ++nt)
#pragma unroll
            for (int i = 0; i < 16; ++i) acc[mt][nt][i] = 0.f;
}
template <int NT, class Epi>
DEVI void gemm_phase(const bf16_t* A, int lda, const bf16_t* Bt, int ldb, int K, int tiles_m, int tiles_n, const Epi& epi, lchar* lds) {
    const int tid = threadIdx.x, lane = tid & 63, wid = tid >> 6, wm = wid >> 2, wn = wid & 3, r = lane & 31, h = lane >> 5;
    constexpr int BN = 128 * NT;
    for (int t = blockIdx.x; t < tiles_m * tiles_n; t += gridDim.x) {
        const int tm = t % tiles_m, tn = t / tiles_m;
        f32x16 acc[4][NT];
        acc_zero<NT>(acc);
        gemm_kloop<NT>(acc, A + (size_t)tm * 256 * lda, lda, Bt + (size_t)tn * BN * ldb, ldb, K, lds);
#pragma unroll
        for (int mt = 0; mt < 4; ++mt)
#pragma unroll
            for (int nt = 0; nt < NT; ++nt)
#pragma unroll
                for (int rg = 0; rg < 4; ++rg) {
                    const int row = tm * 256 + wm * 128 + mt * 32 + r;
                    const int col = tn * BN + wn * 32 * NT + nt * 32 + 8 * rg + 4 * h;
                    epi(row, col, (f32x4){acc[mt][nt][4 * rg], acc[mt][nt][4 * rg + 1], acc[mt][nt][4 * rg + 2], acc[mt][nt][4 * rg + 3]});
                }
    }
}
struct EpiInproj {
    bf16_t* G; bf16_t* P; const float* gbias;
    DEVI void operator()(int row, int col, f32x4 v) const {
        if (col < GW) {
            const f32x4 b = *(const f32x4*)(gbias + col);
            f32x4 s;
            s.x = 1.f / (1.f + __expf(-(v.x + b.x))); s.y = 1.f / (1.f + __expf(-(v.y + b.y)));
            s.z = 1.f / (1.f + __expf(-(v.z + b.z))); s.w = 1.f / (1.f + __expf(-(v.w + b.w)));
            u32x2 o; o.x = pk2(s.x, s.y); o.y = pk2(s.z, s.w);
            *(u32x2*)(G + (size_t)row * GW + col) = o;
        } else {
            u32x2 o; o.x = pk2(v.x, v.y); o.y = pk2(v.z, v.w);
            *(u32x2*)(P + (size_t)row * PW + (col - GW)) = o;
        }
    }
};
struct EpiBf16 {
    bf16_t* C; int ldc;
    DEVI void operator()(int row, int col, f32x4 v) const {
        u32x2 o; o.x = pk2(v.x, v.y); o.y = pk2(v.z, v.w);
        *(u32x2*)(C + (size_t)row * ldc + col) = o;
    }
};
struct EpiResidual {
    const float* hin; float* hout;
    DEVI void operator()(int row, int col, f32x4 v) const {
        const f32x4 b = *(const f32x4*)(hin + (size_t)row * DM + col);
        *(f32x4*)(hout + (size_t)row * DM + col) = b + v;
    }
};
struct EpiF32 {
    float* C; int ldc;
    DEVI void operator()(int row, int col, f32x4 v) const { *(f32x4*)(C + (size_t)row * ldc + col) = v; }
};

DEVI void phase_merge(const bf16_t* Y, const bf16_t* Wbr  , const bf16_t* G, bf16_t* merged, lchar* lds) {
    const int tid = threadIdx.x, lane = tid & 63, wid = tid >> 6, wm = wid >> 2, wn = wid & 3, r = lane & 31, h = lane >> 5;
    for (int t = blockIdx.x; t < 64 * 8; t += gridDim.x) {
        const int tm = t % 64, tn = t / 64;
        f32x16 macc[4][1];
        acc_zero<1>(macc);
        for (int br = 0; br < 4; ++br) {
            f32x16 acc[4][1];
            acc_zero<1>(acc);
            gemm_kloop<1>(acc, Y + (size_t)tm * 256 * DM + br * 256, DM, Wbr + ((size_t)br * 1024 + tn * 128) * 256, 256, 256, lds);
#pragma unroll
            for (int mt = 0; mt < 4; ++mt)
#pragma unroll
                for (int rg = 0; rg < 4; ++rg) {
                    const int row = tm * 256 + wm * 128 + mt * 32 + r;
                    const int col = tn * 128 + wn * 32 + 8 * rg + 4 * h;
                    const u32x2 g = *(const u32x2*)(G + (size_t)row * GW + br * 1024 + col);
                    macc[mt][0][4 * rg + 0] += bflo(g.x) * acc[mt][0][4 * rg + 0];
                    macc[mt][0][4 * rg + 1] += bfhi(g.x) * acc[mt][0][4 * rg + 1];
                    macc[mt][0][4 * rg + 2] += bflo(g.y) * acc[mt][0][4 * rg + 2];
                    macc[mt][0][4 * rg + 3] += bfhi(g.y) * acc[mt][0][4 * rg + 3];
                }
        }
#pragma unroll
        for (int mt = 0; mt < 4; ++mt)
#pragma unroll
            for (int rg = 0; rg < 4; ++rg) {
                const int row = tm * 256 + wm * 128 + mt * 32 + r;
                const int col = tn * 128 + wn * 32 + 8 * rg + 4 * h;
                u32x2 o; o.x = pk2(macc[mt][0][4 * rg], macc[mt][0][4 * rg + 1]); o.y = pk2(macc[mt][0][4 * rg + 2], macc[mt][0][4 * rg + 3]);
                *(u32x2*)(merged + (size_t)row * DM + col) = o;
            }
    }
}

DEVI void vtrans_unit(const bf16_t* src, int pitch, int off, int t0, int dil, bf16_t* VT, LAS bf16_t* T, int lane) {
    constexpr int TS = 68;
    const int cw = 64 / dil;
#pragma unroll
    for (int i = 0; i < 8; ++i) {
        const int tl = i * 8 + (lane >> 3), ch = lane & 7;
        const u32x4 v = *(const u32x4*)(src + (size_t)(t0 + tl) * pitch + off + ch * 8);
        const int tp = (tl % dil) * cw + tl / dil;
        T[(ch * 8 + 0) * TS + tp] = (bf16_t)(v.x & 0xffffu); T[(ch * 8 + 1) * TS + tp] = (bf16_t)(v.x >> 16);
        T[(ch * 8 + 2) * TS + tp] = (bf16_t)(v.y & 0xffffu); T[(ch * 8 + 3) * TS + tp] = (bf16_t)(v.y >> 16);
        T[(ch * 8 + 4) * TS + tp] = (bf16_t)(v.z & 0xffffu); T[(ch * 8 + 5) * TS + tp] = (bf16_t)(v.z >> 16);
        T[(ch * 8 + 6) * TS + tp] = (bf16_t)(v.w & 0xffffu); T[(ch * 8 + 7) * TS + tp] = (bf16_t)(v.w >> 16);
    }
    asm volatile("s_waitcnt lgkmcnt(0)" ::: "memory");
    const int L = S / dil;
#pragma unroll
    for (int i = 0; i < 16; ++i) {
        const int id = i * 64 + lane, d = id >> 4, c = id & 15;
        const u32x2 v = *(const LAS u32x2*)(T + d * TS + c * 4);
        const int tp = c * 4, cls = tp / cw, within = tp % cw;
        const int pos = cls * L + t0 / dil + within;
        *(u32x2*)(VT + (size_t)d * S + pos) = v;
    }
    asm volatile("s_waitcnt lgkmcnt(0)" ::: "memory");
}

DEVI float rope_freq16(int i) { return exp2f(-(float)i * (13.287712379549449f / 16.f)); }
DEVI float rope32(float x, int li, float pos) {
    const float xp = __shfl_xor(x, 16);
    const float ang = pos * rope_freq16(li & 15);
    const float c = cosf(ang), s = sinf(ang);
    return (li < 16) ? (x * c - xp * s) : (xp * s + x * c);
}
DEVI void phase_post1(const Params& p, int layer, lchar* lds) {
    const int tid = threadIdx.x, lane = tid & 63, wid = tid >> 6;
    const int gw = blockIdx.x * NWAVES + wid, ngw = gridDim.x * NWAVES;
    unsigned char* ws = p.ws;
    const bf16_t* P = (const bf16_t*)(ws + WS_P);
    unsigned char* qkv = ws + WS_QKV;
    const float aqg = p.in[5][layer * 64 + lane], akg = p.in[6][layer * 64 + lane];
    const float dqg = p.in[16][layer * 64 + lane], dkg = p.in[17][layer * 64 + lane];
    float bqg[3], bkg[3];
#pragma unroll
    for (int g = 0; g < 3; ++g) { bqg[g] = p.in[8][(layer * 3 + g) * 64 + lane]; bkg[g] = p.in[9][(layer * 3 + g) * 64 + lane]; }
    const float ckg_pe = p.in[15][layer * 96 + 64 + (lane & 31)];
    f32x4 cqlg = *(const f32x4*)(p.in[10] + layer * 256 + 4 * lane);
    f32x2 ckvlg = *(const f32x2*)(p.in[11] + layer * 128 + 2 * lane);
    const float qs64 = 0.125f * LOG2E;
    for (int t = gw; t < S; t += ngw) {
        const bf16_t* row = P + (size_t)t * PW;
#pragma unroll
        for (int hh = 0; hh < 4; ++hh) {
            const float v = bf2f(row[O_AQ + hh * 64 + lane]);
            const float rs = rsqrtf(wave_sum(v * v) * (1.f / 64.f) + EPS);
            ((bf16_t*)(qkv + Q_QA))[((size_t)hh * S + t) * 64 + lane] = f2bf(v * rs * aqg * qs64);
        }
#pragma unroll
        for (int kh = 0; kh < 2; ++kh) {
            const float v = bf2f(row[O_AK + kh * 64 + lane]);
            const float rs = rsqrtf(wave_sum(v * v) * (1.f / 64.f) + EPS);
            ((bf16_t*)(qkv + Q_KA))[((size_t)kh * S + t) * 64 + lane] = f2bf(v * rs * akg);
        }
#pragma unroll
        for (int g = 0; g < 3; ++g) {
            const int dil = (g == 0) ? 1 : (g == 1 ? 4 : 16);
            const int pos = (t % dil) * (S / dil) + t / dil;
#pragma unroll
            for (int hh = 0; hh < 4; ++hh) {
                const float v = bf2f(row[O_BQ + g * 256 + hh * 64 + lane]);
                const float rs = rsqrtf(wave_sum(v * v) * (1.f / 64.f) + EPS);
                ((bf16_t*)(qkv + Q_QB))[((size_t)(g * 4 + hh) * S + pos) * 64 + lane] = f2bf(v * rs * bqg[g] * qs64);
                const float w = bf2f(row[O_BK + g * 256 + hh * 64 + lane]);
                const float rs2 = rsqrtf(wave_sum(w * w) * (1.f / 64.f) + EPS);
                ((bf16_t*)(qkv + Q_KB))[((size_t)(g * 4 + hh) * S + pos) * 64 + lane] = f2bf(w * rs2 * bkg[g]);
            }
        }
        {
            const float pos = (lane < 32) ? (float)(t >> 6) : (float)(t & 63);
#pragma unroll
            for (int hh = 0; hh < 4; ++hh) {
                const float v = bf2f(row[O_DQ + hh * 64 + lane]);
                const float rs = rsqrtf(wave_sum(v * v) * (1.f / 64.f) + EPS);
                const float y = rope32(v * rs * dqg, lane & 31, pos);
                ((bf16_t*)(qkv + Q_QD))[((size_t)hh * S + t) * 64 + lane] = f2bf(y * qs64);
            }
#pragma unroll
            for (int kh = 0; kh < 2; ++kh) {
                const float v = bf2f(row[O_DK + kh * 64 + lane]);
                const float rs = rsqrtf(wave_sum(v * v) * (1.f / 64.f) + EPS);
                const float y = rope32(v * rs * dkg, lane & 31, pos);
                ((bf16_t*)(qkv + Q_KD))[((size_t)kh * S + t) * 64 + lane] = f2bf(y);
            }
        }
        {
            const u32x2 w = *(const u32x2*)(row + O_CQ + 4 * lane);
            const float a = bflo(w.x), b = bfhi(w.x), c = bflo(w.y), d = bfhi(w.y);
            const float rs = rsqrtf(wave_sum(a * a + b * b + c * c + d * d) * (1.f / 256.f) + EPS);
            u32x2 o; o.x = pk2(a * rs * cqlg.x, b * rs * cqlg.y); o.y = pk2(c * rs * cqlg.z, d * rs * cqlg.w);
            *(u32x2*)((bf16_t*)(ws + WS_CQN) + (size_t)t * 256 + 4 * lane) = o;
            const unsigned w2 = *(const unsigned*)(row + O_CKV + 2 * lane);
            const float e = bflo(w2), f = bfhi(w2);
            const float rs2 = rsqrtf(wave_sum(e * e + f * f) * (1.f / 128.f) + EPS);
            *(unsigned*)((bf16_t*)(ws + WS_CKVN) + (size_t)t * 128 + 2 * lane) = pk2(e * rs2 * ckvlg.x, f * rs2 * ckvlg.y);
            float kr = (lane < 32) ? bf2f(row[O_CKR + lane]) : 0.f;
            const float rs3 = rsqrtf(wave_sum(kr * kr) * (1.f / 32.f) + EPS);
            const float y = rope32(kr * rs3 * ckg_pe, lane & 31, (float)t);
            if (lane < 32) {
                const bf16_t yb = f2bf(y);
#pragma unroll
                for (int hh = 0; hh < 4; ++hh) ((bf16_t*)(qkv + Q_KC))[((size_t)hh * S + t) * 96 + 64 + lane] = yb;
            }
        }
    }
    LAS bf16_t* T = (LAS bf16_t*)(lds + wid * 8704);
    for (int u = gw; u < 16 * 256; u += ngw) {
        const int hd = u >> 8, t0 = (u & 255) * 64;
        if (hd < 2) vtrans_unit(P, PW, O_AV + hd * 64, t0, 1, (bf16_t*)(qkv + Q_VAT) + (size_t)hd * 64 * S, T, lane);
        else if (hd < 14) { const int gh = hd - 2, g = gh >> 2; const int dil = (g == 0) ? 1 : (g == 1 ? 4 : 16);
            vtrans_unit(P, PW, O_BV + gh * 64, t0, dil, (bf16_t*)(qkv + Q_VBT) + (size_t)gh * 64 * S, T, lane); }
        else vtrans_unit(P, PW, O_DV + (hd - 14) * 64, t0, 1, (bf16_t*)(qkv + Q_VDT) + (size_t)(hd - 14) * 64 * S, T, lane);
    }
}
DEVI void phase_post2(const Params& p, int layer, lchar* lds) {
    const int tid = threadIdx.x, lane = tid & 63, wid = tid >> 6;
    const int gw = blockIdx.x * NWAVES + wid, ngw = gridDim.x * NWAVES;
    unsigned char* ws = p.ws;
    unsigned char* qkv = ws + WS_QKV;
    const bf16_t* CQ = (const bf16_t*)(ws + WS_CQRAW);
    const bf16_t* CKV = (const bf16_t*)(ws + WS_CKVRAW);
    const float qg_n = p.in[14][layer * 96 + lane];
    const float qg_p = p.in[14][layer * 96 + 64 + (lane & 31)];
    const float kg_n = p.in[15][layer * 96 + lane];
    const float qs96 = 0.10206207261596575f * LOG2E;
    for (int t = gw; t < S; t += ngw) {
#pragma unroll
        for (int hh = 0; hh < 4; ++hh) {
            const float v = bf2f(CQ[(size_t)t * 384 + hh * 96 + lane]);
            const float rs = rsqrtf(wave_sum(v * v) * (1.f / 64.f) + EPS);
            bf16_t* qo = (bf16_t*)(qkv + Q_QC) + ((size_t)hh * S + t) * 96;
            qo[lane] = f2bf(v * rs * qg_n * qs96);
            const float w = (lane < 32) ? bf2f(CQ[(size_t)t * 384 + hh * 96 + 64 + lane]) : 0.f;
            const float rs2 = rsqrtf(wave_sum(w * w) * (1.f / 32.f) + EPS);
            const float y = rope32(w * rs2 * qg_p, lane & 31, (float)t);
            if (lane < 32) qo[64 + lane] = f2bf(y * qs96);
            const float k = bf2f(CKV[(size_t)t * 512 + hh * 128 + lane]);
            const float rs3 = rsqrtf(wave_sum(k * k) * (1.f / 64.f) + EPS);
            ((bf16_t*)(qkv + Q_KC))[((size_t)hh * S + t) * 96 + lane] = f2bf(k * rs3 * kg_n);
        }
    }
    LAS bf16_t* T = (LAS bf16_t*)(lds + wid * 8704);
    for (int u = gw; u < 4 * 256; u += ngw) {
        const int hd = u >> 8, t0 = (u & 255) * 64;
        vtrans_unit(CKV, 512, hd * 128 + 64, t0, 1, (bf16_t*)(qkv + Q_VCT) + (size_t)hd * 64 * S, T, lane);
    }
}

template <int DQ>
DEVI void dense_attn_unit(const bf16_t* Q, const bf16_t* K, const bf16_t* VT, bf16_t* Y  , int qb, lchar* lds) {
    constexpr int KS = DQ / 16, KROW = DQ * 2 + 16, KTB = 64 * KROW, VROW = 136, VTB = 64 * VROW, KCH = DQ / 8;
    const int tid = threadIdx.x, lane = tid & 63, wid = tid >> 6, r = lane & 31, h = lane >> 5;
    lchar* Kb[2] = {lds, lds + KTB};
    lchar* Vb[2] = {lds + 2 * KTB, lds + 2 * KTB + VTB};
    const int qrow = qb * 256 + wid * 32 + r;
    bf16x8 qf[KS];
#pragma unroll
    for (int ks = 0; ks < KS; ++ks) qf[ks] = *(const bf16x8*)(Q + (size_t)qrow * DQ + ks * 16 + h * 8);
    float m = -1e30f, l = 0.f;
    f32x16 o[2];
#pragma unroll
    for (int i = 0; i < 16; ++i) { o[0][i] = 0.f; o[1][i] = 0.f; }
    const int k_r0 = tid / KCH, k_c0 = tid % KCH;
    const int k_r1 = (512 + tid) / KCH, k_c1 = (512 + tid) % KCH;
    constexpr bool K2 = (64 * KCH > 512);
    const bool has2 = K2 && (512 + tid < 64 * KCH);
    const int v_d = tid >> 3, v_c = tid & 7;
    u32x4 rk0, rk1 = {0u, 0u, 0u, 0u}, rv;
    rk0 = *(const u32x4*)(K + (size_t)k_r0 * DQ + k_c0 * 8);
    if (has2) rk1 = *(const u32x4*)(K + (size_t)k_r1 * DQ + k_c1 * 8);
    rv = *(const u32x4*)(VT + (size_t)v_d * S + v_c * 8);
    __syncthreads();
    *(LAS u32x4*)(Kb[0] + k_r0 * KROW + k_c0 * 16) = rk0;
    if (has2) *(LAS u32x4*)(Kb[0] + k_r1 * KROW + k_c1 * 16) = rk1;
    *(LAS u32x2*)(Vb[0] + v_d * VROW + v_c * 16) = (u32x2){rv.x, rv.y};
    *(LAS u32x2*)(Vb[0] + v_d * VROW + v_c * 16 + 8) = (u32x2){rv.z, rv.w};
    __syncthreads();
    constexpr int NT = S / 64;
#pragma unroll 1
    for (int j = 0; j < NT; ++j) {
        const int cur = j & 1;
        if (j + 1 < NT) {
            const size_t kt = (size_t)(j + 1) * 64;
            rk0 = *(const u32x4*)(K + (kt + k_r0) * DQ + k_c0 * 8);
            if (has2) rk1 = *(const u32x4*)(K + (kt + k_r1) * DQ + k_c1 * 8);
            rv = *(const u32x4*)(VT + (size_t)v_d * S + kt + v_c * 8);
        }
        f32x16 p0, p1;
#pragma unroll
        for (int i = 0; i < 16; ++i) { p0[i] = 0.f; p1[i] = 0.f; }
#pragma unroll
        for (int ks = 0; ks < KS; ++ks) {
            const bf16x8 k0 = *(const LAS bf16x8*)(Kb[cur] + r * KROW + (2 * ks + h) * 16);
            const bf16x8 k1 = *(const LAS bf16x8*)(Kb[cur] + (32 + r) * KROW + (2 * ks + h) * 16);
            p0 = __builtin_amdgcn_mfma_f32_32x32x16_bf16(k0, qf[ks], p0, 0, 0, 0);
            p1 = __builtin_amdgcn_mfma_f32_32x32x16_bf16(k1, qf[ks], p1, 0, 0, 0);
        }
        __builtin_amdgcn_sched_barrier(0);
        float mx = fmaxf(p0[0], p1[0]);
#pragma unroll
        for (int i = 1; i < 16; ++i) mx = fmaxf(mx, fmaxf(p0[i], p1[i]));
        mx = fmaxf(mx, __shfl_xor(mx, 32));
        const float mn = fmaxf(m, mx);
        const float alpha = fast_exp2(m - mn);
        m = mn;
        float ls = 0.f;
#pragma unroll
        for (int i = 0; i < 16; ++i) { p0[i] = fast_exp2(p0[i] - mn); p1[i] = fast_exp2(p1[i] - mn); ls += p0[i] + p1[i]; }
        l = l * alpha + ls;
#pragma unroll
        for (int i = 0; i < 16; ++i) { o[0][i] *= alpha; o[1][i] *= alpha; }
        bf16x8 pf[2][2];
        {
            u32x4 w;
            w.x = pk2(p0[0], p0[1]); w.y = pk2(p0[2], p0[3]); w.z = pk2(p0[4], p0[5]); w.w = pk2(p0[6], p0[7]); pf[0][0] = __builtin_bit_cast(bf16x8, w);
            w.x = pk2(p0[8], p0[9]); w.y = pk2(p0[10], p0[11]); w.z = pk2(p0[12], p0[13]); w.w = pk2(p0[14], p0[15]); pf[0][1] = __builtin_bit_cast(bf16x8, w);
            w.x = pk2(p1[0], p1[1]); w.y = pk2(p1[2], p1[3]); w.z = pk2(p1[4], p1[5]); w.w = pk2(p1[6], p1[7]); pf[1][0] = __builtin_bit_cast(bf16x8, w);
            w.x = pk2(p1[8], p1[9]); w.y = pk2(p1[10], p1[11]); w.z = pk2(p1[12], p1[13]); w.w = pk2(p1[14], p1[15]); pf[1][1] = __builtin_bit_cast(bf16x8, w);
        }
        __builtin_amdgcn_sched_barrier(0);
#pragma unroll
        for (int db = 0; db < 2; ++db)
#pragma unroll
            for (int kb = 0; kb < 2; ++kb)
#pragma unroll
                for (int s = 0; s < 2; ++s) {
                    const lchar* vp = Vb[cur] + (db * 32 + r) * VROW + (kb * 32 + 16 * s + 4 * h) * 2;
                    const u32x2 a = *(const LAS u32x2*)(vp);
                    const u32x2 b = *(const LAS u32x2*)(vp + 16);
                    const u32x4 w = {a.x, a.y, b.x, b.y};
                    o[db] = __builtin_amdgcn_mfma_f32_32x32x16_bf16(__builtin_bit_cast(bf16x8, w), pf[kb][s], o[db], 0, 0, 0);
                }
        __builtin_amdgcn_sched_barrier(0);
        if (j + 1 < NT) {
            const int nx = cur ^ 1;
            *(LAS u32x4*)(Kb[nx] + k_r0 * KROW + k_c0 * 16) = rk0;
            if (has2) *(LAS u32x4*)(Kb[nx] + k_r1 * KROW + k_c1 * 16) = rk1;
            *(LAS u32x2*)(Vb[nx] + v_d * VROW + v_c * 16) = (u32x2){rv.x, rv.y};
            *(LAS u32x2*)(Vb[nx] + v_d * VROW + v_c * 16 + 8) = (u32x2){rv.z, rv.w};
        }
        __syncthreads();
    }
    l += __shfl_xor(l, 32);
    const float inv = 1.f / l;
    bf16_t* yrow = Y + (size_t)qrow * DM;
#pragma unroll
    for (int db = 0; db < 2; ++db)
#pragma unroll
        for (int rg = 0; rg < 4; ++rg) {
            u32x2 w; w.x = pk2(o[db][4 * rg] * inv, o[db][4 * rg + 1] * inv); w.y = pk2(o[db][4 * rg + 2] * inv, o[db][4 * rg + 3] * inv);
            *(u32x2*)(yrow + db * 32 + 8 * rg + 4 * h) = w;
        }
}

DEVI int rel_bucket(int rel) {
    const int n = rel < 0 ? -rel : rel;
    int b;
    if (n < 8) b = n; else if (n < 15) b = 8; else if (n < 27) b = 9; else if (n < 50) b = 10; else if (n < 91) b = 11; else if (n < 166) b = 12;
    else if (n < 305) b = 13; else if (n < 559) b = 14; else b = 15;
    return b + (rel > 0 ? 16 : 0);
}
DEVI void banded_unit(const bf16_t* Q, const bf16_t* K, const bf16_t* VT, int q0, int hw, int L, int dil, const LAS float* lut, bool has_sink, float sink2,
                      bf16_t* out, int ld_out, float* lse_out  , int lane) {
    const int r = lane & 31, h = lane >> 5;
    const int qpos = q0 + r;
    const int seg_lo = (q0 / L) * L, seg_hi = seg_lo + L;
    bf16x8 qf[4];
#pragma unroll
    for (int ks = 0; ks < 4; ++ks) qf[ks] = *(const bf16x8*)(Q + (size_t)qpos * 64 + ks * 16 + h * 8);
    float m = has_sink ? sink2 : -1e30f;
    float l = (has_sink && h == 0) ? 1.f : 0.f;
    f32x16 o[2];
#pragma unroll
    for (int i = 0; i < 16; ++i) { o[0][i] = 0.f; o[1][i] = 0.f; }
    const int nkb = (2 * hw + 32) / 32;
#pragma unroll 1
    for (int i = 0; i < nkb; ++i) {
        const int kbase = q0 - hw + 32 * i;
        int kp = kbase + r; kp = kp < 0 ? 0 : (kp > S - 1 ? S - 1 : kp);
        f32x16 pa;
#pragma unroll
        for (int q = 0; q < 16; ++q) pa[q] = 0.f;
#pragma unroll
        for (int ks = 0; ks < 4; ++ks) {
            const bf16x8 kf = *(const bf16x8*)(K + (size_t)kp * 64 + ks * 16 + h * 8);
            pa = __builtin_amdgcn_mfma_f32_32x32x16_bf16(kf, qf[ks], pa, 0, 0, 0);
        }
        float mx = -INFINITY;
#pragma unroll
        for (int q = 0; q < 16; ++q) {
            const int kp2 = kbase + crow(q, h);
            const int rel = kp2 - qpos;
            const bool valid = (kp2 >= seg_lo) && (kp2 < seg_hi) && (rel >= -hw) && (rel <= hw);
            int li = rel + hw; li = li < 0 ? 0 : (li > 2 * hw ? 2 * hw : li);
            const float b = lut[li];
            pa[q] = valid ? (pa[q] + b) : -INFINITY;
            mx = fmaxf(mx, pa[q]);
        }
        mx = fmaxf(mx, __shfl_xor(mx, 32));
        const float mn = fmaxf(m, mx);
        const float alpha = fast_exp2(m - mn);
        m = mn;
        float ls = 0.f;
#pragma unroll
        for (int q = 0; q < 16; ++q) { pa[q] = fast_exp2(pa[q] - mn); ls += pa[q]; }
        l = l * alpha + ls;
#pragma unroll
        for (int q = 0; q < 16; ++q) { o[0][q] *= alpha; o[1][q] *= alpha; }
        bf16x8 pf[2];
        {
            u32x4 w;
            w.x = pk2(pa[0], pa[1]); w.y = pk2(pa[2], pa[3]); w.z = pk2(pa[4], pa[5]); w.w = pk2(pa[6], pa[7]); pf[0] = __builtin_bit_cast(bf16x8, w);
            w.x = pk2(pa[8], pa[9]); w.y = pk2(pa[10], pa[11]); w.z = pk2(pa[12], pa[13]); w.w = pk2(pa[14], pa[15]); pf[1] = __builtin_bit_cast(bf16x8, w);
        }
#pragma unroll
        for (int s = 0; s < 2; ++s) {
            int kg = kbase + 16 * s + 4 * h, kg2 = kg + 8;
            kg = (kg < 0 || kg >= S) ? 0 : kg;
            kg2 = (kg2 < 0 || kg2 >= S) ? 0 : kg2;
#pragma unroll
            for (int db = 0; db < 2; ++db) {
                const bf16_t* vrow = VT + (size_t)(db * 32 + r) * S;
                const u32x2 a = *(const u32x2*)(vrow + kg);
                const u32x2 b = *(const u32x2*)(vrow + kg2);
                const u32x4 w = {a.x, a.y, b.x, b.y};
                o[db] = __builtin_amdgcn_mfma_f32_32x32x16_bf16(__builtin_bit_cast(bf16x8, w), pf[s], o[db], 0, 0, 0);
            }
        }
    }
    l += __shfl_xor(l, 32);
    const float inv = 1.f / l;
    const int token = (qpos % L) * dil + qpos / L;
    bf16_t* yrow = out + (size_t)token * ld_out;
#pragma unroll
    for (int db = 0; db < 2; ++db)
#pragma unroll
        for (int rg = 0; rg < 4; ++rg) {
            u32x2 w; w.x = pk2(o[db][4 * rg] * inv, o[db][4 * rg + 1] * inv); w.y = pk2(o[db][4 * rg + 2] * inv, o[db][4 * rg + 3] * inv);
            *(u32x2*)(yrow + db * 32 + 8 * rg + 4 * h) = w;
        }
    if (lse_out && h == 0) lse_out[(size_t)token * 4] = (m + log2f(l)) * 0.6931471805599453f;
}

DEVI void phase_attention(const Params& p, int layer, lchar* lds) {
    const int tid = threadIdx.x, lane = tid & 63, wid = tid >> 6;
    unsigned char* ws = p.ws;
    unsigned char* qkv = ws + WS_QKV;
    bf16_t* Y = (bf16_t*)(ws + WS_Y);
    LAS float* lut = (LAS float*)(lds + 49152);
    const float* relb = p.in[1];
    for (int i = tid; i < 16 * 260; i += NTHREADS) {
        const int hd = i / 260, e = i % 260;
        float v = 0.f;
        if (hd < 4) { if (e < 257) v = relb[rel_bucket(e - 128) * 16 + hd] * LOG2E; }
        else { const int gh = hd - 4, g = gh >> 2; const int dil = (g == 0) ? 1 : (g == 1 ? 4 : 16);
            if (e < 129) v = relb[rel_bucket((e - 64) * dil) * 16 + 4 + gh] * LOG2E; }
        lut[i] = v;
    }
    __syncthreads();
    for (int id = blockIdx.x; id < 512; id += gridDim.x) {
        const int mh = id & 7, qb = id >> 3;
        if (mh < 4) {
            dense_attn_unit<96>((const bf16_t*)(qkv + Q_QC) + (size_t)mh * S * 96, (const bf16_t*)(qkv + Q_KC) + (size_t)mh * S * 96,
                                (const bf16_t*)(qkv + Q_VCT) + (size_t)mh * 64 * S, Y + 512 + mh * 64, qb, lds);
        } else {
            const int hh = mh - 4;
            dense_attn_unit<64>((const bf16_t*)(qkv + Q_QD) + (size_t)hh * S * 64, (const bf16_t*)(qkv + Q_KD) + (size_t)(hh >> 1) * S * 64,
                                (const bf16_t*)(qkv + Q_VDT) + (size_t)(hh >> 1) * 64 * S, Y + 768 + hh * 64, qb, lds);
        }
    }
    const int gw = blockIdx.x * NWAVES + wid, ngw = gridDim.x * NWAVES;
    for (int u = gw; u < 16 * 512; u += ngw) {
        const int hd = u & 15, qt = u >> 4;
        if (hd < 4) {
            const float sink2 = p.in[7][layer * 4 + hd] * LOG2E;
            banded_unit((const bf16_t*)(qkv + Q_QA) + (size_t)hd * S * 64, (const bf16_t*)(qkv + Q_KA) + (size_t)(hd >> 1) * S * 64,
                        (const bf16_t*)(qkv + Q_VAT) + (size_t)(hd >> 1) * 64 * S, qt * 32, 128, S, 1, lut + hd * 260, true, sink2,
                        Y + hd * 64, DM, nullptr, lane);
        } else {
            const int gh = hd - 4, g = gh >> 2, hh = gh & 3; const int dil = (g == 0) ? 1 : (g == 1 ? 4 : 16);
            banded_unit((const bf16_t*)(qkv + Q_QB) + (size_t)gh * S * 64, (const bf16_t*)(qkv + Q_KB) + (size_t)gh * S * 64,
                        (const bf16_t*)(qkv + Q_VBT) + (size_t)gh * 64 * S, qt * 32, 64, S / dil, dil, lut + hd * 260, false, 0.f,
                        (bf16_t*)(ws + WS_OB) + (size_t)g * S * 256 + hh * 64, 256, (float*)(ws + WS_LSE) + (size_t)g * S * 4 + hh, lane);
        }
    }
}
DEVI void phase_bmerge(const Params& p, int layer) {
    const int tid = threadIdx.x;
    unsigned char* ws = p.ws;
    const bf16_t* OB = (const bf16_t*)(ws + WS_OB);
    const float* LSE = (const float*)(ws + WS_LSE);
    bf16_t* Y = (bf16_t*)(ws + WS_Y);
    const size_t gtid = (size_t)blockIdx.x * NTHREADS + tid, gthreads = (size_t)gridDim.x * NTHREADS;
    for (size_t i = gtid; i < (size_t)S * 32; i += gthreads) {
        const int t = (int)(i >> 5), hh = (int)((i >> 3) & 3), c = (int)(i & 7);
        const float l0 = LSE[(size_t)t * 4 + hh], l1 = LSE[((size_t)S + t) * 4 + hh], l2 = LSE[((size_t)2 * S + t) * 4 + hh];
        const float mx = fmaxf(l0, fmaxf(l1, l2));
        float w0 = __expf(l0 - mx), w1 = __expf(l1 - mx), w2 = __expf(l2 - mx);
        const float inv = 1.f / (w0 + w1 + w2);
        w0 *= inv; w1 *= inv; w2 *= inv;
        const u32x4 a = *(const u32x4*)(OB + (size_t)t * 256 + hh * 64 + c * 8);
        const u32x4 b = *(const u32x4*)(OB + ((size_t)S + t) * 256 + hh * 64 + c * 8);
        const u32x4 d = *(const u32x4*)(OB + ((size_t)2 * S + t) * 256 + hh * 64 + c * 8);
        u32x4 o;
        o.x = pk2(w0 * bflo(a.x) + w1 * bflo(b.x) + w2 * bflo(d.x), w0 * bfhi(a.x) + w1 * bfhi(b.x) + w2 * bfhi(d.x));
        o.y = pk2(w0 * bflo(a.y) + w1 * bflo(b.y) + w2 * bflo(d.y), w0 * bfhi(a.y) + w1 * bfhi(b.y) + w2 * bfhi(d.y));
        o.z = pk2(w0 * bflo(a.z) + w1 * bflo(b.z) + w2 * bflo(d.z), w0 * bfhi(a.z) + w1 * bfhi(b.z) + w2 * bfhi(d.z));
        o.w = pk2(w0 * bflo(a.w) + w1 * bflo(b.w) + w2 * bflo(d.w), w0 * bfhi(a.w) + w1 * bfhi(b.w) + w2 * bfhi(d.w));
        *(u32x4*)(Y + (size_t)t * DM + 256 + hh * 64 + c * 8) = o;
    }
    convert_f32_bf16(p.in[23] + (size_t)layer * 16384 * 1024, (bf16_t*)(ws + WS_PU), (size_t)16384 * 1024, gtid, gthreads);
    convert_f32_bf16(p.in[24] + (size_t)layer * 16384 * 1024, (bf16_t*)(ws + WS_PV), (size_t)16384 * 1024, gtid, gthreads);
}

DEVI void phase_scores(const Params& p, int layer, lchar* lds) {
    const int tid = threadIdx.x, lane = tid & 63, wid = tid >> 6, wm = wid >> 2, wn = wid & 3, r = lane & 31, h = lane >> 5;
    const bf16_t* PQ = (const bf16_t*)(p.ws + WS_PQ);
    const bf16_t* KEYS = (const bf16_t*)(p.ws + WS_KEYS) + (size_t)layer * 16 * 128 * 64;
    float* SC = (float*)(p.ws + WS_SCORES);
    for (int t = blockIdx.x; t < 64 * 16; t += gridDim.x) {
        const int tm = t & 63, hc = t >> 6;
        f32x16 acc[4][1];
        acc_zero<1>(acc);
        gemm_kloop<1>(acc, PQ + (size_t)tm * 256 * DM + hc * 64, DM, KEYS + (size_t)hc * 128 * 64, 64, 64, lds);
#pragma unroll
        for (int mt = 0; mt < 4; ++mt)
#pragma unroll
            for (int rg = 0; rg < 4; ++rg) {
                const int row = tm * 256 + wm * 128 + mt * 32 + r;
                const int col = wn * 32 + 8 * rg + 4 * h;
                *(f32x4*)(SC + (size_t)row * 2048 + hc * 128 + col) = (f32x4){acc[mt][0][4 * rg], acc[mt][0][4 * rg + 1], acc[mt][0][4 * rg + 2], acc[mt][0][4 * rg + 3]};
            }
    }
}
DEVI void phase_route(const Params& p) {
    const int tid = threadIdx.x, lane = tid & 63, wid = tid >> 6;
    const int gw = blockIdx.x * NWAVES + wid, ngw = gridDim.x * NWAVES;
    const float* SC = (const float*)(p.ws + WS_SCORES);
    int* IDX = (int*)(p.ws + WS_IDX);
    float* GATE = (float*)(p.ws + WS_GATE);
    for (int u = gw; u < S * 8; u += ngw) {
        const int t = u >> 3, hd = u & 7;
        const float* sc = SC + (size_t)t * 2048 + hd * 256;
        float tv[2]; int ti[2];
#pragma unroll
        for (int c = 0; c < 2; ++c) {
            float a0 = sc[c * 128 + lane], a1 = sc[c * 128 + 64 + lane];
            float v = -INFINITY; int ix = 0;
            for (int it = 0; it < 16; ++it) {
                const float best = fmaxf(a0, a1);
                const float wm = wave_max(best);
                const unsigned long long mk = __ballot(best == wm);
                const int wl = __ffsll((long long)mk) - 1;
                const int myidx = (a0 >= a1) ? lane : lane + 64;
                const int widx = __shfl(myidx, wl);
                if (lane == wl) { if (a0 >= a1) a0 = -INFINITY; else a1 = -INFINITY; }
                if (lane == it) { v = wm; ix = widx; }
            }
            tv[c] = v; ti[c] = ix;
        }
        float cs[4]; int ci[4];
        const int a = lane >> 2;
        const float va = __shfl(tv[0], a); const int ia = __shfl(ti[0], a);
#pragma unroll
        for (int j = 0; j < 4; ++j) {
            const int b = (lane & 3) * 4 + j;
            cs[j] = va + __shfl(tv[1], b);
            ci[j] = ia * 128 + __shfl(ti[1], b);
        }
        float sv = -INFINITY; int si = 0;
        for (int it = 0; it < 16; ++it) {
            const float best = fmaxf(fmaxf(cs[0], cs[1]), fmaxf(cs[2], cs[3]));
            const float wm = wave_max(best);
            const unsigned long long mk = __ballot(best == wm);
            const int wl = __ffsll((long long)mk) - 1;
            int myidx;
            if (cs[0] == best) myidx = ci[0]; else if (cs[1] == best) myidx = ci[1]; else if (cs[2] == best) myidx = ci[2]; else myidx = ci[3];
            const int widx = __shfl(myidx, wl);
            if (lane == wl) { if (cs[0] == best) cs[0] = -INFINITY; else if (cs[1] == best) cs[1] = -INFINITY; else if (cs[2] == best) cs[2] = -INFINITY; else cs[3] = -INFINITY; }
            if (lane == it) { sv = wm; si = widx; }
        }
        const float top = __shfl(sv, 0);
        const float e = (lane < 16) ? __expf(sv - top) : 0.f;
        const float sum = wave_sum(e);
        if (lane < 16) { IDX[(size_t)t * 128 + hd * 16 + lane] = si; GATE[(size_t)t * 128 + hd * 16 + lane] = e / sum; }
    }
}
DEVI void phase_expert(const Params& p) {
    const int tid = threadIdx.x, lane = tid & 63, wid = tid >> 6;
    const int gw = blockIdx.x * NWAVES + wid, ngw = gridDim.x * NWAVES;
    const bf16_t* HN = (const bf16_t*)(p.ws + WS_HN);
    const bf16_t* PU = (const bf16_t*)(p.ws + WS_PU);
    const bf16_t* PV = (const bf16_t*)(p.ws + WS_PV);
    const int* IDX = (const int*)(p.ws + WS_IDX);
    const float* GATE = (const float*)(p.ws + WS_GATE);
    float* hout = p.out;
    for (int t = gw; t < S; t += ngw) {
        const u32x4 xa = *(const u32x4*)(HN + (size_t)t * DM + 8 * lane), xb = *(const u32x4*)(HN + (size_t)t * DM + 512 + 8 * lane);
        float x[16] = {bflo(xa.x), bfhi(xa.x), bflo(xa.y), bfhi(xa.y), bflo(xa.z), bfhi(xa.z), bflo(xa.w), bfhi(xa.w),
                       bflo(xb.x), bfhi(xb.x), bflo(xb.y), bfhi(xb.y), bflo(xb.z), bfhi(xb.z), bflo(xb.w), bfhi(xb.w)};
        const int e_lo = IDX[(size_t)t * 128 + lane], e_hi = IDX[(size_t)t * 128 + 64 + lane];
        const float g_lo = GATE[(size_t)t * 128 + lane], g_hi = GATE[(size_t)t * 128 + 64 + lane];
        float acc[16];
#pragma unroll
        for (int i = 0; i < 16; ++i) acc[i] = 0.f;
        for (int e0 = 0; e0 < 128; e0 += 4) {
            int ex[4]; float gx[4]; u32x4 ua[4], ub[4];
#pragma unroll
            for (int j = 0; j < 4; ++j) {
                const int e = e0 + j;
                ex[j] = (e0 < 64) ? __shfl(e_lo, e) : __shfl(e_hi, e - 64);
                gx[j] = (e0 < 64) ? __shfl(g_lo, e) : __shfl(g_hi, e - 64);
                ua[j] = *(const u32x4*)(PU + (size_t)ex[j] * DM + 8 * lane);
                ub[j] = *(const u32x4*)(PU + (size_t)ex[j] * DM + 512 + 8 * lane);
            }
            float dt[4];
#pragma unroll
            for (int j = 0; j < 4; ++j) {
                float d = x[0] * bflo(ua[j].x) + x[1] * bfhi(ua[j].x);
                d += x[2] * bflo(ua[j].y) + x[3] * bfhi(ua[j].y);
                d += x[4] * bflo(ua[j].z) + x[5] * bfhi(ua[j].z);
                d += x[6] * bflo(ua[j].w) + x[7] * bfhi(ua[j].w);
                d += x[8] * bflo(ub[j].x) + x[9] * bfhi(ub[j].x);
                d += x[10] * bflo(ub[j].y) + x[11] * bfhi(ub[j].y);
                d += x[12] * bflo(ub[j].z) + x[13] * bfhi(ub[j].z);
                d += x[14] * bflo(ub[j].w) + x[15] * bfhi(ub[j].w);
                dt[j] = d;
            }
#pragma unroll
            for (int j = 0; j < 4; ++j) {
                ua[j] = *(const u32x4*)(PV + (size_t)ex[j] * DM + 8 * lane);
                ub[j] = *(const u32x4*)(PV + (size_t)ex[j] * DM + 512 + 8 * lane);
            }
#pragma unroll
            for (int j = 0; j < 4; ++j) {
                const float d = wave_sum(dt[j]);
                const float a = 0.5f * d * (1.f + erff(d * 0.7071067811865476f)) * gx[j];
                acc[0] += a * bflo(ua[j].x); acc[1] += a * bfhi(ua[j].x); acc[2] += a * bflo(ua[j].y); acc[3] += a * bfhi(ua[j].y);
                acc[4] += a * bflo(ua[j].z); acc[5] += a * bfhi(ua[j].z); acc[6] += a * bflo(ua[j].w); acc[7] += a * bfhi(ua[j].w);
                acc[8] += a * bflo(ub[j].x); acc[9] += a * bfhi(ub[j].x); acc[10] += a * bflo(ub[j].y); acc[11] += a * bfhi(ub[j].y);
                acc[12] += a * bflo(ub[j].z); acc[13] += a * bfhi(ub[j].z); acc[14] += a * bflo(ub[j].w); acc[15] += a * bfhi(ub[j].w);
            }
        }
        float* hr = hout + (size_t)t * DM;
        f32x4 h0 = *(f32x4*)(hr + 8 * lane), h1 = *(f32x4*)(hr + 8 * lane + 4), h2 = *(f32x4*)(hr + 512 + 8 * lane), h3 = *(f32x4*)(hr + 512 + 8 * lane + 4);
        h0 += (f32x4){acc[0], acc[1], acc[2], acc[3]}; h1 += (f32x4){acc[4], acc[5], acc[6], acc[7]};
        h2 += (f32x4){acc[8], acc[9], acc[10], acc[11]}; h3 += (f32x4){acc[12], acc[13], acc[14], acc[15]};
        *(f32x4*)(hr + 8 * lane) = h0; *(f32x4*)(hr + 8 * lane + 4) = h1; *(f32x4*)(hr + 512 + 8 * lane) = h2; *(f32x4*)(hr + 512 + 8 * lane + 4) = h3;
    }
}

constexpr int PH_PER_LAYER = 14, N_PHASES = 1 + NLAYER * PH_PER_LAYER;
template <int ONLY> __global__ void __launch_bounds__(NTHREADS) fwd_kernel(Params p) {
    extern __shared__ __attribute__((aligned(16))) unsigned char lds_raw[];
    lchar* lds = (lchar*)lds_raw;
    unsigned char* ws = p.ws;
    int ph = 0;
#if MULTI_LAUNCH
#define GRIDSYNC() do { } while (0)
#else
#define GRIDSYNC() do { if (ph + 1 < p.ph_hi) cg::this_grid().sync(); } while (0)
#endif
#define PHASE(KS, ...) do { if ((ONLY < 0 || ONLY == (KS)) && p.ph_lo <= ph && ph < p.ph_hi) { __VA_ARGS__; GRIDSYNC(); } ++ph; } while (0)
    PHASE(0, phase_prep(p, lds));
#pragma unroll 1
    for (int layer = 0; layer < NLAYER; ++layer) {
        const float* hin = (layer == 0) ? p.in[0] : p.out;
        PHASE(1, phase_rownorm(hin, p.in[2] + layer * DM, (bf16_t*)(ws + WS_HN)));
        PHASE(2, { EpiInproj e{(bf16_t*)(ws + WS_G), (bf16_t*)(ws + WS_P), p.in[4] + layer * GW};
                gemm_phase<2>((const bf16_t*)(ws + WS_HN), DM, (const bf16_t*)(ws + WS_WIN) + (size_t)layer * INP * DM, DM, DM, 64, INP / 256, e, lds); });
        PHASE(3, phase_post1(p, layer, lds));
        PHASE(4, { EpiBf16 e1{(bf16_t*)(ws + WS_CQRAW), 384};
                gemm_phase<1>((const bf16_t*)(ws + WS_CQN), 256, (const bf16_t*)(ws + WS_WUQ) + (size_t)layer * 384 * 256, 256, 256, 64, 3, e1, lds);
                EpiBf16 e2{(bf16_t*)(ws + WS_CKVRAW), 512};
                gemm_phase<1>((const bf16_t*)(ws + WS_CKVN), 128, (const bf16_t*)(ws + WS_WUKV) + (size_t)layer * 512 * 128, 128, 128, 64, 4, e2, lds); });
        PHASE(5, phase_post2(p, layer, lds));
        PHASE(6, phase_attention(p, layer, lds));
        PHASE(7, phase_bmerge(p, layer));
        PHASE(8, phase_merge((const bf16_t*)(ws + WS_Y), (const bf16_t*)(ws + WS_WBR) + (size_t)layer * 4 * 1024 * 256, (const bf16_t*)(ws + WS_G), (bf16_t*)(ws + WS_MERGED), lds));
        PHASE(9, { EpiResidual e{hin, p.out};
                gemm_phase<2>((const bf16_t*)(ws + WS_MERGED), DM, (const bf16_t*)(ws + WS_WOUT) + (size_t)layer * DM * DM, DM, DM, 64, 4, e, lds); });
        PHASE(10, phase_rownorm(p.out, p.in[20] + layer * DM, (bf16_t*)(ws + WS_HN)));
        PHASE(11, { EpiBf16 e{(bf16_t*)(ws + WS_PQ), DM};
                gemm_phase<2>((const bf16_t*)(ws + WS_HN), DM, (const bf16_t*)(ws + WS_WPQ) + (size_t)layer * DM * DM, DM, DM, 64, 4, e, lds); });
        PHASE(12, phase_scores(p, layer, lds));
        PHASE(13, phase_route(p));
        PHASE(14, phase_expert(p));
    }
#undef PHASE
#undef GRIDSYNC
}

typedef void (*phase_fn)(Params);
#if MULTI_LAUNCH
static phase_fn phase_kernels[15] = {fwd_kernel<0>, fwd_kernel<1>, fwd_kernel<2>, fwd_kernel<3>, fwd_kernel<4>, fwd_kernel<5>, fwd_kernel<6>, fwd_kernel<7>,
                                     fwd_kernel<8>, fwd_kernel<9>, fwd_kernel<10>, fwd_kernel<11>, fwd_kernel<12>, fwd_kernel<13>, fwd_kernel<14>};
#endif
extern "C" void kernel_launch(void* const* d_in, const int* in_sizes, int n_in, void* d_out, int out_size, void* d_ws, size_t ws_size, hipStream_t stream) {
    static int grid = 0;
    if (grid == 0) {
        if (n_in != 25 || ws_size < WS_END) { fprintf(stderr, "kernel_launch: unexpected n_in %d or ws_size %zu\n", n_in, ws_size); grid = -1; return; }
        int dev = 0, cus = 0, per_cu = 0;
        (void)hipGetDevice(&dev);
        (void)hipDeviceGetAttribute(&cus, hipDeviceAttributeMultiprocessorCount, dev);
#if MULTI_LAUNCH
        for (int k = 0; k < 15; ++k) (void)hipFuncSetAttribute((const void*)phase_kernels[k], hipFuncAttributeMaxDynamicSharedMemorySize, LDS_BYTES);
        per_cu = 1;
#else
        (void)hipFuncSetAttribute((const void*)fwd_kernel<-1>, hipFuncAttributeMaxDynamicSharedMemorySize, LDS_BYTES);
        (void)hipOccupancyMaxActiveBlocksPerMultiprocessor(&per_cu, (const void*)fwd_kernel<-1>, NTHREADS, LDS_BYTES);
#endif
        if (per_cu < 1) per_cu = 1;
        grid = cus * 1;
        (void)hipGetLastError();
    }
    if (grid < 0) return;
    Params p{};
    for (int i = 0; i < 25; ++i) p.in[i] = (const float*)d_in[i];
    p.out = (float*)d_out; p.ws = (unsigned char*)d_ws;
#if MULTI_LAUNCH
    for (int ph = 0; ph < N_PHASES; ++ph) {
        p.ph_lo = ph; p.ph_hi = ph + 1;
        const int ks = (ph == 0) ? 0 : 1 + (ph - 1) % PH_PER_LAYER;
        void* args[] = {&p};
        (void)hipLaunchKernel((const void*)phase_kernels[ks], dim3(grid), dim3(NTHREADS), args, LDS_BYTES, stream);
    }
#else
    p.ph_lo = 0; p.ph_hi = N_PHASES;
    void* args[] = {&p};
    hipError_t e = hipLaunchCooperativeKernel((const void*)fwd_kernel<-1>, dim3(grid), dim3(NTHREADS), args, LDS_BYTES, stream);
    if (e != hipSuccess) fprintf(stderr, "cooperative launch failed: %s (grid %d)\n", hipGetErrorString(e), grid);
#endif
}
```

```cpp
#include <hip/hip_runtime.h>
#include <hip/hip_cooperative_groups.h>
#include <stdint.h>
#include <stdio.h>
namespace cg = cooperative_groups;

#ifndef MULTI_LAUNCH
#define MULTI_LAUNCH 0
#endif

#ifndef REPEAT_PHASE
#define REPEAT_PHASE -1
#endif
#ifndef SELFCHECK
#define SELFCHECK 0
#endif
#ifndef ATTN_PROBE
#define ATTN_PROBE 0
#endif
#ifndef EXPERT_FP4
#define EXPERT_FP4 1
#endif
#define DEVI __device__ __forceinline__
#define LAS __attribute__((address_space(3)))
#define SBAR() __builtin_amdgcn_sched_barrier(0)
typedef unsigned short bf16_t;
typedef short bf16x8 __attribute__((ext_vector_type(8)));
typedef short s16x4 __attribute__((ext_vector_type(4)));
typedef float f32x16 __attribute__((ext_vector_type(16)));
typedef float f32x4 __attribute__((ext_vector_type(4)));
typedef float f32x2 __attribute__((ext_vector_type(2)));
typedef unsigned u32x4 __attribute__((ext_vector_type(4)));
typedef unsigned u32x2 __attribute__((ext_vector_type(2)));
typedef LAS char lchar;

constexpr int S = 16384, DM = 1024, NLAYER = 2;
constexpr int INW = 7840, INP = 7936, PW = 3840, GW = 4096, NGATE0 = 3744;
constexpr int O_AQ = 0, O_AK = 256, O_AV = 384, O_BQ = 512, O_BK = 1280, O_BV = 2048, O_CQ = 2816, O_CKV = 3072, O_CKR = 3200,
              O_DQ = 3232, O_DK = 3488, O_DV = 3616;
constexpr float EPS = 1e-6f;
constexpr float LOG2E = 1.4426950408889634f;
constexpr int NTHREADS = 512, NWAVES = 8;
constexpr int LDS_BYTES = 151552;

constexpr size_t MiB = 1u << 20;
constexpr size_t WS_CTL = 0;
constexpr size_t WS_WIN = 1 * MiB;
constexpr size_t WS_WUQ = 32 * MiB;
constexpr size_t WS_WUKV = 32 * MiB + 512 * 1024;
constexpr size_t WS_WBR = 33 * MiB;
constexpr size_t WS_WOUT = 37 * MiB;
constexpr size_t WS_WPQ = 41 * MiB;
constexpr size_t WS_KEYS = 45 * MiB;
constexpr size_t WS_CQN = 46 * MiB;
constexpr size_t WS_CKVN = 54 * MiB;
constexpr size_t WS_HN = 58 * MiB;
constexpr size_t WS_P = 90 * MiB;
constexpr size_t WS_G = 210 * MiB;
constexpr size_t WS_QKV = 338 * MiB;
constexpr size_t WS_END = 474 * MiB;
constexpr size_t WS_CQRAW = WS_P;
constexpr size_t WS_CKVRAW = WS_P + 12 * MiB;
constexpr size_t WS_OB = WS_P + 28 * MiB;
constexpr size_t WS_LSE = WS_P + 52 * MiB;
constexpr size_t WS_Y = WS_P + 53 * MiB;
constexpr size_t WS_MERGED = WS_P + 85 * MiB;
constexpr size_t WS_PQ = WS_P;
constexpr size_t WS_IDX = WS_P + 32 * MiB;
constexpr size_t WS_GATE = WS_P + 40 * MiB;
constexpr size_t WS_SCORES = WS_G;
constexpr size_t Q_QA = 0, Q_KA = 8 * MiB, Q_VAT = 12 * MiB, Q_QB = 16 * MiB, Q_KB = 40 * MiB, Q_VBT = 64 * MiB, Q_QC = 88 * MiB,
                 Q_KC = 100 * MiB, Q_VCT = 112 * MiB, Q_QD = 120 * MiB, Q_KD = 128 * MiB, Q_VDT = 132 * MiB;
constexpr size_t WS_PU = WS_QKV, WS_PV = WS_QKV + 16 * MiB;
constexpr size_t WS_US = WS_QKV + 32 * MiB, WS_VS = WS_QKV + 32 * MiB + 65536;

struct Params {
    const float* in[25];
    float* out;
    unsigned char* ws;
    int ph_lo, ph_hi;
};

DEVI unsigned pk2(float lo, float hi) {
    typedef __bf16 bf2 __attribute__((ext_vector_type(2)));
    f32x2 v = {lo, hi};
    bf2 b = __builtin_convertvector(v, bf2);
    return __builtin_bit_cast(unsigned, b);
}
DEVI unsigned short f2bf(float f) { return (unsigned short)(pk2(f, 0.f) & 0xffffu); }
DEVI float bf2f(unsigned short b) { return __uint_as_float(((unsigned)b) << 16); }
DEVI float bflo(unsigned w) { return __uint_as_float(w << 16); }
DEVI float bfhi(unsigned w) { return __uint_as_float(w & 0xffff0000u); }
template <int CTRL> DEVI float dppf(float v) { return __uint_as_float((unsigned)__builtin_amdgcn_update_dpp(0, (int)__float_as_uint(v), CTRL, 0xF, 0xF, false)); }
DEVI float swz_xor16(float v) { return __uint_as_float((unsigned)__builtin_amdgcn_ds_swizzle((int)__float_as_uint(v), 0x401F)); }
DEVI float swz_xor4(float v) { return __uint_as_float((unsigned)__builtin_amdgcn_ds_swizzle((int)__float_as_uint(v), 0x101F)); }
DEVI float wave_sum(float v) {
    v += dppf<0xB1>(v);
    v += dppf<0x4E>(v);
    v += dppf<0x141>(v);
    v += dppf<0x140>(v);
    v += swz_xor16(v);
    auto rr = __builtin_amdgcn_permlane32_swap(__float_as_uint(v), __float_as_uint(v), false, false);
    return __uint_as_float(rr[0]) + __uint_as_float(rr[1]);
}
DEVI float wave_max(float v) {
    v = fmaxf(v, dppf<0xB1>(v)); v = fmaxf(v, dppf<0x4E>(v)); v = fmaxf(v, dppf<0x141>(v)); v = fmaxf(v, dppf<0x140>(v));
    v = fmaxf(v, swz_xor16(v));
    auto rr = __builtin_amdgcn_permlane32_swap(__float_as_uint(v), __float_as_uint(v), false, false);
    return fmaxf(__uint_as_float(rr[0]), __uint_as_float(rr[1]));
}
DEVI float half_max(float v) { auto rr = __builtin_amdgcn_permlane32_swap(__float_as_uint(v), __float_as_uint(v), false, false); return fmaxf(__uint_as_float(rr[0]), __uint_as_float(rr[1])); }
DEVI float half_sum(float v) { auto rr = __builtin_amdgcn_permlane32_swap(__float_as_uint(v), __float_as_uint(v), false, false); return __uint_as_float(rr[0]) + __uint_as_float(rr[1]); }
DEVI int bperm(int v, int src_lane) { return __builtin_amdgcn_ds_bpermute(src_lane << 2, v); }
DEVI float bpermf(float v, int src_lane) { return __uint_as_float((unsigned)__builtin_amdgcn_ds_bpermute(src_lane << 2, (int)__float_as_uint(v))); }
constexpr unsigned WTAB_OFF = LDS_BYTES - 16 - 64;
DEVI int owave() { const unsigned key = (unsigned)__builtin_amdgcn_s_getreg((5 << 11) | 4) & 63u;
    return __builtin_amdgcn_readfirstlane((int)((volatile LAS unsigned char*)(WTAB_OFF))[key]); }
DEVI int olane() { unsigned z = 0u; asm volatile("" : "+v"(z)); return (int)__builtin_amdgcn_mbcnt_hi(~0u, __builtin_amdgcn_mbcnt_lo(~0u, z)); }
DEVI int otid() { return owave() * 64 + olane(); }
DEVI int ogrid() { int g = gridDim.x; asm volatile("" : "+v"(g)); return __builtin_amdgcn_readfirstlane(g); }
DEVI int obid() { int b = blockIdx.x; asm volatile("" : "+v"(b)); return __builtin_amdgcn_readfirstlane(b); }
DEVI int crow(int reg, int h) { return (reg & 3) + 8 * (reg >> 2) + 4 * h; }
DEVI float fast_exp2(float x) { return __builtin_amdgcn_exp2f(x); }

DEVI void transpose_item(const float* W, int ldn, int K, bf16_t* WT, int k0, int n0, int drow0, LAS float* scr, int lane) {
    float wv[32];
#pragma unroll
    for (int i = 0; i < 32; ++i) wv[i] = W[(size_t)(k0 + 2 * i + (lane >> 5)) * ldn + n0 + (lane & 31)];
#pragma unroll
    for (int i = 0; i < 32; ++i) scr[(2 * i + (lane >> 5)) * 33 + (lane & 31)] = wv[i];
    asm volatile("s_waitcnt lgkmcnt(0)" ::: "memory");
    const int c = lane & 7;
#pragma unroll
    for (int j = 0; j < 4; ++j) {
        const int n = (lane >> 3) + 8 * j;
        const LAS float* s = scr + (8 * c) * 33 + n;
        u32x4 o;
        o.x = pk2(s[0 * 33], s[1 * 33]); o.y = pk2(s[2 * 33], s[3 * 33]); o.z = pk2(s[4 * 33], s[5 * 33]); o.w = pk2(s[6 * 33], s[7 * 33]);
        *(u32x4*)(WT + (size_t)(drow0 + n) * K + k0 + 8 * c) = o;
    }
    asm volatile("s_waitcnt lgkmcnt(0)" ::: "memory");
}
DEVI void transpose_matrix(const float* W, int K, int N, bf16_t* WT, bool remap, LAS float* scr, int gw, int ngw, int lane) {
    const int nblk = N / 32, items = (K / 64) * nblk;
    for (int it = gw; it < items; it += ngw) {
        const int kb = it / nblk, nb = it % nblk, n0 = 32 * nb;
        int drow0 = n0;
        if (remap) drow0 = (n0 >= NGATE0) ? (n0 - NGATE0) : (n0 + GW);
        transpose_item(W, N, K, WT, 64 * kb, n0, drow0, scr, lane);
    }
}
DEVI void convert_f32_bf16(const float* src, bf16_t* dst, size_t n, size_t gtid, size_t gthreads) {
    for (size_t i = gtid * 4; i < n; i += gthreads * 4) {
        const f32x4 v = *(const f32x4*)(src + i);
        u32x2 o; o.x = pk2(v.x, v.y); o.y = pk2(v.z, v.w);
        *(u32x2*)(dst + i) = o;
    }
}
DEVI void phase_prep(const Params& p, lchar* lds) {
    const int tid = otid(), lane = tid & 63, wid = tid >> 6;
#if SELFCHECK && MULTI_LAUNCH
    if (obid() == 0 && tid < 8) ((unsigned*)(p.ws + WS_CTL))[3900 + tid] = 0u;
#endif
    const int gw = obid() * NWAVES + wid, ngw = ogrid() * NWAVES;
    LAS float* scr = (LAS float*)(lds + wid * 8704);
    unsigned char* ws = p.ws;
    for (int l = 0; l < NLAYER; ++l) {
        bf16_t* win = (bf16_t*)(ws + WS_WIN) + (size_t)l * INP * DM;
        transpose_matrix(p.in[3] + (size_t)l * DM * INW, DM, INW, win, true, scr, gw, ngw, lane);
        for (int i = gw * 64 + lane; i < (INP - INW) * DM / 8; i += ngw * 64) *(u32x4*)(win + (size_t)INW * DM + (size_t)i * 8) = (u32x4){0u, 0u, 0u, 0u};
        transpose_matrix(p.in[12] + (size_t)l * 256 * 384, 256, 384, (bf16_t*)(ws + WS_WUQ) + (size_t)l * 384 * 256, false, scr, gw, ngw, lane);
        transpose_matrix(p.in[13] + (size_t)l * 128 * 512, 128, 512, (bf16_t*)(ws + WS_WUKV) + (size_t)l * 512 * 128, false, scr, gw, ngw, lane);
        for (int n = 0; n < 4; ++n)
            transpose_matrix(p.in[18] + ((size_t)l * 4 + n) * 256 * 1024, 256, 1024, (bf16_t*)(ws + WS_WBR) + ((size_t)l * 4 + n) * 1024 * 256, false, scr, gw, ngw, lane);
        transpose_matrix(p.in[19] + (size_t)l * DM * DM, DM, DM, (bf16_t*)(ws + WS_WOUT) + (size_t)l * DM * DM, false, scr, gw, ngw, lane);
        transpose_matrix(p.in[21] + (size_t)l * DM * DM, DM, DM, (bf16_t*)(ws + WS_WPQ) + (size_t)l * DM * DM, false, scr, gw, ngw, lane);
    }
    convert_f32_bf16(p.in[22], (bf16_t*)(ws + WS_KEYS), (size_t)NLAYER * 16 * 128 * 64, (size_t)obid() * NTHREADS + tid, (size_t)ogrid() * NTHREADS);
}

DEVI void phase_rownorm(const float* h, const float* gain, bf16_t* hn) {
    const int tid = otid(), lane = tid & 63, wid = tid >> 6;
    const int gw = obid() * NWAVES + wid, ngw = ogrid() * NWAVES;
    f32x4 g[4];
#pragma unroll
    for (int j = 0; j < 4; ++j) g[j] = *(const f32x4*)(gain + 4 * lane + 256 * j);
    for (int row = gw; row < S; row += ngw) {
        const float* xr = h + (size_t)row * DM;
        f32x4 v[4]; float ss = 0.f;
#pragma unroll
        for (int j = 0; j < 4; ++j) { v[j] = *(const f32x4*)(xr + 4 * lane + 256 * j); ss += (v[j].x * v[j].x + v[j].y * v[j].y) + (v[j].z * v[j].z + v[j].w * v[j].w); }
        const float rstd = rsqrtf(wave_sum(ss) * (1.f / DM) + EPS);
        bf16_t* orow = hn + (size_t)row * DM;
#pragma unroll
        for (int j = 0; j < 4; ++j) {
            u32x2 o; o.x = pk2(v[j].x * rstd * g[j].x, v[j].y * rstd * g[j].y); o.y = pk2(v[j].z * rstd * g[j].z, v[j].w * rstd * g[j].w);
            *(u32x2*)(orow + 4 * lane + 256 * j) = o;
        }
    }
}

constexpr int GROW = 144;
template <int NT>
DEVI void gemm_kloop(f32x16 (&acc)[4][NT], const bf16_t* A, int lda, const bf16_t* B, int ldb, int K, lchar* lds) {
    const int tid = otid(), lane = tid & 63, wid = tid >> 6, wm = wid >> 2, wn = wid & 3, r = lane & 31, h = lane >> 5;
    constexpr int NGB = 2 * NT;
    constexpr int ASZ = 256 * 128, STG = ASZ + 128 * NT * 128;
    const int rr = lane >> 3, pp = lane & 7;
    const int skey = ((wid & 1) << 2) | (rr >> 1);
    const bf16_t* ap = A + (size_t)(wid * 8 + rr) * lda + ((pp ^ skey) << 3);
    const bf16_t* bp = B + (size_t)(wid * 8 + rr) * ldb + ((pp ^ skey) << 3);
    const int nk = K / 64;
#define G_DMA(kt, st) do { lchar* as_ = lds + (st) * STG + wid * 1024; lchar* bs_ = as_ + ASZ; \
        _Pragma("unroll") for (int i = 0; i < 4; ++i) __builtin_amdgcn_global_load_lds((const unsigned*)(ap + (size_t)(64 * i) * lda + (kt) * 64), (LAS unsigned*)(as_ + i * 8192), 16, 0, 0); \
        _Pragma("unroll") for (int i = 0; i < NGB; ++i) __builtin_amdgcn_global_load_lds((const unsigned*)(bp + (size_t)(64 * i) * ldb + (kt) * 64), (LAS unsigned*)(bs_ + i * 8192), 16, 0, 0); } while (0)
    __syncthreads();
    G_DMA(0, 0);
    __syncthreads();
    const int xa = (wm * 128 + r) * 128, xb = (wn * 32 * NT + r) * 128, sw = (r >> 1) & 7;
    for (int kt = 0; kt < nk; ++kt) {
        if (kt + 1 < nk) G_DMA(kt + 1, (kt + 1) & 1);
        const lchar* As = lds + (kt & 1) * STG; const lchar* Bs = As + ASZ;
        bf16x8 xf[2][4], wf[2][NT];
#define F_LOAD(ks, S_) do { const int co_ = ((2 * (ks) + h) ^ sw) << 4; \
            _Pragma("unroll") for (int mt = 0; mt < 4; ++mt) xf[S_][mt] = *(const LAS bf16x8*)(As + xa + mt * 32 * 128 + co_); \
            _Pragma("unroll") for (int nt = 0; nt < NT; ++nt) wf[S_][nt] = *(const LAS bf16x8*)(Bs + xb + nt * 32 * 128 + co_); } while (0)
#define F_MMA(S_) do { _Pragma("unroll") for (int mt = 0; mt < 4; ++mt) _Pragma("unroll") for (int nt = 0; nt < NT; ++nt) \
            acc[mt][nt] = __builtin_amdgcn_mfma_f32_32x32x16_bf16(wf[S_][nt], xf[S_][mt], acc[mt][nt], 0, 0, 0); } while (0)
        F_LOAD(0, 0);
        __builtin_amdgcn_sched_barrier(0);
        F_LOAD(1, 1);
        __builtin_amdgcn_sched_barrier(0);
        F_MMA(0);
        __builtin_amdgcn_sched_barrier(0);
        F_LOAD(2, 0);
        __builtin_amdgcn_sched_barrier(0);
        F_MMA(1);
        __builtin_amdgcn_sched_barrier(0);
        F_LOAD(3, 1);
        __builtin_amdgcn_sched_barrier(0);
        F_MMA(0);
        __builtin_amdgcn_sched_barrier(0);
        F_MMA(1);
#undef F_LOAD
#undef F_MMA
        __syncthreads();
    }
#undef G_DMA
}
template <int NT> DEVI void acc_zero(f32x16 (&acc)[4][NT]) {
#pragma unroll
    for (int mt = 0; mt < 4; ++mt)
#pragma unroll
        for (int nt = 0; nt < NT; ++nt)
#pragma unroll
            for (int i = 0; i < 16; ++i) acc[mt][nt][i] = 0.f;
}
template <int NT, class Epi>
DEVI void gemm_phase(const bf16_t* A, int lda, const bf16_t* Bt, int ldb, int K, int tiles_m, int tiles_n, const Epi& epi, lchar* lds) {
    const int tid = otid(), lane = tid & 63, wid = tid >> 6, wm = wid >> 2, wn = wid & 3, r = lane & 31, h = lane >> 5;
    constexpr int BN = 128 * NT;
    for (int t = obid(); t < tiles_m * tiles_n; t += ogrid()) {
        const int tm = t % tiles_m, tn = t / tiles_m;
        f32x16 acc[4][NT];
        acc_zero<NT>(acc);
        gemm_kloop<NT>(acc, A + (size_t)tm * 256 * lda, lda, Bt + (size_t)tn * BN * ldb, ldb, K, lds);
#pragma unroll
        for (int mt = 0; mt < 4; ++mt)
#pragma unroll
            for (int nt = 0; nt < NT; ++nt)
#pragma unroll
                for (int rg = 0; rg < 4; ++rg) {
                    const int row = tm * 256 + wm * 128 + mt * 32 + r;
                    const int col = tn * BN + wn * 32 * NT + nt * 32 + 8 * rg + 4 * h;
                    epi(row, col, (f32x4){acc[mt][nt][4 * rg], acc[mt][nt][4 * rg + 1], acc[mt][nt][4 * rg + 2], acc[mt][nt][4 * rg + 3]});
                }
    }
}
struct EpiInproj {
    bf16_t* G; bf16_t* P; const float* gbias;
    DEVI void operator()(int row, int col, f32x4 v) const {
        if (col < GW) {
            const f32x4 b = *(const f32x4*)(gbias + col);
            f32x4 s;
            s.x = __builtin_amdgcn_rcpf(1.f + fast_exp2(-LOG2E * (v.x + b.x))); s.y = __builtin_amdgcn_rcpf(1.f + fast_exp2(-LOG2E * (v.y + b.y)));
            s.z = __builtin_amdgcn_rcpf(1.f + fast_exp2(-LOG2E * (v.z + b.z))); s.w = __builtin_amdgcn_rcpf(1.f + fast_exp2(-LOG2E * (v.w + b.w)));
            u32x2 o; o.x = pk2(s.x, s.y); o.y = pk2(s.z, s.w);
            *(u32x2*)(G + (size_t)row * GW + col) = o;
        } else {
            u32x2 o; o.x = pk2(v.x, v.y); o.y = pk2(v.z, v.w);
            *(u32x2*)(P + (size_t)row * PW + (col - GW)) = o;
        }
    }
};
struct EpiInproj8 {
    bf16_t* G; bf16_t* P; const float* gbias;
    DEVI void operator()(int row, int col, f32x4 v0, f32x4 v1) const {
        u32x4 o;
        if (col < GW) {
            const f32x4 b0 = *(const f32x4*)(gbias + col), b1 = *(const f32x4*)(gbias + col + 4);
            f32x4 s0, s1;
            s0.x = __builtin_amdgcn_rcpf(1.f + fast_exp2(-LOG2E * (v0.x + b0.x))); s0.y = __builtin_amdgcn_rcpf(1.f + fast_exp2(-LOG2E * (v0.y + b0.y)));
            s0.z = __builtin_amdgcn_rcpf(1.f + fast_exp2(-LOG2E * (v0.z + b0.z))); s0.w = __builtin_amdgcn_rcpf(1.f + fast_exp2(-LOG2E * (v0.w + b0.w)));
            s1.x = __builtin_amdgcn_rcpf(1.f + fast_exp2(-LOG2E * (v1.x + b1.x))); s1.y = __builtin_amdgcn_rcpf(1.f + fast_exp2(-LOG2E * (v1.y + b1.y)));
            s1.z = __builtin_amdgcn_rcpf(1.f + fast_exp2(-LOG2E * (v1.z + b1.z))); s1.w = __builtin_amdgcn_rcpf(1.f + fast_exp2(-LOG2E * (v1.w + b1.w)));
            int w0 = __builtin_amdgcn_cvt_pk_fp8_f32(s0.x, s0.y, 0, false); w0 = __builtin_amdgcn_cvt_pk_fp8_f32(s0.z, s0.w, w0, true);
            int w1 = __builtin_amdgcn_cvt_pk_fp8_f32(s1.x, s1.y, 0, false); w1 = __builtin_amdgcn_cvt_pk_fp8_f32(s1.z, s1.w, w1, true);
            *(u32x2*)((unsigned char*)G + (size_t)row * GW + col) = (u32x2){(unsigned)w0, (unsigned)w1};
        } else {
            o.x = pk2(v0.x, v0.y); o.y = pk2(v0.z, v0.w); o.z = pk2(v1.x, v1.y); o.w = pk2(v1.z, v1.w);
            *(u32x4*)(P + (size_t)row * PW + (col - GW)) = o;
        }
    }
};
struct EpiBf16 {
    bf16_t* C; int ldc;
    DEVI void operator()(int row, int col, f32x4 v) const {
        u32x2 o; o.x = pk2(v.x, v.y); o.y = pk2(v.z, v.w);
        *(u32x2*)(C + (size_t)row * ldc + col) = o;
    }
};
struct EpiResidual {
    const float* hin; float* hout;
    DEVI void operator()(int row, int col, f32x4 v) const {
        const f32x4 b = *(const f32x4*)(hin + (size_t)row * DM + col);
        *(f32x4*)(hout + (size_t)row * DM + col) = b + v;
    }
};
struct EpiF32 {
    float* C; int ldc;
    DEVI void operator()(int row, int col, f32x4 v) const { *(f32x4*)(C + (size_t)row * ldc + col) = v; }
};

DEVI void phase_merge(const bf16_t* Y, const bf16_t* Wbr  , const bf16_t* G, bf16_t* merged, lchar* lds) {
    const int tid = otid(), lane = tid & 63, wid = tid >> 6, wm = wid >> 2, wn = wid & 3, r = lane & 31, h = lane >> 5;
    constexpr int ASZ = 256 * 128, STG = ASZ + 128 * 128;
    static_assert(3 * STG <= LDS_BYTES - 96, "merge ring");
    const int rr = lane >> 3, pp = lane & 7;
    const int skey = ((wid & 1) << 2) | (rr >> 1);
    const int lrow = wid * 8 + rr, lcol = (pp ^ skey) << 3;
    const int bid = obid(), gsz = ogrid();
    const int ntile = (512 - bid + gsz - 1) / gsz, nit = ntile * 16;
    const int xa = (wm * 128 + r) * 128, xb = (wn * 32 + r) * 128, sw = (r >> 1) & 7;
#define M_DMA(q_, st_) do { const int qq_ = (q_) < nit ? (q_) : nit - 1; const int t_ = bid + (qq_ >> 4) * gsz, kt_ = qq_ & 15; \
        const bf16_t* ap_ = Y + ((size_t)(t_ & 63) * 256 + lrow) * DM + kt_ * 64 + lcol; \
        const bf16_t* bp_ = Wbr + ((size_t)(kt_ >> 2) * 1024 + (t_ >> 6) * 128 + lrow) * 256 + (kt_ & 3) * 64 + lcol; \
        lchar* as_ = lds + (st_) * STG + wid * 1024; \
        _Pragma("unroll") for (int i = 0; i < 4; ++i) __builtin_amdgcn_global_load_lds((const unsigned*)(ap_ + (size_t)(64 * i) * DM), (LAS unsigned*)(as_ + i * 8192), 16, 0, 0); \
        _Pragma("unroll") for (int i = 0; i < 2; ++i) __builtin_amdgcn_global_load_lds((const unsigned*)(bp_ + (size_t)(64 * i) * 256), (LAS unsigned*)(as_ + ASZ + i * 8192), 16, 0, 0); } while (0)
    __syncthreads();
    M_DMA(0, 0); M_DMA(1, 1);
    asm volatile("s_waitcnt vmcnt(6)" ::: "memory");
    __builtin_amdgcn_s_barrier();
    SBAR();
    int st = 0;
    f32x16 macc[4], acc[4];
#pragma unroll 1
    for (int qb = 0; qb < nit; qb += 4) {
        const int t = bid + (qb >> 4) * gsz, tm = t & 63, tn = t >> 6, br = (qb >> 2) & 3;
        if (br == 0) {
#pragma unroll
            for (int mt = 0; mt < 4; ++mt)
#pragma unroll
                for (int i = 0; i < 16; ++i) macc[mt][i] = 0.f;
        }
#pragma unroll
        for (int mt = 0; mt < 4; ++mt)
#pragma unroll
            for (int i = 0; i < 16; ++i) acc[mt][i] = 0.f;
        unsigned gq[4][4];
#pragma unroll
        for (int kq = 0; kq < 4; ++kq) {
            const int sn = (st == 0) ? 2 : st - 1;
            M_DMA(qb + kq + 2, sn);
            SBAR();
            if (kq == 0) {
                const unsigned char* gp = (const unsigned char*)G + ((size_t)tm * 256 + wm * 128 + r) * GW + br * 1024 + tn * 128 + wn * 32 + 4 * h;
#pragma unroll
                for (int mt = 0; mt < 4; ++mt)
#pragma unroll
                    for (int rg = 0; rg < 4; ++rg) gq[mt][rg] = *(const unsigned*)(gp + (size_t)mt * 32 * GW + 8 * rg);
                SBAR();
            }
            const lchar* As = lds + st * STG; const lchar* Bs = As + ASZ;
            bf16x8 xf[2][4], wf[2];
#define F_LOAD(ks, S_) do { const int co_ = ((2 * (ks) + h) ^ sw) << 4; \
            _Pragma("unroll") for (int mt = 0; mt < 4; ++mt) xf[S_][mt] = *(const LAS bf16x8*)(As + xa + mt * 32 * 128 + co_); \
            wf[S_] = *(const LAS bf16x8*)(Bs + xb + co_); } while (0)
#define F_MMA(S_) do { _Pragma("unroll") for (int mt = 0; mt < 4; ++mt) acc[mt] = __builtin_amdgcn_mfma_f32_32x32x16_bf16(wf[S_], xf[S_][mt], acc[mt], 0, 0, 0); } while (0)
            F_LOAD(0, 0); SBAR();
            F_LOAD(1, 1); SBAR();
            F_MMA(0); SBAR();
            F_LOAD(2, 0); SBAR();
            F_MMA(1); SBAR();
            F_LOAD(3, 1); SBAR();
            F_MMA(0); SBAR();
            F_MMA(1); SBAR();
#undef F_LOAD
#undef F_MMA
            if (kq == 3) {
#pragma unroll
                for (int mt = 0; mt < 4; ++mt)
#pragma unroll
                    for (int rg = 0; rg < 4; ++rg) {
                        const f32x2 g01 = __builtin_amdgcn_cvt_pk_f32_fp8((int)gq[mt][rg], false), g23 = __builtin_amdgcn_cvt_pk_f32_fp8((int)gq[mt][rg], true);
                        macc[mt][4 * rg + 0] += g01.x * acc[mt][4 * rg + 0];
                        macc[mt][4 * rg + 1] += g01.y * acc[mt][4 * rg + 1];
                        macc[mt][4 * rg + 2] += g23.x * acc[mt][4 * rg + 2];
                        macc[mt][4 * rg + 3] += g23.y * acc[mt][4 * rg + 3];
                    }
            }
            if (kq == 0) asm volatile("s_waitcnt vmcnt(22)" ::: "memory"); else asm volatile("s_waitcnt vmcnt(6)" ::: "memory");
            __builtin_amdgcn_s_barrier();
            SBAR();
            st = (st == 2) ? 0 : st + 1;
        }
        if (br == 3) {
#pragma unroll
            for (int mt = 0; mt < 4; ++mt)
#pragma unroll
                for (int rg = 0; rg < 4; ++rg) {
                    const int row = tm * 256 + wm * 128 + mt * 32 + r;
                    const int col = tn * 128 + wn * 32 + 8 * rg + 4 * h;
                    u32x2 o; o.x = pk2(macc[mt][4 * rg], macc[mt][4 * rg + 1]); o.y = pk2(macc[mt][4 * rg + 2], macc[mt][4 * rg + 3]);
                    *(u32x2*)(merged + (size_t)row * DM + col) = o;
                }
        }
    }
#undef M_DMA
    asm volatile("s_waitcnt vmcnt(0)" ::: "memory");
}

namespace pg8 {
#define PG8_LAS __attribute__((address_space(3)))
typedef unsigned short bf16_t;
typedef short bf16x8 __attribute__((ext_vector_type(8)));
typedef float f32x4 __attribute__((ext_vector_type(4)));
typedef unsigned u32x4 __attribute__((ext_vector_type(4)));
constexpr int BM = 256, BK = 64, HALF = 128, HTB = HALF * BK * 2  , STAGE_BYTES = 8 * HTB, NXCD = 8, WGM = 8;

__host__ __device__ __forceinline__ int lds_byte(int r, int c) { const int st = (r >> 4) * 2 + (c >> 5), rr = r & 15, cc = c & 31, ob = rr * 64 + cc * 2; return st * 1024 + (ob ^ (((ob >> 9) & 1) << 5)); }
__host__ __device__ __forceinline__ void stage_rc(int b, int& R, int& C) { const int st = b / 1024, sb = b % 1024, swz = sb ^ (((sb >> 9) & 1) << 5); R = (st >> 1) * 16 + swz / 64; C = (st & 1) * 32 + (swz % 64) / 2; }
__host__ __device__ __forceinline__ int perm32(int rho) { const int n = rho >> 4, i = rho & 15; return 8 * (i >> 2) + 4 * n + (i & 3); }

struct Unit { int pm, pn; };
struct Gemm { const bf16_t* A; const bf16_t* Bt; int M, N, K; };

struct StaticOrder {
    int nM, nN, nwg, G, c;
    __host__ __device__ void init(int M, int N, int G_, int c_) { nM = M / BM; nN = N / BM; nwg = nM * nN; G = G_; c = c_; }
    __host__ __device__ bool next(int i, Unit& u) const {
        const long L = (long)i * G + c; if (L >= nwg) return false;
        int wgid = (int)L; { const int q = nwg / NXCD, r = nwg % NXCD, xcd = wgid % NXCD, off = wgid / NXCD; wgid = (xcd < r ? xcd * (q + 1) : r * (q + 1) + (xcd - r) * q) + off; }
        const int nig = WGM * nN, gid = wgid / nig, fm = gid * WGM, gsz = (nM - fm) < WGM ? (nM - fm) : WGM;
        u.pm = fm + ((wgid % nig) % gsz); u.pn = (wgid % nig) / gsz; return true;
    }
    __device__ __forceinline__ void a_ready(const Unit&) const {}
    __device__ __forceinline__ void done(const Unit&) const {}
};

template <class Epi, class Sched, bool ALIGN_EPI = false, bool SP2 = false>
__device__ __forceinline__ void gemm_phase(PG8_LAS unsigned char* lds, const Gemm g, const Sched& S, const Epi& E) {
    const int tid = otid(), wid = __builtin_amdgcn_readfirstlane(tid >> 6), lane = tid & 63, wr = wid >> 2, wc = wid & 3, fr = lane & 15, fq = lane >> 4;
    const int K = g.K, nt = K / BK;
    unsigned voffA[2], voffB[2];
#pragma unroll
    for (int i = 0; i < 2; ++i) { int R, C; stage_rc(tid * 16 + i * 8192, R, C); const int Rb = Epi::PERM ? ((R & ~31) + perm32(R & 31)) : R;
        voffA[i] = (unsigned)(R * K + C) * 2u; voffB[i] = (unsigned)(Rb * K + C) * 2u; }
    const size_t kstep = (size_t)(BK * 2);
    const size_t hstep = (size_t)HALF * K * 2;
    const size_t tstep = 2 * hstep;
    const unsigned ldsw = (unsigned)wid * 1024u;
    const int aoff = lds_byte(wr * 64 + fr, fq * 8), boff = lds_byte(wc * 32 + fr, fq * 8);
#define PG8_SA(b, h) (((b) * 2 + (h)) * HTB)
#define PG8_SB(b, h) ((4 + (b) * 2 + (h)) * HTB)
#define PG8_STAGE(bufoff, gbase, voff) do { _Pragma("unroll") for (int _i = 0; _i < 2; ++_i) \
        __builtin_amdgcn_global_load_lds((const unsigned*)((const char*)(gbase) + (voff)[_i]), (PG8_LAS unsigned*)(lds + (bufoff) + ldsw + _i * 8192), 16, 0, 0); } while (0)
#define PG8_LDA(dst, b, h) do { _Pragma("unroll") for (int m = 0; m < 4; ++m) _Pragma("unroll") for (int k = 0; k < 2; ++k) dst[m][k] = *(const PG8_LAS bf16x8*)(lds + PG8_SA(b, h) + aoff + m * 2048 + k * 1024); } while (0)
#define PG8_LDB(dst, b, h) do { _Pragma("unroll") for (int n = 0; n < 2; ++n) _Pragma("unroll") for (int k = 0; k < 2; ++k) dst[n][k] = *(const PG8_LAS bf16x8*)(lds + PG8_SB(b, h) + boff + n * 2048 + k * 1024); } while (0)
#define PG8_MMA(ai, bj, At, Bt) do { __builtin_amdgcn_s_setprio(1); _Pragma("unroll") for (int m = 0; m < 4; ++m) _Pragma("unroll") for (int n = 0; n < 2; ++n) _Pragma("unroll") for (int k = 0; k < 2; ++k) \
        acc[ai][bj][m][n] = __builtin_amdgcn_mfma_f32_16x16x32_bf16(Bt[n][k], At[m][k], acc[ai][bj][m][n], 0, 0, 0); __builtin_amdgcn_s_setprio(0); } while (0)
#define PG8_WAIT_V(n) asm volatile("s_waitcnt vmcnt(" #n ")" ::: "memory")
#define PG8_WAIT_L(n) asm volatile("s_waitcnt lgkmcnt(" #n ")" ::: "memory")
#define PG8_BAR __builtin_amdgcn_s_barrier()
#define PG8_SCHED __builtin_amdgcn_sched_barrier(0)
    Unit cur, nxt; int ui = 0;
    if (!S.next(0, cur)) return;
    f32x4 acc[2][2][4][2];
#pragma unroll
    for (int a = 0; a < 2; ++a)
#pragma unroll
        for (int b = 0; b < 2; ++b)
#pragma unroll
            for (int m = 0; m < 4; ++m)
#pragma unroll
                for (int n = 0; n < 2; ++n) acc[a][b][m][n] = (f32x4){0.f, 0.f, 0.f, 0.f};
    bf16x8 At[4][2], B0[2][2], B1[2][2];
    const char* cA = (const char*)g.A + (size_t)cur.pm * tstep; const char* cB = (const char*)g.Bt + (size_t)cur.pn * tstep;
    S.a_ready(cur);
    if constexpr (SP2) {
        PG8_STAGE(PG8_SB(0, 0), cB, voffB); PG8_STAGE(PG8_SB(0, 1), cB + hstep, voffB); PG8_STAGE(PG8_SA(0, 0), cA, voffA); PG8_STAGE(PG8_SA(0, 1), cA + hstep, voffA);
        if (wr == 1) PG8_BAR;
        PG8_WAIT_V(2); PG8_BAR;
        PG8_STAGE(PG8_SB(1, 0), cB + kstep, voffB); PG8_STAGE(PG8_SA(1, 0), cA + kstep, voffA); PG8_STAGE(PG8_SB(1, 1), cB + hstep + kstep, voffB);
        PG8_WAIT_V(6); PG8_BAR;
    } else {
        PG8_STAGE(PG8_SB(0, 0), cB, voffB); PG8_STAGE(PG8_SA(0, 0), cA, voffA); PG8_STAGE(PG8_SB(0, 1), cB + hstep, voffB); PG8_STAGE(PG8_SA(0, 1), cA + hstep, voffA);
        if (wr == 1) PG8_BAR;
        PG8_WAIT_V(4); PG8_BAR;
        PG8_STAGE(PG8_SB(1, 0), cB + kstep, voffB); PG8_STAGE(PG8_SA(1, 0), cA + kstep, voffA); PG8_STAGE(PG8_SB(1, 1), cB + hstep + kstep, voffB);
        PG8_WAIT_V(6); PG8_BAR;
    }
    for (;;) {
        const bool has_next = S.next(ui + 1, nxt);
        const char* nA = has_next ? (const char*)g.A + (size_t)nxt.pm * tstep : cA; const char* nB = has_next ? (const char*)g.Bt + (size_t)nxt.pn * tstep : cB;
        for (int t = 0; t < nt; t += 2) {
            const bool last = (t == nt - 2);
            const char* a1 = cA + (size_t)(t + 1) * kstep;
            const char* a2 = last ? nA : cA + (size_t)(t + 2) * kstep; const char* b2 = last ? nB : cB + (size_t)(t + 2) * kstep;
            const char* a3 = a2 + kstep; const char* b3 = b2 + kstep;
            if (last && has_next) S.a_ready(nxt);
            if constexpr (SP2) {
            PG8_LDB(B0, 0, 0); PG8_LDB(B1, 0, 1); PG8_SCHED; PG8_LDA(At, 0, 0); PG8_STAGE(PG8_SA(1, 1), a1 + hstep, voffA);
            PG8_WAIT_V(8); PG8_WAIT_L(0); PG8_BAR; PG8_MMA(0, 0, At, B0); PG8_MMA(0, 1, At, B1); PG8_BAR; PG8_SCHED;
            PG8_LDA(At, 0, 1); PG8_STAGE(PG8_SB(0, 0), b2, voffB); PG8_STAGE(PG8_SB(0, 1), b2 + hstep, voffB); PG8_STAGE(PG8_SA(0, 0), a2, voffA);
            PG8_WAIT_V(8); PG8_WAIT_L(0); PG8_BAR; PG8_MMA(1, 0, At, B0); PG8_MMA(1, 1, At, B1); PG8_BAR; PG8_SCHED;
            PG8_LDB(B0, 1, 0); PG8_LDB(B1, 1, 1); PG8_SCHED; PG8_LDA(At, 1, 0); PG8_STAGE(PG8_SA(0, 1), a2 + hstep, voffA);
            PG8_WAIT_V(8); PG8_WAIT_L(0); PG8_BAR; PG8_MMA(0, 0, At, B0); PG8_MMA(0, 1, At, B1); PG8_BAR; PG8_SCHED;
            PG8_LDA(At, 1, 1); PG8_STAGE(PG8_SB(1, 0), b3, voffB); PG8_STAGE(PG8_SB(1, 1), b3 + hstep, voffB); PG8_STAGE(PG8_SA(1, 0), a3, voffA);
            PG8_WAIT_V(8); PG8_WAIT_L(0); PG8_BAR; PG8_MMA(1, 0, At, B0); PG8_MMA(1, 1, At, B1); PG8_BAR; PG8_SCHED;
            } else {
            PG8_LDB(B0, 0, 0); PG8_SCHED; PG8_LDA(At, 0, 0); PG8_STAGE(PG8_SA(1, 1), a1 + hstep, voffA);
            PG8_WAIT_L(8); PG8_BAR; PG8_WAIT_L(0); PG8_MMA(0, 0, At, B0); PG8_BAR; PG8_SCHED;
            PG8_LDB(B1, 0, 1); PG8_STAGE(PG8_SB(0, 0), b2, voffB);
            PG8_BAR; PG8_WAIT_L(0); PG8_MMA(0, 1, At, B1); PG8_BAR;
            PG8_LDA(At, 0, 1); PG8_STAGE(PG8_SA(0, 0), a2, voffA);
            PG8_BAR; PG8_WAIT_L(0); PG8_MMA(1, 0, At, B0); PG8_BAR; PG8_SCHED;
            PG8_STAGE(PG8_SB(0, 1), b2 + hstep, voffB);
            PG8_WAIT_V(6); PG8_BAR; PG8_MMA(1, 1, At, B1); PG8_BAR;
            PG8_LDB(B0, 1, 0); PG8_SCHED; PG8_LDA(At, 1, 0); PG8_STAGE(PG8_SA(0, 1), a2 + hstep, voffA);
            PG8_WAIT_L(8); PG8_BAR; PG8_WAIT_L(0); PG8_MMA(0, 0, At, B0); PG8_BAR; PG8_SCHED;
            PG8_LDB(B1, 1, 1); PG8_STAGE(PG8_SB(1, 0), b3, voffB);
            PG8_BAR; PG8_WAIT_L(0); PG8_MMA(0, 1, At, B1); PG8_BAR;
            PG8_LDA(At, 1, 1); PG8_STAGE(PG8_SA(1, 0), a3, voffA);
            PG8_BAR; PG8_WAIT_L(0); PG8_MMA(1, 0, At, B0); PG8_BAR; PG8_SCHED;
            PG8_STAGE(PG8_SB(1, 1), b3 + hstep, voffB);
            PG8_WAIT_V(6); PG8_BAR; PG8_MMA(1, 1, At, B1); PG8_BAR;
            }
        }
        if constexpr (ALIGN_EPI) { if (wr == 0) PG8_BAR; }
        if constexpr (!Epi::AFTER_DRAIN) { E(acc, cur, wr, wc, fr, fq); S.done(cur); }
        if (!has_next) break;
#pragma unroll
        for (int a = 0; a < 2; ++a)
#pragma unroll
            for (int b = 0; b < 2; ++b)
#pragma unroll
                for (int m = 0; m < 4; ++m)
#pragma unroll
                    for (int n = 0; n < 2; ++n) acc[a][b][m][n] = (f32x4){0.f, 0.f, 0.f, 0.f};
        cur = nxt; cA = nA; cB = nB; ++ui;
        if constexpr (ALIGN_EPI) { if (wr == 1) PG8_BAR; }
    }
    PG8_WAIT_V(0);
    if constexpr (!ALIGN_EPI) { if (wr == 0) PG8_BAR; }
    PG8_BAR;
    if constexpr (Epi::AFTER_DRAIN) { E.fused(acc, cur, wr, wc, fr, fq, lds, wid, lane); S.done(cur); }
#undef PG8_SA
#undef PG8_SB
#undef PG8_STAGE
#undef PG8_LDA
#undef PG8_LDB
#undef PG8_MMA
#undef PG8_WAIT_V
#undef PG8_WAIT_L
#undef PG8_BAR
#undef PG8_SCHED
}
}

template <class F> struct Pg8Epi8 {
    static constexpr bool PERM = true, AFTER_DRAIN = false;
    F f;
    __device__ __forceinline__ void operator()(const pg8::f32x4 (&acc)[2][2][4][2], const pg8::Unit& u, int wr, int wc, int fr, int fq) const {
#pragma unroll
        for (int ai = 0; ai < 2; ++ai)
#pragma unroll
            for (int m = 0; m < 4; ++m)
#pragma unroll
                for (int bj = 0; bj < 2; ++bj) {
                    const int row = u.pm * 256 + ai * 128 + wr * 64 + m * 16 + fr;
                    const int col = u.pn * 256 + bj * 128 + wc * 32 + 8 * fq;
                    const pg8::f32x4 a = acc[ai][bj][m][0], b = acc[ai][bj][m][1];
                    f(row, col, (f32x4){a[0], a[1], a[2], a[3]}, (f32x4){b[0], b[1], b[2], b[3]});
                }
    }
};
template <class F> struct Pg8Epi {
    static constexpr bool PERM = false, AFTER_DRAIN = false;
    F f;
    __device__ __forceinline__ void operator()(const pg8::f32x4 (&acc)[2][2][4][2], const pg8::Unit& u, int wr, int wc, int fr, int fq) const {
#pragma unroll
        for (int ai = 0; ai < 2; ++ai)
#pragma unroll
            for (int m = 0; m < 4; ++m)
#pragma unroll
                for (int bj = 0; bj < 2; ++bj)
#pragma unroll
                    for (int n = 0; n < 2; ++n) {
                        const int row = u.pm * 256 + ai * 128 + wr * 64 + m * 16 + fr;
                        const int col = u.pn * 256 + bj * 128 + wc * 32 + n * 16 + 4 * fq;
                        const pg8::f32x4 v = acc[ai][bj][m][n];
                        f(row, col, (f32x4){v[0], v[1], v[2], v[3]});
                    }
    }
};

template <bool PERM = false>
DEVI void vtrans_unit(const bf16_t* src, int pitch, int off, int t0, int dil, bf16_t* VT, LAS bf16_t* T, int lane) {
    constexpr int TS = 68;
    const int cw = 64 / dil;
#pragma unroll
    for (int i = 0; i < 8; ++i) {
        const int tl = i * 8 + (lane >> 3), ch = lane & 7;
        const u32x4 v = *(const u32x4*)(src + (size_t)(t0 + tl) * pitch + off + ch * 8);
        const int tp = (tl % dil) * cw + tl / dil;
        T[(ch * 8 + 0) * TS + tp] = (bf16_t)(v.x & 0xffffu); T[(ch * 8 + 1) * TS + tp] = (bf16_t)(v.x >> 16);
        T[(ch * 8 + 2) * TS + tp] = (bf16_t)(v.y & 0xffffu); T[(ch * 8 + 3) * TS + tp] = (bf16_t)(v.y >> 16);
        T[(ch * 8 + 4) * TS + tp] = (bf16_t)(v.z & 0xffffu); T[(ch * 8 + 5) * TS + tp] = (bf16_t)(v.z >> 16);
        T[(ch * 8 + 6) * TS + tp] = (bf16_t)(v.w & 0xffffu); T[(ch * 8 + 7) * TS + tp] = (bf16_t)(v.w >> 16);
    }
    asm volatile("s_waitcnt lgkmcnt(0)" ::: "memory");
    const int L = S / dil;
#pragma unroll
    for (int i = 0; i < 16; ++i) {
        const int id = i * 64 + lane, d = id >> 4, c = id & 15;
        const u32x2 v = *(const LAS u32x2*)(T + d * TS + c * 4);
        if constexpr (PERM) {
            int w = __builtin_amdgcn_cvt_pk_fp8_f32(bflo(v.x), bfhi(v.x), 0, false);
            w = __builtin_amdgcn_cvt_pk_fp8_f32(bflo(v.y), bfhi(v.y), w, true);
            const int dw = 8 * (c & 1) + 4 * (c >> 3) + ((c & 7) >> 1);
            *(int*)((unsigned char*)VT + (size_t)d * S + t0 + 4 * dw) = w;
        } else {
            const int tp = c * 4, cls = tp / cw, within = tp % cw;
            const int pos = cls * L + t0 / dil + within;
            *(u32x2*)(VT + (size_t)d * S + pos) = v;
        }
    }
    asm volatile("s_waitcnt lgkmcnt(0)" ::: "memory");
}

DEVI float rope_freq16(int i) { return exp2f(-(float)i * (13.287712379549449f / 16.f)); }
DEVI float rope32(float x, int li, float pos) {
    const float xp = swz_xor16(x);
    float rev = pos * rope_freq16(li & 15) * 0.15915494309189535f; rev -= floorf(rev);
    const float c = __builtin_amdgcn_cosf(rev), s = __builtin_amdgcn_sinf(rev);
    return (li < 16) ? (x * c - xp * s) : (xp * s + x * c);
}
DEVI void phase_post1(const Params& p, int layer, lchar* lds) {
    const int tid = otid(), lane = tid & 63, wid = tid >> 6;
    const int gw = obid() * NWAVES + wid, ngw = ogrid() * NWAVES;
    unsigned char* ws = p.ws;
    const bf16_t* P = (const bf16_t*)(ws + WS_P);
    unsigned char* qkv = ws + WS_QKV;
    LAS float* gtab = (LAS float*)(lds + 8 * 8704);
    for (int i = tid; i < 640; i += NTHREADS) {
        const int gi = i >> 6, d = i & 63;
        const float* src = gi == 0 ? p.in[5] + layer * 64 : gi == 1 ? p.in[6] + layer * 64 : gi < 5 ? p.in[8] + (layer * 3 + gi - 2) * 64 : gi < 8 ? p.in[9] + (layer * 3 + gi - 5) * 64
                         : gi == 8 ? p.in[16] + layer * 64 : p.in[17] + layer * 64;
        gtab[i] = src[d];
    }
    __syncthreads();
    const float ckg_pe = p.in[15][layer * 96 + 64 + (lane & 31)];
    f32x4 cqlg = *(const f32x4*)(p.in[10] + layer * 256 + 4 * lane);
    f32x2 ckvlg = *(const f32x2*)(p.in[11] + layer * 128 + 2 * lane);
    const float qs64 = 0.125f * LOG2E;
    const int g4 = lane >> 4, sub = lane & 15;
    for (int t = gw; t < S; t += ngw) {
        const bf16_t* row = P + (size_t)t * PW;
        u32x2 wvs[9];
#pragma unroll
        for (int it = 0; it < 9; ++it) {
            const int hI = it * 4 + g4;
            const int srcc = hI < 6 ? hI * 64 : (hI < 30 ? 512 + (hI - 6) * 64 : 3232 + (hI - 30) * 64);
            wvs[it] = *(const u32x2*)(row + srcc + 4 * sub);
        }
#pragma unroll
        for (int it = 0; it < 9; ++it) {
            const int hI = it * 4 + g4;
            const u32x2 wv = wvs[it];
            float x0 = bflo(wv.x), x1 = bfhi(wv.x), x2 = bflo(wv.y), x3 = bfhi(wv.y);
            float ss = (x0 * x0 + x1 * x1) + (x2 * x2 + x3 * x3);
            ss += dppf<0xB1>(ss); ss += dppf<0x4E>(ss); ss += dppf<0x141>(ss); ss += dppf<0x140>(ss);
            const float rs = rsqrtf(ss * (1.f / 64.f) + EPS);
            const int gi = hI < 4 ? 0 : (hI < 6 ? 1 : (hI < 18 ? 2 + ((hI - 6) >> 2) : (hI < 30 ? 5 + ((hI - 18) >> 2) : (hI < 34 ? 8 : 9))));
            const f32x4 gn = *(const LAS f32x4*)(gtab + gi * 64 + 4 * sub);
            x0 *= rs * gn.x; x1 *= rs * gn.y; x2 *= rs * gn.z; x3 *= rs * gn.w;
            const bool isq = (hI < 4) || (hI >= 6 && hI < 18) || (hI >= 30 && hI < 34);
            if (it >= 7) {
                const float p0 = swz_xor4(x0), p1 = swz_xor4(x1), p2 = swz_xor4(x2), p3 = swz_xor4(x3);
                if (hI >= 30) {
                    const float pos = (sub >> 3) ? (float)(t & 63) : (float)(t >> 6);
                    const bool first = (sub & 4) == 0;
                    const int fi = 4 * (sub & 3);
                    float xs[4] = {x0, x1, x2, x3}; const float ps[4] = {p0, p1, p2, p3};
#pragma unroll
                    for (int q = 0; q < 4; ++q) {
                        float rev = pos * rope_freq16(fi + q) * 0.15915494309189535f; rev -= floorf(rev);
                        const float c = __builtin_amdgcn_cosf(rev), sn = __builtin_amdgcn_sinf(rev);
                        xs[q] = first ? (xs[q] * c - ps[q] * sn) : (ps[q] * sn + xs[q] * c);
                    }
                    x0 = xs[0]; x1 = xs[1]; x2 = xs[2]; x3 = xs[3];
                }
            }
            const float sc = isq ? qs64 : 1.f;
            u32x2 o; o.x = pk2(x0 * sc, x1 * sc); o.y = pk2(x2 * sc, x3 * sc);
            if (it >= 7 && hI >= 30) {
                int w8 = __builtin_amdgcn_cvt_pk_fp8_f32(x0 * sc, x1 * sc, 0, false); w8 = __builtin_amdgcn_cvt_pk_fp8_f32(x2 * sc, x3 * sc, w8, true);
                const size_t d8 = (hI < 34) ? Q_QD + ((size_t)(hI - 30) * S + t) * 64 : Q_KD + ((size_t)(hI - 34) * S + t) * 64;
                *(int*)(qkv + d8 + 4 * sub) = w8;
                continue;
            }
            size_t doff;
            if (hI < 4) doff = Q_QA + ((size_t)hI * S + t) * 128;
            else if (hI < 6) doff = Q_KA + ((size_t)(hI - 4) * S + t) * 128;
            else if (hI < 30) {
                const int gh = (hI < 18) ? hI - 6 : hI - 18, g = gh >> 2;
                const int dil = (g == 0) ? 1 : (g == 1 ? 4 : 16);
                const int pos = (t % dil) * (S / dil) + t / dil;
                doff = ((hI < 18) ? Q_QB : Q_KB) + ((size_t)gh * S + pos) * 128;
            } else if (hI < 34) doff = Q_QD + ((size_t)(hI - 30) * S + t) * 128;
            else doff = Q_KD + ((size_t)(hI - 34) * S + t) * 128;
            *(u32x2*)(qkv + doff + 8 * sub) = o;
        }
        {
            const u32x2 w = *(const u32x2*)(row + O_CQ + 4 * lane);
            const float a = bflo(w.x), b = bfhi(w.x), c = bflo(w.y), d = bfhi(w.y);
            const float rs = rsqrtf(wave_sum(a * a + b * b + c * c + d * d) * (1.f / 256.f) + EPS);
            u32x2 o; o.x = pk2(a * rs * cqlg.x, b * rs * cqlg.y); o.y = pk2(c * rs * cqlg.z, d * rs * cqlg.w);
            *(u32x2*)((bf16_t*)(ws + WS_CQN) + (size_t)t * 256 + 4 * lane) = o;
            const unsigned w2 = *(const unsigned*)(row + O_CKV + 2 * lane);
            const float e = bflo(w2), f = bfhi(w2);
            const float rs2 = rsqrtf(wave_sum(e * e + f * f) * (1.f / 128.f) + EPS);
            *(unsigned*)((bf16_t*)(ws + WS_CKVN) + (size_t)t * 128 + 2 * lane) = pk2(e * rs2 * ckvlg.x, f * rs2 * ckvlg.y);
            float kr = (lane < 32) ? bf2f(row[O_CKR + lane]) : 0.f;
            const float rs3 = rsqrtf(wave_sum(kr * kr) * (1.f / 32.f) + EPS);
            const float y = rope32(kr * rs3 * ckg_pe, lane & 31, (float)t);
            {
                const unsigned char yb = (lane < 32) ? (unsigned char)(__builtin_amdgcn_cvt_pk_fp8_f32(y, 0.f, 0, false) & 0xff) : (unsigned char)0;
#pragma unroll
                for (int hh = 0; hh < 4; ++hh) (qkv + Q_KC)[((size_t)hh * S + t) * 128 + 64 + lane] = yb;
            }
        }
    }
    LAS bf16_t* T = (LAS bf16_t*)(lds + wid * 8704);
    for (int u = gw; u < 16 * 256; u += ngw) {
        const int hd = u >> 8, t0 = (u & 255) * 64;
        if (hd < 2) vtrans_unit(P, PW, O_AV + hd * 64, t0, 1, (bf16_t*)(qkv + Q_VAT) + (size_t)hd * 64 * S, T, lane);
        else if (hd < 14) { const int gh = hd - 2, g = gh >> 2; const int dil = (g == 0) ? 1 : (g == 1 ? 4 : 16);
            vtrans_unit(P, PW, O_BV + gh * 64, t0, dil, (bf16_t*)(qkv + Q_VBT) + (size_t)gh * 64 * S, T, lane); }
        else vtrans_unit<true>(P, PW, O_DV + (hd - 14) * 64, t0, 1, (bf16_t*)(qkv + Q_VDT + (size_t)(hd - 14) * 64 * S), T, lane);
    }
}
DEVI void phase_post2(const Params& p, int layer, lchar* lds) {
    const int tid = otid(), lane = tid & 63, wid = tid >> 6;
    const int gw = obid() * NWAVES + wid, ngw = ogrid() * NWAVES;
    unsigned char* ws = p.ws;
    unsigned char* qkv = ws + WS_QKV;
    const bf16_t* CQ = (const bf16_t*)(ws + WS_CQRAW);
    const bf16_t* CKV = (const bf16_t*)(ws + WS_CKVRAW);
    const float qs96 = 0.10206207261596575f * LOG2E;
    const int g4 = lane >> 4, sub = lane & 15;
    const f32x4 qgn = *(const f32x4*)(p.in[14] + layer * 96 + 4 * sub);
    const f32x4 kgn = *(const f32x4*)(p.in[15] + layer * 96 + 4 * sub);
    const int g8 = lane >> 3, s8 = lane & 7;
    const f32x4 qgp = *(const f32x4*)(p.in[14] + layer * 96 + 64 + 4 * s8);
    for (int t = gw; t < S; t += ngw) {
        {
            const u32x2 wv = *(const u32x2*)(CQ + (size_t)t * 384 + g4 * 96 + 4 * sub);
            float x0 = bflo(wv.x), x1 = bfhi(wv.x), x2 = bflo(wv.y), x3 = bfhi(wv.y);
            float ss = (x0 * x0 + x1 * x1) + (x2 * x2 + x3 * x3);
            ss += dppf<0xB1>(ss); ss += dppf<0x4E>(ss); ss += dppf<0x141>(ss); ss += dppf<0x140>(ss);
            const float rs = rsqrtf(ss * (1.f / 64.f) + EPS) * qs96;
            int w8 = __builtin_amdgcn_cvt_pk_fp8_f32(x0 * rs * qgn.x, x1 * rs * qgn.y, 0, false); w8 = __builtin_amdgcn_cvt_pk_fp8_f32(x2 * rs * qgn.z, x3 * rs * qgn.w, w8, true);
            *(int*)(qkv + Q_QC + ((size_t)g4 * S + t) * 128 + 4 * sub) = w8;
        }
        {
            const u32x2 wv = *(const u32x2*)(CKV + (size_t)t * 512 + g4 * 128 + 4 * sub);
            float x0 = bflo(wv.x), x1 = bfhi(wv.x), x2 = bflo(wv.y), x3 = bfhi(wv.y);
            float ss = (x0 * x0 + x1 * x1) + (x2 * x2 + x3 * x3);
            ss += dppf<0xB1>(ss); ss += dppf<0x4E>(ss); ss += dppf<0x141>(ss); ss += dppf<0x140>(ss);
            const float rs = rsqrtf(ss * (1.f / 64.f) + EPS);
            int w8 = __builtin_amdgcn_cvt_pk_fp8_f32(x0 * rs * kgn.x, x1 * rs * kgn.y, 0, false); w8 = __builtin_amdgcn_cvt_pk_fp8_f32(x2 * rs * kgn.z, x3 * rs * kgn.w, w8, true);
            *(int*)(qkv + Q_KC + ((size_t)g4 * S + t) * 128 + 4 * sub) = w8;
        }
        {
            const int hh = g8 & 3;
            const u32x2 wv = *(const u32x2*)(CQ + (size_t)t * 384 + hh * 96 + 64 + 4 * s8);
            float xs[4] = {bflo(wv.x), bfhi(wv.x), bflo(wv.y), bfhi(wv.y)};
            float ss = (xs[0] * xs[0] + xs[1] * xs[1]) + (xs[2] * xs[2] + xs[3] * xs[3]);
            ss += dppf<0xB1>(ss); ss += dppf<0x4E>(ss); ss += dppf<0x141>(ss);
            const float rs = rsqrtf(ss * (1.f / 32.f) + EPS);
            const float gq[4] = {qgp.x, qgp.y, qgp.z, qgp.w};
            const bool first = (s8 & 4) == 0;
            float ys[4];
#pragma unroll
            for (int q = 0; q < 4; ++q) {
                const float y = xs[q] * rs * gq[q];
                const float yp = swz_xor4(y);
                float rev = (float)t * rope_freq16(4 * (s8 & 3) + q) * 0.15915494309189535f; rev -= floorf(rev);
                const float c = __builtin_amdgcn_cosf(rev), sn = __builtin_amdgcn_sinf(rev);
                ys[q] = (first ? (y * c - yp * sn) : (yp * sn + y * c)) * qs96;
            }
            int w8 = __builtin_amdgcn_cvt_pk_fp8_f32(ys[0], ys[1], 0, false); w8 = __builtin_amdgcn_cvt_pk_fp8_f32(ys[2], ys[3], w8, true);
            *(int*)(qkv + Q_QC + ((size_t)hh * S + t) * 128 + (lane < 32 ? 64 : 96) + 4 * s8) = (lane < 32) ? w8 : 0;
        }
    }
    LAS bf16_t* T = (LAS bf16_t*)(lds + wid * 8704);
    for (int u = gw; u < 4 * 256; u += ngw) {
        const int hd = u >> 8, t0 = (u & 255) * 64;
        vtrans_unit<true>(CKV, 512, hd * 128 + 64, t0, 1, (bf16_t*)(qkv + Q_VCT + (size_t)hd * 64 * S), T, lane);
    }
}

#define PIN(x) asm volatile("" : "+v"(x))
DEVI float max3f(float a, float b, float c) { float r; asm("v_max3_f32 %0, %1, %2, %3" : "=v"(r) : "v"(a), "v"(b), "v"(c)); return r; }
DEVI float max2f(float a, float b) { float r; asm("v_max_f32_e32 %0, %1, %2" : "=v"(r) : "v"(a), "v"(b)); return r; }
DEVI float rowmax32(const f32x16& a, const f32x16& b) {
    float x = max3f(a[0], a[1], a[2]), y = max3f(a[3], a[4], a[5]);
    x = max3f(x, a[6], a[7]); y = max3f(y, a[8], a[9]); x = max3f(x, a[10], a[11]); y = max3f(y, a[12], a[13]); x = max3f(x, a[14], a[15]);
    y = max3f(y, b[0], b[1]); x = max3f(x, b[2], b[3]); y = max3f(y, b[4], b[5]); x = max3f(x, b[6], b[7]); y = max3f(y, b[8], b[9]);
    x = max3f(x, b[10], b[11]); y = max3f(y, b[12], b[13]); x = max3f(x, b[14], b[15]);
    return max2f(x, y);
}
typedef int i32x8 __attribute__((ext_vector_type(8)));
template <int DQ> struct AttnCfg {
    static constexpr int KROWB = (DQ == 64) ? 64 : 128, KST = KROWB / 64, KTB = 64 * KROWB, VTB = 4096, NSLOT = 4, K_RING = 0, V_RING = NSLOT * KTB;
};
struct AttnDma { const unsigned char* kg; const unsigned char* vg; int kd, vd; };
template <int DQ> DEVI void attn_dma_k(const AttnDma& d, int jt, int slot, lchar* lds, int lane) {
    typedef AttnCfg<DQ> C;
    if constexpr (DQ == 64) { if (lane < 32) __builtin_amdgcn_global_load_lds((const unsigned*)(d.kg + (size_t)jt * C::KTB), (LAS unsigned*)(lds + C::K_RING + slot * C::KTB + d.kd), 16, 0, 0); }
    else __builtin_amdgcn_global_load_lds((const unsigned*)(d.kg + (size_t)jt * C::KTB), (LAS unsigned*)(lds + C::K_RING + slot * C::KTB + d.kd), 16, 0, 0);
}
template <int DQ> DEVI void attn_dma_v(const AttnDma& d, int jt, int slot, lchar* lds, int lane) {
    typedef AttnCfg<DQ> C;
    if (lane < 32) __builtin_amdgcn_global_load_lds((const unsigned*)(d.vg + (size_t)jt * 64), (LAS unsigned*)(lds + C::V_RING + slot * C::VTB + d.vd), 16, 0, 0);
}
#define ATTN_WAIT(n) asm volatile("s_waitcnt vmcnt(" #n ")" ::: "memory")
#define MFMA_F8(a, b, c) __builtin_amdgcn_mfma_scale_f32_32x32x64_f8f6f4(a, b, c, 0, 0, 0, 0, 0, 0)
DEVI i32x8 cat8(const u32x4 a, const u32x4 b) { return (i32x8){(int)a.x, (int)a.y, (int)a.z, (int)a.w, (int)b.x, (int)b.y, (int)b.z, (int)b.w}; }
constexpr float ATTN_OFF = 6.f;
#define CVT8(PX, G, DST) do { int w_ = __builtin_amdgcn_cvt_pk_fp8_f32(PX[4 * (G)], PX[4 * (G) + 1], 0, false); \
        w_ = __builtin_amdgcn_cvt_pk_fp8_f32(PX[4 * (G) + 2], PX[4 * (G) + 3], w_, true); DST = w_; } while (0)
template <int DQ>
DEVI void attn_step(int j, int NT, f32x16& pc0, f32x16& pc1, f32x16& sn0, f32x16& sn1, f32x16& negm, f32x16 (&o)[2], f32x16& o2, const i32x8 ones8, float& mhat,
                    const i32x8 (&qf)[AttnCfg<DQ>::KST], const AttnDma& dm, const int (&voff)[2], const int (&koff)[2 * AttnCfg<DQ>::KST], lchar* lds, int lane) {
    typedef AttnCfg<DQ> C;
    constexpr int KST = C::KST;
    constexpr float THR = ATTN_OFF + 2.f;
    {
        const int jk = (j + 3 < NT) ? j + 3 : NT - 1, jv = (j + 2 < NT) ? j + 2 : NT - 1;
        attn_dma_v<DQ>(dm, jv, (j + 2) & 3, lds, lane);
        attn_dma_k<DQ>(dm, jk, (j + 3) & 3, lds, lane);
    }
    const lchar* kbs = lds + C::K_RING + ((j + 1) & 3) * C::KTB;
    const lchar* vbs = lds + C::V_RING + (j & 3) * C::VTB;
    u32x4 kc[2][2 * KST];
#pragma unroll
    for (int t = 0; t < 2; ++t)
#pragma unroll
        for (int c = 0; c < 2 * KST; ++c) kc[t][c] = *(const LAS u32x4*)(kbs + koff[c] + t * 32 * C::KROWB);
    SBAR();
    i32x8 pb;
#define EXD(I) pc1[I] = fast_exp2(pc1[I])
    if constexpr (KST == 1) {
        sn0 = MFMA_F8(cat8(kc[0][0], kc[0][1]), qf[0], negm);
        EXD(8); EXD(9); EXD(10); EXD(11); EXD(12); EXD(13); EXD(14); EXD(15); PIN(pc1); SBAR();
        sn1 = MFMA_F8(cat8(kc[1][0], kc[1][1]), qf[0], negm);
        CVT8(pc0, 0, pb[0]); CVT8(pc0, 1, pb[1]); CVT8(pc0, 2, pb[2]); CVT8(pc0, 3, pb[3]);
        CVT8(pc1, 0, pb[4]); CVT8(pc1, 1, pb[5]); CVT8(pc1, 2, pb[6]); CVT8(pc1, 3, pb[7]); PIN(pb); SBAR();
    } else {
        sn0 = MFMA_F8(cat8(kc[0][0], kc[0][1]), qf[0], negm);
        EXD(8); EXD(9); EXD(10); EXD(11); CVT8(pc0, 0, pb[0]); CVT8(pc0, 1, pb[1]); PIN(pc1); PIN(pb); SBAR();
        sn1 = MFMA_F8(cat8(kc[1][0], kc[1][1]), qf[0], negm);
        EXD(12); EXD(13); EXD(14); EXD(15); CVT8(pc0, 2, pb[2]); CVT8(pc0, 3, pb[3]); PIN(pc1); PIN(pb); SBAR();
        sn0 = MFMA_F8(cat8(kc[0][2], kc[0][3]), qf[1], sn0);
        CVT8(pc1, 0, pb[4]); CVT8(pc1, 1, pb[5]); PIN(pb); SBAR();
        sn1 = MFMA_F8(cat8(kc[1][2], kc[1][3]), qf[1], sn1);
        CVT8(pc1, 2, pb[6]); CVT8(pc1, 3, pb[7]); PIN(pb); SBAR();
    }
#undef EXD
    u32x4 va[2][2];
#define VLD(db, c) va[db][c] = *(const LAS u32x4*)(vbs + voff[c] + (db) * 2048)
    VLD(0, 0); VLD(0, 1); VLD(1, 0); VLD(1, 1);
    asm volatile("s_nop 15\n\ts_nop 15\n\ts_nop 7" : "+v"(sn0), "+v"(sn1));
    float mx = rowmax32(sn0, sn1);
    {
        auto rr = __builtin_amdgcn_permlane32_swap(__float_as_uint(mx), __float_as_uint(mx), false, false);
        mx = max2f(__uint_as_float(rr[0]), __uint_as_float(rr[1]));
    }
    float f = 1.f;
    const bool resc = __any(mx > THR);
    if (__builtin_expect(resc, 0)) {
        const float dl = fmaxf(mx - ATTN_OFF, 0.f);
        mhat += dl;
#pragma unroll
        for (int i = 0; i < 16; ++i) { sn0[i] -= dl; sn1[i] -= dl; negm[i] = -mhat; }
        f = fast_exp2(-dl);
    }
    SBAR();
#define EX1(PX, I) PX[I] = fast_exp2(PX[I])
    o[0] = MFMA_F8(cat8(va[0][0], va[0][1]), pb, o[0]);
    EX1(sn0, 0); EX1(sn0, 1); EX1(sn0, 2); EX1(sn0, 3); EX1(sn0, 4); EX1(sn0, 5); EX1(sn0, 6); EX1(sn0, 7); PIN(sn0); SBAR();
    o[1] = MFMA_F8(cat8(va[1][0], va[1][1]), pb, o[1]);
    EX1(sn0, 8); EX1(sn0, 9); EX1(sn0, 10); EX1(sn0, 11); EX1(sn0, 12); EX1(sn0, 13); EX1(sn0, 14); EX1(sn0, 15); PIN(sn0); SBAR();
    o2 = MFMA_F8(ones8, pb, o2);
    EX1(sn1, 0); EX1(sn1, 1); EX1(sn1, 2); EX1(sn1, 3); EX1(sn1, 4); EX1(sn1, 5); EX1(sn1, 6); EX1(sn1, 7); PIN(sn1); SBAR();
#undef EX1
#undef VLD
    if (__builtin_expect(resc, 0)) {
#pragma unroll
        for (int i = 0; i < 16; ++i) { o[0][i] *= f; o[1][i] *= f; o2[i] *= f; }
    }
    ATTN_WAIT(2);
    __builtin_amdgcn_s_barrier();
    SBAR();
}
template <int DQ>
DEVI void dense_attn_unit(const unsigned char* Q8, const unsigned char* K8, const unsigned char* VT8, bf16_t* Y  , int qb, lchar* lds) {
    typedef AttnCfg<DQ> C;
    constexpr int KST = C::KST;
    const int tid = otid(), lane = tid & 63, wid = tid >> 6, r = lane & 31, h = lane >> 5;
    const int qrow = qb * 256 + wid * 32 + r;
    AttnDma dm;
    {
        const int row8 = wid * 8 + ((lane & 31) >> 2), ch8 = (lane & 3) ^ ((row8 >> 2) & 3);
        dm.vg = VT8 + (size_t)row8 * S + ch8 * 16; dm.vd = wid * 512;
        if constexpr (DQ == 64) { dm.kg = K8 + (size_t)row8 * 64 + ch8 * 16; dm.kd = wid * 512; }
        else { const int krow = wid * 8 + (lane >> 3), kch = (lane & 7) ^ ((krow >> 1) & 7); dm.kg = K8 + (size_t)krow * 128 + kch * 16; dm.kd = wid * 1024; }
    }
    int voff[2], koff[2 * KST];
    {
        const int sw4 = (r >> 2) & 3;
        voff[0] = r * 64 + (((2 * h) ^ sw4) << 4); voff[1] = r * 64 + (((2 * h + 1) ^ sw4) << 4);
        if constexpr (DQ == 64) { koff[0] = voff[0]; koff[1] = voff[1]; }
        else {
            const int m7 = (r >> 1) & 7;
#pragma unroll
            for (int c = 0; c < 4; ++c) koff[c] = r * 128 + (((4 * (c >> 1) + 2 * h + (c & 1)) ^ m7) << 4);
        }
    }
    __syncthreads();
    attn_dma_k<DQ>(dm, 0, 0, lds, lane); attn_dma_v<DQ>(dm, 0, 0, lds, lane);
    attn_dma_k<DQ>(dm, 1, 1, lds, lane); attn_dma_v<DQ>(dm, 1, 1, lds, lane);
    attn_dma_k<DQ>(dm, 2, 2, lds, lane);
    i32x8 qf[KST];
#pragma unroll
    for (int ks = 0; ks < KST; ++ks) {
        const unsigned char* qp = Q8 + (size_t)qrow * C::KROWB + 64 * ks + 32 * h;
        qf[ks] = cat8(*(const u32x4*)qp, *(const u32x4*)(qp + 16));
    }
    ATTN_WAIT(0);
    __builtin_amdgcn_s_barrier();
    SBAR();

    float mhat;
    f32x16 negm, pa0, pa1, pb0, pb1, o[2], o2;
#pragma unroll
    for (int i = 0; i < 16; ++i) { pa0[i] = 0.f; pa1[i] = 0.f; o[0][i] = 0.f; o[1][i] = 0.f; o2[i] = 0.f; }
    const int onew = (r == 0) ? 0x38383838 : 0;
    const i32x8 ones8 = {onew, onew, onew, onew, onew, onew, onew, onew};
#pragma unroll
    for (int ks = 0; ks < KST; ++ks) {
        const lchar* kp0 = lds + C::K_RING;
        pa0 = MFMA_F8(cat8(*(const LAS u32x4*)(kp0 + koff[2 * ks]), *(const LAS u32x4*)(kp0 + koff[2 * ks + 1])), qf[ks], pa0);
        pa1 = MFMA_F8(cat8(*(const LAS u32x4*)(kp0 + koff[2 * ks] + 32 * C::KROWB), *(const LAS u32x4*)(kp0 + koff[2 * ks + 1] + 32 * C::KROWB)), qf[ks], pa1);
    }
    {
        float mx = fmaxf(pa0[0], pa1[0]);
#pragma unroll
        for (int i = 1; i < 16; ++i) mx = fmaxf(mx, fmaxf(pa0[i], pa1[i]));
        auto rr = __builtin_amdgcn_permlane32_swap(__float_as_uint(mx), __float_as_uint(mx), false, false);
        mhat = fmaxf(__uint_as_float(rr[0]), __uint_as_float(rr[1])) - ATTN_OFF;
#pragma unroll
        for (int i = 0; i < 16; ++i) { pa0[i] = fast_exp2(pa0[i] - mhat); pa1[i] = (i < 8) ? fast_exp2(pa1[i] - mhat) : pa1[i] - mhat; negm[i] = -mhat; }
    }
    constexpr int NT = S / 64;
#pragma unroll 1
    for (int j = 0; j < NT - 2; j += 2) {
        attn_step<DQ>(j, NT, pa0, pa1, pb0, pb1, negm, o, o2, ones8, mhat, qf, dm, voff, koff, lds, lane);
        attn_step<DQ>(j + 1, NT, pb0, pb1, pa0, pa1, negm, o, o2, ones8, mhat, qf, dm, voff, koff, lds, lane);
    }
    attn_step<DQ>(NT - 2, NT, pa0, pa1, pb0, pb1, negm, o, o2, ones8, mhat, qf, dm, voff, koff, lds, lane);
    {
        i32x8 pb;
#pragma unroll
        for (int i = 8; i < 16; ++i) pb1[i] = fast_exp2(pb1[i]);
        CVT8(pb0, 0, pb[0]); CVT8(pb0, 1, pb[1]); CVT8(pb0, 2, pb[2]); CVT8(pb0, 3, pb[3]);
        CVT8(pb1, 0, pb[4]); CVT8(pb1, 1, pb[5]); CVT8(pb1, 2, pb[6]); CVT8(pb1, 3, pb[7]);
        const lchar* vb = lds + C::V_RING + ((NT - 1) & 3) * C::VTB;
#pragma unroll
        for (int db = 0; db < 2; ++db)
            o[db] = MFMA_F8(cat8(*(const LAS u32x4*)(vb + voff[0] + db * 2048), *(const LAS u32x4*)(vb + voff[1] + db * 2048)), pb, o[db]);
        o2 = MFMA_F8(ones8, pb, o2);
    }
    ATTN_WAIT(0);
    float l;
    {
        auto rr = __builtin_amdgcn_permlane32_swap(__float_as_uint(o2[0]), __float_as_uint(o2[0]), false, false);
        l = __uint_as_float(rr[0]);
    }
    const float inv = 1.f / l;
    bf16_t* yrow = Y + (size_t)qrow * DM;
#pragma unroll
    for (int db = 0; db < 2; ++db)
#pragma unroll
        for (int rg = 0; rg < 4; ++rg) {
            u32x2 w; w.x = pk2(o[db][4 * rg] * inv, o[db][4 * rg + 1] * inv); w.y = pk2(o[db][4 * rg + 2] * inv, o[db][4 * rg + 3] * inv);
            *(u32x2*)(yrow + db * 32 + 8 * rg + 4 * h) = w;
        }
}

DEVI int rel_bucket(int rel) {
    const int n = rel < 0 ? -rel : rel;
    int b;
    if (n < 8) b = n; else if (n < 15) b = 8; else if (n < 27) b = 9; else if (n < 50) b = 10; else if (n < 91) b = 11; else if (n < 166) b = 12;
    else if (n < 305) b = 13; else if (n < 559) b = 14; else b = 15;
    return b + (rel > 0 ? 16 : 0);
}
template <int HW>
DEVI void banded_block_task(const bf16_t* Q, const bf16_t* K, const bf16_t* VT, int q0, int L, int dil, const float* relb, int bias_col, bool has_sink, float sink2,
                            bf16_t* out, int ld_out, float* lse_out, lchar* lds) {
    constexpr int NK = 256 + 2 * HW, KSTR = 144, VSTR = NK * 2 + 16, NKB = (2 * HW + 32) / 32;
    constexpr int LUTN = 32 * NKB + 32;
    constexpr int K_OFF = 0, V_OFF = NK * KSTR, LUT_OFF = V_OFF + 64 * VSTR;
    static_assert(LUT_OFF + 4 * LUTN * 4 <= LDS_BYTES - 96, "banded LDS footprint");
    constexpr float THR = 8.f;
    const int tid = otid(), lane = tid & 63, wid = tid >> 6, r = lane & 31, h = lane >> 5;
    const int band_lo = q0 - HW;
    const int seg_lo = (q0 / L) * L, seg_hi = seg_lo + L;
    const bool edge = (band_lo < seg_lo) || (band_lo + NK > seg_hi);
    __syncthreads();
#pragma unroll
    for (int i = 0; i < NK * 8 / 512; ++i) {
        const int c = tid + 512 * i, row = c >> 3, cc = c & 7;
        int key = band_lo + row; key = key < 0 ? 0 : (key > S - 1 ? S - 1 : key);
        *(LAS u32x4*)(lds + K_OFF + row * KSTR + cc * 16) = *(const u32x4*)(K + (size_t)key * 64 + cc * 8);
    }
#pragma unroll
    for (int i = 0; i < 64 * (NK / 8) / 512; ++i) {
        const int c = tid + 512 * i, d = c / (NK / 8), kc = c % (NK / 8);
        int key0 = band_lo + kc * 8; key0 = key0 < 0 ? 0 : (key0 > S - 8 ? S - 8 : key0);
        const u32x4 v = *(const u32x4*)(VT + (size_t)d * S + key0);
        *(LAS u32x2*)(lds + V_OFF + d * VSTR + (kc >> 1) * 32 + (kc & 1) * 8) = (u32x2){v.x, v.y};
        *(LAS u32x2*)(lds + V_OFF + d * VSTR + (kc >> 1) * 32 + (kc & 1) * 8 + 16) = (u32x2){v.z, v.w};
    }
    LAS float* lut = (LAS float*)(lds + LUT_OFF);
    for (int e = tid; e < 4 * LUTN; e += NTHREADS) {
        const int sp = e / LUTN, x = e % LUTN + sp - 32;
        float v = -INFINITY;
        if (x >= 0 && x <= 2 * HW) v = relb[rel_bucket((x - HW) * dil) * 16 + bias_col] * LOG2E;
        lut[e] = v;
    }
    const int qw0 = q0 + 32 * wid, qpos = qw0 + r;
    bf16x8 qf[4];
#pragma unroll
    for (int ks = 0; ks < 4; ++ks) qf[ks] = *(const bf16x8*)(Q + (size_t)qpos * 64 + ks * 16 + h * 8);
    const int sp = (4 - (r & 3)) & 3;
    const LAS float* lutl = lut + sp * LUTN + (32 + 4 * h - r - sp);
    __syncthreads();
    float m = has_sink ? sink2 : -64.f;
    float l = (has_sink && h == 0) ? 1.f : 0.f;
    f32x16 o[2];
#pragma unroll
    for (int i = 0; i < 16; ++i) { o[0][i] = 0.f; o[1][i] = 0.f; }
#pragma unroll 1
    for (int i = 0; i < NKB; ++i) {
        const int brow = 32 * wid + 32 * i;
        bf16x8 kf[4]; f32x4 bv[4]; u32x4 vf[2][2];
#pragma unroll
        for (int ks = 0; ks < 4; ++ks) kf[ks] = *(const LAS bf16x8*)(lds + K_OFF + (brow + r) * KSTR + (2 * ks + h) * 16);
#pragma unroll
        for (int g = 0; g < 4; ++g) bv[g] = *(const LAS f32x4*)(lutl + 32 * i + 8 * g);
#pragma unroll
        for (int s2 = 0; s2 < 2; ++s2)
#pragma unroll
            for (int db = 0; db < 2; ++db) vf[s2][db] = *(const LAS u32x4*)(lds + V_OFF + (db * 32 + r) * VSTR + (brow + 16 * s2) * 2 + 16 * h);
        f32x16 pa;
#pragma unroll
        for (int q = 0; q < 16; ++q) pa[q] = -m;
#pragma unroll
        for (int ks = 0; ks < 4; ++ks) pa = __builtin_amdgcn_mfma_f32_32x32x16_bf16(kf[ks], qf[ks], pa, 0, 0, 0);
#pragma unroll
        for (int q = 0; q < 16; ++q) pa[q] += bv[q >> 2][q & 3];
        if (edge) {
            const int kb0 = band_lo + brow + 4 * h;
#pragma unroll
            for (int q = 0; q < 16; ++q) {
                const int kp2 = kb0 + (q & 3) + 8 * (q >> 2);
                pa[q] = (kp2 >= seg_lo && kp2 < seg_hi) ? pa[q] : -INFINITY;
            }
        }
        float mx = fmaxf(fmaxf(pa[0], pa[1]), pa[2]);
#pragma unroll
        for (int q = 3; q < 15; q += 2) mx = fmaxf(fmaxf(mx, pa[q]), pa[q + 1]);
        mx = fmaxf(mx, pa[15]);
        mx = half_max(mx);
        if (__any(mx > THR)) {
            const float dl = fmaxf(mx, 0.f), alpha = fast_exp2(-dl);
            m += dl; l *= alpha;
#pragma unroll
            for (int q = 0; q < 16; ++q) { pa[q] -= dl; o[0][q] *= alpha; o[1][q] *= alpha; }
        }
        float ls = 0.f;
#pragma unroll
        for (int q = 0; q < 16; ++q) { pa[q] = fast_exp2(pa[q]); ls += pa[q]; }
        l += ls;
        bf16x8 pf[2];
        {
            u32x4 w;
            w.x = pk2(pa[0], pa[1]); w.y = pk2(pa[2], pa[3]); w.z = pk2(pa[4], pa[5]); w.w = pk2(pa[6], pa[7]); pf[0] = __builtin_bit_cast(bf16x8, w);
            w.x = pk2(pa[8], pa[9]); w.y = pk2(pa[10], pa[11]); w.z = pk2(pa[12], pa[13]); w.w = pk2(pa[14], pa[15]); pf[1] = __builtin_bit_cast(bf16x8, w);
        }
#pragma unroll
        for (int s2 = 0; s2 < 2; ++s2)
#pragma unroll
            for (int db = 0; db < 2; ++db) o[db] = __builtin_amdgcn_mfma_f32_32x32x16_bf16(__builtin_bit_cast(bf16x8, vf[s2][db]), pf[s2], o[db], 0, 0, 0);
    }
    l = half_sum(l);
    const float inv = 1.f / l;
    const int token = (qpos % L) * dil + qpos / L;
    bf16_t* yrow = out + (size_t)token * ld_out;
#pragma unroll
    for (int db = 0; db < 2; ++db)
#pragma unroll
        for (int rg = 0; rg < 4; ++rg) {
            u32x2 w; w.x = pk2(o[db][4 * rg] * inv, o[db][4 * rg + 1] * inv); w.y = pk2(o[db][4 * rg + 2] * inv, o[db][4 * rg + 3] * inv);
            *(u32x2*)(yrow + db * 32 + 8 * rg + 4 * h) = w;
        }
    if (lse_out && h == 0) lse_out[(size_t)token * 4] = (m + log2f(l)) * 0.6931471805599453f;
}
DEVI void phase_attention(const Params& p, int layer, lchar* lds) {
    unsigned char* ws = p.ws;
    unsigned char* qkv = ws + WS_QKV;
    bf16_t* Y = (bf16_t*)(ws + WS_Y);
    for (int rr_ = 0; rr_ < (REPEAT_PHASE == 61 ? 2 : 1); ++rr_)
    for (int id = obid(); id < 512; id += ogrid()) {
        const int mh = (id & 7) ^ ((id >> 6) & 4), qb = id >> 3;
        if (mh < 4) {
            dense_attn_unit<96>((const unsigned char*)(qkv + Q_QC) + (size_t)mh * S * 128, (const unsigned char*)(qkv + Q_KC) + (size_t)mh * S * 128,
                                (const unsigned char*)(qkv + Q_VCT) + (size_t)mh * 64 * S, Y + 512 + mh * 64, qb, lds);
        } else {
            const int hh = mh - 4;
            dense_attn_unit<64>((const unsigned char*)(qkv + Q_QD) + (size_t)hh * S * 64, (const unsigned char*)(qkv + Q_KD) + (size_t)(hh >> 1) * S * 64,
                                (const unsigned char*)(qkv + Q_VDT) + (size_t)(hh >> 1) * 64 * S, Y + 768 + hh * 64, qb, lds);
        }
    }
    for (int rr_ = 0; rr_ < (REPEAT_PHASE == 62 ? 2 : 1); ++rr_)
    for (int u = obid(); u < 16 * 64; u += ogrid()) {
        const int hd = (u + 4 * (u >> 8)) & 15, ck = u >> 4;
        if (hd < 4) {
            banded_block_task<128>((const bf16_t*)(qkv + Q_QA) + (size_t)hd * S * 64, (const bf16_t*)(qkv + Q_KA) + (size_t)(hd >> 1) * S * 64,
                                   (const bf16_t*)(qkv + Q_VAT) + (size_t)(hd >> 1) * 64 * S, ck * 256, S, 1, p.in[1], hd, true, p.in[7][layer * 4 + hd] * LOG2E,
                                   Y + hd * 64, DM, nullptr, lds);
        } else {
            const int gh = hd - 4, g = gh >> 2, hh = gh & 3; const int dil = (g == 0) ? 1 : (g == 1 ? 4 : 16);
            banded_block_task<64>((const bf16_t*)(qkv + Q_QB) + (size_t)gh * S * 64, (const bf16_t*)(qkv + Q_KB) + (size_t)gh * S * 64,
                                  (const bf16_t*)(qkv + Q_VBT) + (size_t)gh * 64 * S, ck * 256, S / dil, dil, p.in[1], 4 + gh, false, 0.f,
                                  (bf16_t*)(ws + WS_OB) + (size_t)g * S * 256 + hh * 64, 256, (float*)(ws + WS_LSE) + (size_t)g * S * 4 + hh, lds);
        }
    }
}
DEVI void convert_rows_fp8(const float* src, unsigned char* dst, float* inv_scale, int nrows, int gw, int ngw, int lane) {
    for (int row = gw; row < nrows; row += ngw) {
        const float* sp = src + (size_t)row * 1024 + 16 * lane;
        f32x4 v[4]; float mx = 0.f;
#pragma unroll
        for (int j = 0; j < 4; ++j) { v[j] = *(const f32x4*)(sp + 4 * j); mx = fmaxf(mx, fmaxf(fmaxf(fabsf(v[j].x), fabsf(v[j].y)), fmaxf(fabsf(v[j].z), fabsf(v[j].w)))); }
        mx = wave_max(mx);
        const float sc = mx > 0.f ? 384.f / mx : 1.f;
        u32x4 o;
#pragma unroll
        for (int j = 0; j < 4; ++j) {
            int w = 0;
            w = __builtin_amdgcn_cvt_pk_fp8_f32(v[j].x * sc, v[j].y * sc, w, false);
            w = __builtin_amdgcn_cvt_pk_fp8_f32(v[j].z * sc, v[j].w * sc, w, true);
            o[j] = (unsigned)w;
        }
        *(u32x4*)(dst + (size_t)row * 1024 + 16 * lane) = o;
        if (lane == 0) inv_scale[row] = mx > 0.f ? mx * (1.f / 384.f) : 1.f;
    }
}
DEVI void convert_rows_fp4(const float* src, unsigned char* dst, float* inv_scale, int nrows, int gw, int ngw, int lane) {
    for (int row0 = gw; row0 < nrows; row0 += 2 * ngw) {
        const int row1 = row0 + ngw; const bool has1 = row1 < nrows;
        const float* sp0 = src + (size_t)row0 * 1024 + 16 * lane;
        const float* sp1 = src + (size_t)(has1 ? row1 : row0) * 1024 + 16 * lane;
        f32x4 va[4], vb[4];
#pragma unroll
        for (int j = 0; j < 4; ++j) { va[j] = *(const f32x4*)(sp0 + 4 * j); vb[j] = *(const f32x4*)(sp1 + 4 * j); }
#define CONV_ROW(V, ROW, DO) do { float mx = 0.f; \
            _Pragma("unroll") for (int j = 0; j < 4; ++j) mx = fmaxf(mx, fmaxf(fmaxf(fabsf(V[j].x), fabsf(V[j].y)), fmaxf(fabsf(V[j].z), fabsf(V[j].w)))); \
            mx = wave_max(mx); const float sc = mx > 0.f ? 6.f / mx : 1.f; u32x2 o; \
            _Pragma("unroll") for (int j = 0; j < 2; ++j) { unsigned w = 0u; \
                w = __builtin_amdgcn_cvt_scalef32_pk_fp4_f32(w, V[2 * j].x * sc, V[2 * j].y * sc, 1.0f, 0); \
                w = __builtin_amdgcn_cvt_scalef32_pk_fp4_f32(w, V[2 * j].z * sc, V[2 * j].w * sc, 1.0f, 1); \
                w = __builtin_amdgcn_cvt_scalef32_pk_fp4_f32(w, V[2 * j + 1].x * sc, V[2 * j + 1].y * sc, 1.0f, 2); \
                w = __builtin_amdgcn_cvt_scalef32_pk_fp4_f32(w, V[2 * j + 1].z * sc, V[2 * j + 1].w * sc, 1.0f, 3); o[j] = w; } \
            if (DO) { *(u32x2*)(dst + (size_t)(ROW) * 512 + 8 * lane) = o; if (lane == 0) inv_scale[ROW] = mx > 0.f ? mx * (1.f / 6.f) : 1.f; } } while (0)
        CONV_ROW(va, row0, true);
        CONV_ROW(vb, row1, has1);
#undef CONV_ROW
    }
}
DEVI void convert_rows_i4(const float* src, unsigned char* dst, float* inv_scale, int nrows, int gw, int ngw, int lane) {
    for (int row0 = gw; row0 < nrows; row0 += 2 * ngw) {
        const int row1 = row0 + ngw; const bool has1 = row1 < nrows;
        const float* sp0 = src + (size_t)row0 * 1024 + 16 * lane;
        const float* sp1 = src + (size_t)(has1 ? row1 : row0) * 1024 + 16 * lane;
        f32x4 va[4], vb[4];
#pragma unroll
        for (int j = 0; j < 4; ++j) { va[j] = *(const f32x4*)(sp0 + 4 * j); vb[j] = *(const f32x4*)(sp1 + 4 * j); }
#define CONV_ROW(V, ROW, DO) do { float ss = 0.f; \
            _Pragma("unroll") for (int j = 0; j < 4; ++j) ss += (V[j].x * V[j].x + V[j].y * V[j].y) + (V[j].z * V[j].z + V[j].w * V[j].w); \
            ss = wave_sum(ss); const float step = ss > 0.f ? 0.335f * sqrtf(ss * (1.f / 1024.f)) : 1.f, inv = 1.f / step; u32x2 o; \
            _Pragma("unroll") for (int j = 0; j < 2; ++j) { unsigned w = 0u; \
                _Pragma("unroll") for (int e = 0; e < 8; ++e) { const float v = V[2 * j + (e >> 2)][e & 3]; \
                    const int q = (int)fminf(fmaxf(__builtin_rintf(v * inv), -8.f), 7.f); w |= ((unsigned)q & 15u) << (4 * e); } \
                o[j] = w; } \
            if (DO) { *(u32x2*)(dst + (size_t)(ROW) * 512 + 8 * lane) = o; if (lane == 0) inv_scale[ROW] = step; } } while (0)
        CONV_ROW(va, row0, true);
        CONV_ROW(vb, row1, has1);
#undef CONV_ROW
    }
}
DEVI void phase_bmerge(const Params& p, int layer) {
    const int tid = otid();
    unsigned char* ws = p.ws;
    const bf16_t* OB = (const bf16_t*)(ws + WS_OB);
    const float* LSE = (const float*)(ws + WS_LSE);
    bf16_t* Y = (bf16_t*)(ws + WS_Y);
    const size_t gtid = (size_t)obid() * NTHREADS + tid, gthreads = (size_t)ogrid() * NTHREADS;
    for (size_t i = gtid; i < (size_t)S * 32; i += gthreads) {
        const int t = (int)(i >> 5), hh = (int)((i >> 3) & 3), c = (int)(i & 7);
        const float l0 = LSE[(size_t)t * 4 + hh], l1 = LSE[((size_t)S + t) * 4 + hh], l2 = LSE[((size_t)2 * S + t) * 4 + hh];
        const float mx = fmaxf(l0, fmaxf(l1, l2));
        float w0 = __expf(l0 - mx), w1 = __expf(l1 - mx), w2 = __expf(l2 - mx);
        const float inv = 1.f / (w0 + w1 + w2);
        w0 *= inv; w1 *= inv; w2 *= inv;
        const u32x4 a = *(const u32x4*)(OB + (size_t)t * 256 + hh * 64 + c * 8);
        const u32x4 b = *(const u32x4*)(OB + ((size_t)S + t) * 256 + hh * 64 + c * 8);
        const u32x4 d = *(const u32x4*)(OB + ((size_t)2 * S + t) * 256 + hh * 64 + c * 8);
        u32x4 o;
        o.x = pk2(w0 * bflo(a.x) + w1 * bflo(b.x) + w2 * bflo(d.x), w0 * bfhi(a.x) + w1 * bfhi(b.x) + w2 * bfhi(d.x));
        o.y = pk2(w0 * bflo(a.y) + w1 * bflo(b.y) + w2 * bflo(d.y), w0 * bfhi(a.y) + w1 * bfhi(b.y) + w2 * bfhi(d.y));
        o.z = pk2(w0 * bflo(a.z) + w1 * bflo(b.z) + w2 * bflo(d.z), w0 * bfhi(a.z) + w1 * bfhi(b.z) + w2 * bfhi(d.z));
        o.w = pk2(w0 * bflo(a.w) + w1 * bflo(b.w) + w2 * bflo(d.w), w0 * bfhi(a.w) + w1 * bfhi(b.w) + w2 * bfhi(d.w));
        *(u32x4*)(Y + (size_t)t * DM + 256 + hh * 64 + c * 8) = o;
    }
    const int lane = tid & 63, gw = (int)(gtid >> 6), ngw = (int)(gthreads >> 6);
#if EXPERT_FP4
    convert_rows_i4(p.in[23] + (size_t)layer * 16384 * 1024, ws + WS_PU, (float*)(ws + WS_US), 16384, gw, ngw, lane);
    convert_rows_fp4(p.in[24] + (size_t)layer * 16384 * 1024, ws + WS_PV, (float*)(ws + WS_VS), 16384, gw, ngw, lane);
#else
    convert_rows_fp8(p.in[23] + (size_t)layer * 16384 * 1024, ws + WS_PU, (float*)(ws + WS_US), 16384, gw, ngw, lane);
    convert_rows_fp8(p.in[24] + (size_t)layer * 16384 * 1024, ws + WS_PV, (float*)(ws + WS_VS), 16384, gw, ngw, lane);
#endif
}

DEVI unsigned f2ord(float f) { const unsigned u = __float_as_uint(f); return u ^ ((unsigned)((int)u >> 31) | 0x80000000u); }
DEVI float ord2f(unsigned o) { const unsigned u = (o & 0x80000000u) ? (o ^ 0x80000000u) : ~o; return __uint_as_float(u); }
DEVI void cswap_desc(unsigned& a, unsigned& b) { const unsigned mx = a > b ? a : b, mn = a > b ? b : a; a = mx; b = mn; }
DEVI void sort16_desc(unsigned (&v)[16]) {
    constexpr int KK[10] = {2, 4, 4, 8, 8, 8, 16, 16, 16, 16};
    constexpr int JJ[10] = {1, 2, 1, 4, 2, 1, 8, 4, 2, 1};
#pragma unroll
    for (int st = 0; st < 10; ++st)
#pragma unroll
        for (int i = 0; i < 16; ++i) {
            const int l = i ^ JJ[st];
            if (l > i) { if ((i & KK[st]) == 0) cswap_desc(v[i], v[l]); else cswap_desc(v[l], v[i]); }
        }
}
DEVI void merge16_desc(unsigned (&a)[16], const unsigned (&b)[16]) {
#pragma unroll
    for (int i = 0; i < 16; ++i) a[i] = a[i] > b[15 - i] ? a[i] : b[15 - i];
    constexpr int JJ[4] = {8, 4, 2, 1};
#pragma unroll
    for (int st = 0; st < 4; ++st)
#pragma unroll
        for (int i = 0; i < 16; ++i) { const int l = i ^ JJ[st]; if (l > i) cswap_desc(a[i], a[l]); }
}
DEVI void top16_of_64(unsigned (&g0)[16], unsigned (&g1)[16], unsigned (&g2)[16], unsigned (&g3)[16]) {
    sort16_desc(g0); sort16_desc(g1); sort16_desc(g2); sort16_desc(g3);
    merge16_desc(g0, g1); merge16_desc(g2, g3); merge16_desc(g0, g2);
}
DEVI float blendf(float a, float b, unsigned m) { return __uint_as_float((__float_as_uint(a) & ~m) | (__float_as_uint(b) & m)); }
DEVI void fp8x16_to_f32(const u32x4 w, float (&f)[16]) {
#pragma unroll
    for (int j = 0; j < 4; ++j) {
        const f32x2 a = __builtin_amdgcn_cvt_pk_f32_fp8((int)w[j], false), b = __builtin_amdgcn_cvt_pk_f32_fp8((int)w[j], true);
        f[4 * j] = a.x; f[4 * j + 1] = a.y; f[4 * j + 2] = b.x; f[4 * j + 3] = b.y;
    }
}
DEVI void fp4x16_to_f32(const u32x2 w, float (&f)[16]) {
#pragma unroll
    for (int j = 0; j < 2; ++j)
    {
        const f32x2 a0 = __builtin_amdgcn_cvt_scalef32_pk_f32_fp4(w[j], 1.0f, 0), a1 = __builtin_amdgcn_cvt_scalef32_pk_f32_fp4(w[j], 1.0f, 1);
        const f32x2 a2 = __builtin_amdgcn_cvt_scalef32_pk_f32_fp4(w[j], 1.0f, 2), a3 = __builtin_amdgcn_cvt_scalef32_pk_f32_fp4(w[j], 1.0f, 3);
        f[8 * j] = a0.x; f[8 * j + 1] = a0.y; f[8 * j + 2] = a1.x; f[8 * j + 3] = a1.y; f[8 * j + 4] = a2.x; f[8 * j + 5] = a2.y; f[8 * j + 6] = a3.x; f[8 * j + 7] = a3.y;
    }
}
DEVI void fp4x16_to_pairs(const u32x2 w, f32x2 (&f)[8]) {
#pragma unroll
    for (int j = 0; j < 2; ++j) {
        f[4 * j] = __builtin_amdgcn_cvt_scalef32_pk_f32_fp4(w[j], 1.0f, 0); f[4 * j + 1] = __builtin_amdgcn_cvt_scalef32_pk_f32_fp4(w[j], 1.0f, 1);
        f[4 * j + 2] = __builtin_amdgcn_cvt_scalef32_pk_f32_fp4(w[j], 1.0f, 2); f[4 * j + 3] = __builtin_amdgcn_cvt_scalef32_pk_f32_fp4(w[j], 1.0f, 3);
    }
}
DEVI void fp8x16_to_pairs(const u32x4 w, f32x2 (&f)[8]) {
#pragma unroll
    for (int j = 0; j < 4; ++j) { f[2 * j] = __builtin_amdgcn_cvt_pk_f32_fp8((int)w[j], false); f[2 * j + 1] = __builtin_amdgcn_cvt_pk_f32_fp8((int)w[j], true); }
}
constexpr int PH_PER_LAYER = 11 + 4 * SELFCHECK, N_PHASES = 1 + NLAYER * PH_PER_LAYER + SELFCHECK;
#if SELFCHECK
constexpr int CK_FLAG_WORD = 3900;
constexpr int NSAMP = 24;
DEVI int ck_vperm(int k) { return k ^ ((((k >> 2) ^ (k >> 3)) & 1) ? 12 : 0); }
__device__ const int ck_tokens[NSAMP] = {0, 1, 2, 31, 32, 63, 64, 65, 127, 128, 129, 255, 256, 1023, 1024, 4095, 4096, 5000, 8191, 8192, 12345, 16255, 16382, 16383};
constexpr int R_AQ = 0, R_AK = 256, R_AV = 384, R_BQ = 512, R_BK = 512 + 768, R_BV = 512 + 1536, R_CQ = 512 + 2304, R_CKV = R_CQ + 256, R_CKR = R_CKV + 128,
              R_DQ = R_CKR + 32, R_DK = R_DQ + 256, R_DV = R_DK + 128, R_G = R_DV + 128;
static_assert(R_AQ == O_AQ && R_AK == O_AK && R_AV == O_AV && R_BQ == O_BQ && R_BK == O_BK && R_BV == O_BV && R_CQ == O_CQ && R_CKV == O_CKV && R_CKR == O_CKR &&
              R_DQ == O_DQ && R_DK == O_DK && R_DV == O_DV && R_G == NGATE0, "column partition");
DEVI void ck_flag(const Params& p, unsigned bit) { atomicOr((unsigned*)(p.ws + WS_CTL) + CK_FLAG_WORD, bit); }
DEVI bool ck_vec(float ref, float got, bool active, float tol) {
    const float e = active ? (ref - got) * (ref - got) : 0.f, q = active ? ref * ref : 0.f;
    const float es = wave_sum(e), qs = wave_sum(q);
    return !(es <= tol * tol * qs + 1e-12f);
}
DEVI float ck_relerr(float ref, float got) {
    const float es = wave_sum((ref - got) * (ref - got)), qs = wave_sum(ref * ref);
    return sqrtf(es / (qs + 1e-20f));
}
DEVI unsigned ck_quant(float e) { if (!(e == e)) return 7u; return e < 0.02f ? 0u : e < 0.05f ? 1u : e < 0.1f ? 2u : e < 0.2f ? 3u : e < 0.5f ? 4u : e < 1.0f ? 5u : 6u; }
DEVI float ck_rope_ref(float x_self, float x_pair, int i_in_32, float pos) {
    const int i = i_in_32 & 15;
    const float ang = pos * powf(10000.f, -(float)i / 16.f);
    const float c = cosf(ang), s_ = sinf(ang);
    return (i_in_32 < 16) ? (x_self * c - x_pair * s_) : (x_pair * s_ + x_self * c);
}
DEVI void phase_check1(const Params& p, int layer) {
    const int tid = otid(), lane = tid & 63, wid = tid >> 6, gw = obid() * NWAVES + wid;
    if (gw >= NSAMP) return;
    const int t = ck_tokens[gw];
    unsigned char* ws = p.ws; unsigned char* qkv = ws + WS_QKV;
    const bf16_t* row = (const bf16_t*)(ws + WS_P) + (size_t)t * PW;
    bool bad = false;
    const float sc = 0.125f * LOG2E;
    for (int hh = 0; hh < 4; ++hh) {
        const float v = bf2f(row[R_AQ + hh * 64 + lane]); const float ms = wave_sum(v * v) / 64.f;
        const float ref = v / sqrtf(ms + 1e-6f) * p.in[5][layer * 64 + lane] * sc;
        bad |= ck_vec(ref, bf2f(((const bf16_t*)(qkv + Q_QA))[((size_t)hh * S + t) * 64 + lane]), true, 0.02f);
    }
    for (int kh = 0; kh < 2; ++kh) {
        const float v = bf2f(row[R_AK + kh * 64 + lane]); const float ms = wave_sum(v * v) / 64.f;
        const float ref = v / sqrtf(ms + 1e-6f) * p.in[6][layer * 64 + lane];
        bad |= ck_vec(ref, bf2f(((const bf16_t*)(qkv + Q_KA))[((size_t)kh * S + t) * 64 + lane]), true, 0.02f);
        bad |= ck_vec(bf2f(row[R_AV + kh * 64 + lane]), bf2f(((const bf16_t*)(qkv + Q_VAT))[((size_t)kh * 64 + lane) * S + t]), true, 0.001f);
    }
    for (int g = 0; g < 3; ++g) {
        const int dil = (g == 0) ? 1 : (g == 1 ? 4 : 16), L = S / dil, pos = (t % dil) * L + t / dil;
        for (int hh = 0; hh < 4; ++hh) {
            const int gh = g * 4 + hh;
            float v = bf2f(row[R_BQ + g * 256 + hh * 64 + lane]); float ms = wave_sum(v * v) / 64.f;
            float ref = v / sqrtf(ms + 1e-6f) * p.in[8][(layer * 3 + g) * 64 + lane] * sc;
            bad |= ck_vec(ref, bf2f(((const bf16_t*)(qkv + Q_QB))[((size_t)gh * S + pos) * 64 + lane]), true, 0.02f);
            v = bf2f(row[R_BK + g * 256 + hh * 64 + lane]); ms = wave_sum(v * v) / 64.f;
            ref = v / sqrtf(ms + 1e-6f) * p.in[9][(layer * 3 + g) * 64 + lane];
            bad |= ck_vec(ref, bf2f(((const bf16_t*)(qkv + Q_KB))[((size_t)gh * S + pos) * 64 + lane]), true, 0.02f);
            bad |= ck_vec(bf2f(row[R_BV + g * 256 + hh * 64 + lane]), bf2f(((const bf16_t*)(qkv + Q_VBT))[((size_t)gh * 64 + lane) * S + pos]), true, 0.001f);
        }
    }
    for (int hh = 0; hh < 6; ++hh) {
        const bool isq = hh < 4; const int off = isq ? R_DQ + hh * 64 : R_DK + (hh - 4) * 64;
        const float v = bf2f(row[off + lane]); const float ms = wave_sum(v * v) / 64.f;
        const float y = v / sqrtf(ms + 1e-6f) * (isq ? p.in[16][layer * 64 + lane] : p.in[17][layer * 64 + lane]);
        const float yp = __shfl(y, (lane & 32) | ((lane & 31) ^ 16));
        const float ref = ck_rope_ref(y, yp, lane & 31, (lane < 32) ? (float)(t / 64) : (float)(t % 64)) * (isq ? sc : 1.f);
        const bf16_t* dst = isq ? (const bf16_t*)(qkv + Q_QD) + ((size_t)hh * S + t) * 64 : (const bf16_t*)(qkv + Q_KD) + ((size_t)(hh - 4) * S + t) * 64;
        bad |= ck_vec(ref, bf2f(dst[lane]), true, 0.02f);
    }
    for (int kh = 0; kh < 2; ++kh)
        bad |= ck_vec(bf2f(row[R_DV + kh * 64 + lane]), bf2f(((const bf16_t*)(qkv + Q_VDT))[((size_t)kh * 64 + lane) * S + ck_vperm(t)]), true, 0.001f);
    {
        float ss = 0.f; for (int i = 0; i < 4; ++i) { const float v = bf2f(row[R_CQ + lane + 64 * i]); ss += v * v; }
        const float ms = wave_sum(ss) / 256.f;
        for (int i = 0; i < 4; ++i) { const float v = bf2f(row[R_CQ + lane + 64 * i]);
            bad |= ck_vec(v / sqrtf(ms + 1e-6f) * p.in[10][layer * 256 + lane + 64 * i], bf2f(((const bf16_t*)(ws + WS_CQN))[(size_t)t * 256 + lane + 64 * i]), true, 0.02f); }
        float s2 = 0.f; for (int i = 0; i < 2; ++i) { const float v = bf2f(row[R_CKV + lane + 64 * i]); s2 += v * v; }
        const float ms2 = wave_sum(s2) / 128.f;
        for (int i = 0; i < 2; ++i) { const float v = bf2f(row[R_CKV + lane + 64 * i]);
            bad |= ck_vec(v / sqrtf(ms2 + 1e-6f) * p.in[11][layer * 128 + lane + 64 * i], bf2f(((const bf16_t*)(ws + WS_CKVN))[(size_t)t * 128 + lane + 64 * i]), true, 0.02f); }
        const float kr = lane < 32 ? bf2f(row[R_CKR + lane]) : 0.f; const float ms3 = wave_sum(kr * kr) / 32.f;
        const float y = kr / sqrtf(ms3 + 1e-6f) * p.in[15][layer * 96 + 64 + (lane & 31)];
        const float yp = __shfl(y, (lane & 31) ^ 16);
        const float ref = ck_rope_ref(y, yp, lane & 31, (float)t);
        for (int hh = 0; hh < 4; ++hh) bad |= ck_vec(ref, lane < 32 ? bf2f(((const bf16_t*)(qkv + Q_KC))[((size_t)hh * S + t) * 96 + 64 + lane]) : 0.f, lane < 32, 0.02f);
    }
    if (bad && lane == 0) ck_flag(p, 1u);
}
DEVI void phase_check2(const Params& p, int layer) {
    const int tid = otid(), lane = tid & 63, wid = tid >> 6, gw = obid() * NWAVES + wid;
    if (gw >= NSAMP * 4) return;
    const int t = ck_tokens[gw >> 2], hh = gw & 3;
    unsigned char* ws = p.ws; unsigned char* qkv = ws + WS_QKV;
    const bf16_t* cqn = (const bf16_t*)(ws + WS_CQN) + (size_t)t * 256;
    const bf16_t* ckvn = (const bf16_t*)(ws + WS_CKVN) + (size_t)t * 128;
    const float* wuq = p.in[12] + (size_t)layer * 256 * 384;
    const float* wukv = p.in[13] + (size_t)layer * 128 * 512;
    bool bad = false;
    float qn = 0.f, qp = 0.f, kn = 0.f, vv = 0.f;
    for (int k = 0; k < 256; ++k) { const float a = bf2f(cqn[k]); qn += a * wuq[(size_t)k * 384 + hh * 96 + lane]; if (lane < 32) qp += a * wuq[(size_t)k * 384 + hh * 96 + 64 + lane]; }
    for (int k = 0; k < 128; ++k) { const float a = bf2f(ckvn[k]); kn += a * wukv[(size_t)k * 512 + hh * 128 + lane]; vv += a * wukv[(size_t)k * 512 + hh * 128 + 64 + lane]; }
    const float sc = 0.10206207261596575f * LOG2E;
    {
        const float ms = wave_sum(qn * qn) / 64.f;
        bad |= ck_vec(qn / sqrtf(ms + 1e-6f) * p.in[14][layer * 96 + lane] * sc, bf2f(((const bf16_t*)(qkv + Q_QC))[((size_t)hh * S + t) * 96 + lane]), true, 0.03f);
        const float ms2 = wave_sum(lane < 32 ? qp * qp : 0.f) / 32.f;
        const float y = qp / sqrtf(ms2 + 1e-6f) * p.in[14][layer * 96 + 64 + (lane & 31)];
        const float yp = __shfl(y, (lane & 31) ^ 16);
        bad |= ck_vec(ck_rope_ref(y, yp, lane & 31, (float)t) * sc, lane < 32 ? bf2f(((const bf16_t*)(qkv + Q_QC))[((size_t)hh * S + t) * 96 + 64 + lane]) : 0.f, lane < 32, 0.03f);
        const float ms3 = wave_sum(kn * kn) / 64.f;
        bad |= ck_vec(kn / sqrtf(ms3 + 1e-6f) * p.in[15][layer * 96 + lane], bf2f(((const bf16_t*)(qkv + Q_KC))[((size_t)hh * S + t) * 96 + lane]), true, 0.03f);
        bad |= ck_vec(vv, bf2f(((const bf16_t*)(qkv + Q_VCT))[((size_t)hh * 64 + lane) * S + ck_vperm(t)]), true, 0.03f);
    }
    if (bad && lane == 0) ck_flag(p, 2u);
}
DEVI float ck_bias(const float* relb, int rel_tokens, int col) {
    const int nb = 16, max_exact = 8;
    int ret = rel_tokens > 0 ? nb : 0;
    const int n = rel_tokens < 0 ? -rel_tokens : rel_tokens;
    const float nf = (float)(n > 1 ? n : 1);
    int large = max_exact + (int)(logf(nf / (float)max_exact) / logf(1024.f / (float)max_exact) * (float)(nb - max_exact));
    large = large < nb - 1 ? large : nb - 1;
    ret += (n < max_exact) ? n : large;
    return relb[ret * 16 + col];
}
DEVI void phase_check3(const Params& p, int layer, int mode) {
    const int tid = otid(), lane = tid & 63, wid = tid >> 6, gw = obid() * NWAVES + wid;
    if (gw >= NSAMP * 28) return;
    const int t = ck_tokens[gw / 28], kind = gw % 28;
    if ((kind >= 24) != (mode == 1)) return;
    unsigned char* ws = p.ws; unsigned char* qkv = ws + WS_QKV;
    const bf16_t* Y = (const bf16_t*)(ws + WS_Y);
    unsigned* fw = (unsigned*)(p.ws + WS_CTL) + CK_FLAG_WORD;
    if (kind >= 24) {
        const int hh = kind - 24;
        const bf16_t* OB = (const bf16_t*)(ws + WS_OB); const float* LSE = (const float*)(ws + WS_LSE);
        const float l0 = LSE[(size_t)t * 4 + hh], l1 = LSE[((size_t)S + t) * 4 + hh], l2 = LSE[((size_t)2 * S + t) * 4 + hh];
        const float mx = fmaxf(l0, fmaxf(l1, l2));
        const float w0 = expf(l0 - mx), w1 = expf(l1 - mx), w2 = expf(l2 - mx);
        const float ref = (w0 * bf2f(OB[(size_t)t * 256 + hh * 64 + lane]) + w1 * bf2f(OB[((size_t)S + t) * 256 + hh * 64 + lane]) + w2 * bf2f(OB[((size_t)2 * S + t) * 256 + hh * 64 + lane])) / (w0 + w1 + w2);
        const unsigned qv = ck_quant(ck_relerr(ref, bf2f(Y[(size_t)t * DM + 256 + hh * 64 + lane])));
        if (lane == 0) atomicMax(fw + 4, qv);
        return;
    }
    const bf16_t* Q; const bf16_t* K; const bf16_t* VT; const bf16_t* target; const float* lse_target = nullptr;
    int DQ = 64, klo = 0, khi = S - 1, qp = t, dil = 1, bias_col = -1, slot; float sink2 = 0.f; bool has_sink = false;
    if (kind < 4) { const int hh = kind; slot = 1;
        Q = (const bf16_t*)(qkv + Q_QA) + ((size_t)hh * S + t) * 64; K = (const bf16_t*)(qkv + Q_KA) + (size_t)(hh >> 1) * S * 64; VT = (const bf16_t*)(qkv + Q_VAT) + (size_t)(hh >> 1) * 64 * S;
        klo = t - 128 < 0 ? 0 : t - 128; khi = t + 128 > S - 1 ? S - 1 : t + 128; bias_col = hh; has_sink = true; sink2 = p.in[7][layer * 4 + hh] * LOG2E;
        target = Y + (size_t)t * DM + hh * 64;
    } else if (kind < 16) { const int gh = kind - 4, g = gh >> 2, hh = gh & 3; slot = 2;
        dil = (g == 0) ? 1 : (g == 1 ? 4 : 16); const int L = S / dil, c = t % dil, jq = t / dil;
        qp = c * L + jq;
        Q = (const bf16_t*)(qkv + Q_QB) + ((size_t)gh * S + qp) * 64; K = (const bf16_t*)(qkv + Q_KB) + (size_t)gh * S * 64; VT = (const bf16_t*)(qkv + Q_VBT) + (size_t)gh * 64 * S;
        klo = c * L + (jq - 64 < 0 ? 0 : jq - 64); khi = c * L + (jq + 64 > L - 1 ? L - 1 : jq + 64); bias_col = 4 + gh;
        target = (const bf16_t*)(ws + WS_OB) + ((size_t)g * S + t) * 256 + hh * 64; lse_target = (const float*)(ws + WS_LSE) + ((size_t)g * S + t) * 4 + hh;
    } else if (kind < 20) { const int hh = kind - 16; DQ = 96; slot = 3;
        Q = (const bf16_t*)(qkv + Q_QC) + ((size_t)hh * S + t) * 96; K = (const bf16_t*)(qkv + Q_KC) + (size_t)hh * S * 96; VT = (const bf16_t*)(qkv + Q_VCT) + (size_t)hh * 64 * S;
        target = Y + (size_t)t * DM + 512 + hh * 64;
    } else { const int hh = kind - 20; slot = 3;
        Q = (const bf16_t*)(qkv + Q_QD) + ((size_t)hh * S + t) * 64; K = (const bf16_t*)(qkv + Q_KD) + (size_t)(hh >> 1) * S * 64; VT = (const bf16_t*)(qkv + Q_VDT) + (size_t)(hh >> 1) * 64 * S;
        target = Y + (size_t)t * DM + 768 + hh * 64;
    }
    float m = has_sink ? sink2 : -INFINITY;
#pragma unroll 1
    for (int k = klo + lane; k <= khi; k += 64) {
        float d = 0.f;
#pragma unroll 4
        for (int x = 0; x < DQ; ++x) d += bf2f(Q[x]) * bf2f(K[(size_t)k * DQ + x]);
        if (bias_col >= 0) d += ck_bias(p.in[1], (k - qp) * dil, bias_col) * LOG2E;
        m = fmaxf(m, d);
    }
    m = wave_max(m);
    float out[64]; float den = 0.f;
#pragma unroll
    for (int dd = 0; dd < 64; ++dd) out[dd] = 0.f;
#pragma unroll 1
    for (int k = klo + lane; k <= khi; k += 64) {
        float d = 0.f;
#pragma unroll 4
        for (int x = 0; x < DQ; ++x) d += bf2f(Q[x]) * bf2f(K[(size_t)k * DQ + x]);
        if (bias_col >= 0) d += ck_bias(p.in[1], (k - qp) * dil, bias_col) * LOG2E;
        const float pk = exp2f(d - m); den += pk;
#pragma unroll
        for (int dd = 0; dd < 64; ++dd) out[dd] += pk * bf2f(VT[(size_t)dd * S + (kind >= 16 ? ck_vperm(k) : k)]);
    }
    den = wave_sum(den) + (has_sink ? exp2f(sink2 - m) : 0.f);
    float mine = 0.f;
#pragma unroll
    for (int dd = 0; dd < 64; ++dd) { const float v = wave_sum(out[dd]) / den; if (lane == dd) mine = v; }
    unsigned qv = ck_quant(ck_relerr(mine, bf2f(target[lane])));
    if (lse_target) { const float lref = (m + log2f(den)) * 0.6931471805599453f; if (!(fabsf(lref - *lse_target) < 0.02f)) qv = qv < 5u ? 5u : qv; }
    if (lane == 0) atomicMax(fw + slot, qv);
    {
        const float tg = bf2f(target[lane]);
        unsigned nb = 0u;
        if (__any(!(mine == mine))) nb |= 1u;
        if (__any(!(tg == tg))) nb |= 2u;
        if (!(den > 0.f) || !(den < 1e30f)) nb |= 4u;
        if (!(m > -1e30f) || !(m < 1e30f)) nb |= 8u;
        if (lane == 0 && (slot == 1 || slot == 2)) atomicOr(fw + 4 + slot, nb);
    }
}
DEVI void phase_check_final(const Params& p) {
    const unsigned* fw = (unsigned*)(p.ws + WS_CTL) + CK_FLAG_WORD;
    unsigned fa = __hip_atomic_load(fw + 1, __ATOMIC_RELAXED, __HIP_MEMORY_SCOPE_AGENT), fb = __hip_atomic_load(fw + 2, __ATOMIC_RELAXED, __HIP_MEMORY_SCOPE_AGENT);
    const unsigned fd = __hip_atomic_load(fw + 3, __ATOMIC_RELAXED, __HIP_MEMORY_SCOPE_AGENT), fm = __hip_atomic_load(fw + 4, __ATOMIC_RELAXED, __HIP_MEMORY_SCOPE_AGENT), f0 = __hip_atomic_load(fw, __ATOMIC_RELAXED, __HIP_MEMORY_SCOPE_AGENT);
    unsigned flag = fa | (fb << 3);
    if (fd > 1u || fm > 1u || f0 != 0u) flag = 100u + (fd > 1u ? 1u : 0u) + (fm > 1u ? 2u : 0u) + (f0 ? 4u : 0u);
    if (flag > 127u) flag = 127u;
    const size_t n = (size_t)flag * 128 * DM;
    for (size_t i = (size_t)obid() * NTHREADS + otid(); i < n; i += (size_t)ogrid() * NTHREADS) p.out[i] = 0.f;
}
#endif

DEVI void route_tile(const bf16_t* PQ, const bf16_t* KEYS_, int tile, int hd, LAS unsigned char* slot, LAS int* idxl, LAS float* gatl, int r, int hi) {
    const int t = tile * 32 + r;
    int koff = r * 64 + hi * 8; asm volatile("" : "+v"(koff));
    const bf16_t* KEYS = KEYS_ + koff;
    {
        unsigned s[2][16];
#pragma unroll
        for (int c = 0; c < 2; ++c) {
            const int hc = hd * 2 + c;
            bf16x8 qf[4];
#pragma unroll
            for (int ks = 0; ks < 4; ++ks) qf[ks] = *(const bf16x8*)(PQ + (size_t)t * DM + hc * 64 + ks * 16 + hi * 8);
            unsigned g[4][16];
#pragma unroll
            for (int kb = 0; kb < 4; ++kb) {
                f32x16 acc;
#pragma unroll
                for (int q = 0; q < 16; ++q) acc[q] = 0.f;
#pragma unroll
                for (int ks = 0; ks < 4; ++ks) {
                    const bf16x8 kf = *(const bf16x8*)(KEYS + ((size_t)hc * 128 + kb * 32) * 64 + ks * 16);
                    acc = __builtin_amdgcn_mfma_f32_32x32x16_bf16(kf, qf[ks], acc, 0, 0, 0);
                }
#pragma unroll
                for (int q = 0; q < 16; ++q) {
                    const unsigned low = 127u - (unsigned)(kb * 32 + (q & 3) + 8 * (q >> 2));
                    g[kb][q] = (f2ord(acc[q]) & ~127u) | low;
                }
            }
            top16_of_64(g[0], g[1], g[2], g[3]);
            unsigned lo_[16], hi_[16];
#pragma unroll
            for (int i = 0; i < 16; ++i) {
                const unsigned v = g[0][i] ^ (unsigned)(hi << 2);
                auto rr = __builtin_amdgcn_permlane32_swap(v, v, false, false);
                lo_[i] = rr[0]; hi_[i] = rr[1];
            }
            merge16_desc(lo_, hi_);
#pragma unroll
            for (int i = 0; i < 16; ++i) s[c][i] = lo_[i];
        }
        float f0[16], f1[16];
#pragma unroll
        for (int i = 0; i < 16; ++i) {
            slot[i * 64] = (unsigned char)(127u - (s[0][i] & 127u));
            slot[(16 + i) * 64] = (unsigned char)(127u - (s[1][i] & 127u));
            f0[i] = ord2f(s[0][i] & ~127u); f1[i] = ord2f(s[1][i] & ~127u);
        }
        unsigned cd[4][16];
        {
#define CAND(i, j) ((f2ord(f0[i] + f1[j]) & ~255u) | (unsigned)(255 - ((i) * 16 + (j))))
            cd[0][0] = CAND(0, 0);
            cd[0][1] = CAND(0, 1);
            cd[0][2] = CAND(0, 2);
            cd[0][3] = CAND(0, 3);
            cd[0][4] = CAND(0, 4);
            cd[0][5] = CAND(0, 5);
            cd[0][6] = CAND(0, 6);
            cd[0][7] = CAND(0, 7);
            cd[0][8] = CAND(0, 8);
            cd[0][9] = CAND(0, 9);
            cd[0][10] = CAND(0, 10);
            cd[0][11] = CAND(0, 11);
            cd[0][12] = CAND(0, 12);
            cd[0][13] = CAND(0, 13);
            cd[0][14] = CAND(0, 14);
            cd[0][15] = CAND(0, 15);
            cd[1][0] = CAND(1, 0);
            cd[1][1] = CAND(1, 1);
            cd[1][2] = CAND(1, 2);
            cd[1][3] = CAND(1, 3);
            cd[1][4] = CAND(1, 4);
            cd[1][5] = CAND(1, 5);
            cd[1][6] = CAND(1, 6);
            cd[1][7] = CAND(1, 7);
            cd[1][8] = CAND(2, 0);
            cd[1][9] = CAND(2, 1);
            cd[1][10] = CAND(2, 2);
            cd[1][11] = CAND(2, 3);
            cd[1][12] = CAND(2, 4);
            cd[1][13] = CAND(3, 0);
            cd[1][14] = CAND(3, 1);
            cd[1][15] = CAND(3, 2);
            cd[2][0] = CAND(3, 3);
            cd[2][1] = CAND(4, 0);
            cd[2][2] = CAND(4, 1);
            cd[2][3] = CAND(4, 2);
            cd[2][4] = CAND(5, 0);
            cd[2][5] = CAND(5, 1);
            cd[2][6] = CAND(6, 0);
            cd[2][7] = CAND(6, 1);
            cd[2][8] = CAND(7, 0);
            cd[2][9] = CAND(7, 1);
            cd[2][10] = CAND(8, 0);
            cd[2][11] = CAND(9, 0);
            cd[2][12] = CAND(10, 0);
            cd[2][13] = CAND(11, 0);
            cd[2][14] = CAND(12, 0);
            cd[2][15] = CAND(13, 0);
            cd[3][0] = CAND(14, 0);
            cd[3][1] = CAND(15, 0);
            cd[3][2] = 0u;
            cd[3][3] = 0u;
            cd[3][4] = 0u;
            cd[3][5] = 0u;
            cd[3][6] = 0u;
            cd[3][7] = 0u;
            cd[3][8] = 0u;
            cd[3][9] = 0u;
            cd[3][10] = 0u;
            cd[3][11] = 0u;
            cd[3][12] = 0u;
            cd[3][13] = 0u;
            cd[3][14] = 0u;
            cd[3][15] = 0u;
#undef CAND
        }
        top16_of_64(cd[0], cd[1], cd[2], cd[3]);
        float val[16], e[16]; float sum = 0.f;
#pragma unroll
        for (int k = 0; k < 16; ++k) { val[k] = ord2f(cd[0][k] & ~255u); e[k] = __expf(val[k] - val[0]); sum += e[k]; }
        const float inv = 1.f / sum;
        asm volatile("s_waitcnt lgkmcnt(0)" ::: "memory");
        int id[8]; float gt[8];
#pragma unroll
        for (int k = 0; k < 8; ++k) {
            const unsigned mh = (unsigned)(-hi);
            const unsigned key = (cd[0][8 + k] & mh) | (cd[0][k] & ~mh);
            const float ek = __uint_as_float((__float_as_uint(e[8 + k]) & mh) | (__float_as_uint(e[k]) & ~mh));
            const unsigned code = 255u - (key & 255u);
            const unsigned i0 = slot[(code >> 4) * 64], i1 = slot[(16 + (code & 15)) * 64];
            id[k] = (int)(i0 * 128u + i1); gt[k] = ek * inv;
        }
        LAS int* ip = idxl + r * 128 + hd * 16 + hi * 8;
        LAS float* gp = gatl + r * 128 + hd * 16 + hi * 8;
        *(LAS u32x4*)(ip) = (u32x4){(unsigned)id[0], (unsigned)id[1], (unsigned)id[2], (unsigned)id[3]}; *(LAS u32x4*)(ip + 4) = (u32x4){(unsigned)id[4], (unsigned)id[5], (unsigned)id[6], (unsigned)id[7]};
        *(LAS f32x4*)(gp) = (f32x4){gt[0], gt[1], gt[2], gt[3]}; *(LAS f32x4*)(gp + 4) = (f32x4){gt[4], gt[5], gt[6], gt[7]};
        asm volatile("s_waitcnt lgkmcnt(0)" ::: "memory");
    }
}
DEVI void phase_peer(const Params& p, int layer, float* hout, const float* next_gain, lchar* lds) {
    const int tid = otid(), lane = tid & 63, wid = tid >> 6, r = lane & 31, hi = lane >> 5;
    const bf16_t* PQ = (const bf16_t*)(p.ws + WS_PQ);
    const bf16_t* KEYS = (const bf16_t*)(p.ws + WS_KEYS) + (size_t)layer * 16 * 128 * 64;
    bf16_t* HN = (bf16_t*)(p.ws + WS_HN);
    const unsigned char* PU = p.ws + WS_PU;
    const unsigned char* PV = p.ws + WS_PV;
    const float* US = (const float*)(p.ws + WS_US);
    const float* VS = (const float*)(p.ws + WS_VS);
    LAS unsigned char* slot = (LAS unsigned char*)(lds + wid * 2048) + lane;
    LAS int* idxl = (LAS int*)(lds + 16384);
    LAS float* gatl = (LAS float*)(lds + 32768);
    const unsigned m5 = (unsigned)(-((lane >> 5) & 1)), m4 = (unsigned)(-((lane >> 4) & 1)), m3 = (unsigned)(-((lane >> 3) & 1));
#if EXPERT_FP4
    constexpr int EG = 16;
    const unsigned m2 = (unsigned)(-((lane >> 2) & 1));
    const int je = ((lane >> 5) & 1) * 8 + ((lane >> 4) & 1) * 4 + ((lane >> 3) & 1) * 2 + ((lane >> 2) & 1);
#else
    constexpr int EG = 8;
    const int je = ((lane >> 5) & 1) * 4 + ((lane >> 4) & 1) * 2 + ((lane >> 3) & 1);
#endif
    for (int tile = obid(); tile < 512; tile += ogrid()) {
        __syncthreads();
        route_tile(PQ, KEYS, tile, wid, slot, idxl, gatl, r, hi);
        __builtin_amdgcn_sched_barrier(0);
        __syncthreads();
        __builtin_amdgcn_sched_barrier(0);
#pragma unroll 1
        for (int tt = 0; tt < 4; ++tt) {
            const int row = wid * 4 + tt, t = tile * 32 + row;
            const u32x4 xa = *(const u32x4*)(HN + (size_t)t * DM + 16 * lane), xb = *(const u32x4*)(HN + (size_t)t * DM + 16 * lane + 8);
#if EXPERT_FP4
            unsigned xhw[2], xlw[2]; float xs;
            {
                const float xv[16] = {bflo(xa.x), bfhi(xa.x), bflo(xa.y), bfhi(xa.y), bflo(xa.z), bfhi(xa.z), bflo(xa.w), bfhi(xa.w),
                                      bflo(xb.x), bfhi(xb.x), bflo(xb.y), bfhi(xb.y), bflo(xb.z), bfhi(xb.z), bflo(xb.w), bfhi(xb.w)};
                float mx = 0.f;
#pragma unroll
                for (int i = 0; i < 16; ++i) mx = fmaxf(mx, fabsf(xv[i]));
                mx = wave_max(mx);
                xs = mx * (1.f / 119.f);
                const float inv = mx > 0.f ? 119.f / mx : 0.f;
#pragma unroll
                for (int j = 0; j < 2; ++j) {
                    unsigned wh = 0u, wl = 0u;
#pragma unroll
                    for (int e = 0; e < 8; ++e) {
                        const int q = (int)__builtin_rintf(xv[8 * j + e] * inv);
                        const int ql = ((q + 8) & 15) - 8, qh = (q - ql) >> 4;
                        wl |= ((unsigned)ql & 15u) << (4 * e); wh |= ((unsigned)qh & 15u) << (4 * e);
                    }
                    xhw[j] = wh; xlw[j] = wl;
                }
            }
#else
            const f32x2 x2[8] = {{bflo(xa.x), bfhi(xa.x)}, {bflo(xa.y), bfhi(xa.y)}, {bflo(xa.z), bfhi(xa.z)}, {bflo(xa.w), bfhi(xa.w)},
                                 {bflo(xb.x), bfhi(xb.x)}, {bflo(xb.y), bfhi(xb.y)}, {bflo(xb.z), bfhi(xb.z)}, {bflo(xb.w), bfhi(xb.w)}};
#endif
            const int e_lo = idxl[row * 128 + lane], e_hi = idxl[row * 128 + 64 + lane];
            const float g_lo = gatl[row * 128 + lane], g_hi = gatl[row * 128 + 64 + lane];
#if EXPERT_FP4
            f32x16 c0, c1;
    #pragma unroll
            for (int i = 0; i < 16; ++i) { c0[i] = 0.f; c1[i] = 0.f; }
            const int colj = lane & 31;
            unsigned bmask[8];
    #pragma unroll
            for (int v = 0; v < 8; ++v) bmask[v] = ((colj < 16) && ((v >> 2) == (colj >> 3)) && ((v & 1) == ((colj >> 2) & 1))) ? (0xFFu << (8 * (colj & 3))) : 0u;
            const bool upper = lane >= 32;
#define PEER_LOADG(E0, UW, VX, VY) do { const int es_ = ((E0) < 64) ? e_lo : e_hi; \
        _Pragma("unroll") for (int j = 0; j < 16; ++j) { const int ex = __builtin_amdgcn_readlane(es_, ((E0) + j) & 63); \
            UW[j] = *(const u32x2*)(PU + (size_t)ex * 512 + 8 * lane); VX[j] = *(const unsigned*)(PV + (size_t)ex * 512 + 4 * lane); VY[j] = *(const unsigned*)(PV + (size_t)ex * 512 + 256 + 4 * lane); } } while (0)
#define PEER_COMPUTE(E0, UW, VX, VY) do { const int esel = ((E0) < 64) ? e_lo : e_hi; const float gsel = ((E0) < 64) ? g_lo : g_hi; \
                const int my_e = bperm(esel, ((E0) + je) & 63); \
                const float my_g = bpermf(gsel, ((E0) + je) & 63); \
                const float my_us = US[my_e], my_vs = VS[my_e]; \
                float dt[16]; \
        _Pragma("unroll") \
                for (int j = 0; j < 16; ++j) { \
                    int ah = __builtin_amdgcn_sdot8((int)UW[j].x, (int)xhw[0], 0, false); ah = __builtin_amdgcn_sdot8((int)UW[j].y, (int)xhw[1], ah, false); \
                    int al = __builtin_amdgcn_sdot8((int)UW[j].x, (int)xlw[0], 0, false); al = __builtin_amdgcn_sdot8((int)UW[j].y, (int)xlw[1], al, false); \
                    dt[j] = (float)((ah << 4) + al); \
                } \
                float d8[8], d4[4], d2[2]; \
        _Pragma("unroll") \
                for (int i = 0; i < 8; ++i) { \
                    const float snd = blendf(dt[i + 8], dt[i], m5); \
                    auto rr = __builtin_amdgcn_permlane32_swap(__float_as_uint(snd), __float_as_uint(snd), false, false); \
                    d8[i] = blendf(dt[i], dt[i + 8], m5) + blendf(__uint_as_float(rr[1]), __uint_as_float(rr[0]), m5); \
                } \
        _Pragma("unroll") \
                for (int i = 0; i < 4; ++i) d4[i] = blendf(d8[i], d8[i + 4], m4) + swz_xor16(blendf(d8[i + 4], d8[i], m4)); \
        _Pragma("unroll") \
                for (int i = 0; i < 2; ++i) d2[i] = blendf(d4[i], d4[i + 2], m3) + dppf<0x128>(blendf(d4[i + 2], d4[i], m3)); \
                float d1 = blendf(d2[0], d2[1], m2) + swz_xor4(blendf(d2[1], d2[0], m2)); \
                d1 += dppf<0x4E>(d1); d1 += dppf<0xB1>(d1); \
                const float dd = d1 * (my_us * xs); \
                const float a = 0.5f * dd * (1.f + erff(dd * 0.7071067811865476f)) * my_g * my_vs; \
                const int a8 = __builtin_amdgcn_cvt_pk_fp8_f32(a * 128.f, 0.f, 0, false) & 0xff; \
        _Pragma("unroll") \
                for (int qd = 0; qd < 4; ++qd) { \
                    unsigned rq[4]; \
        _Pragma("unroll") \
                    for (int q = 0; q < 4; ++q) { \
                        const int j = 4 * qd + q; \
                        const int src = ((j >> 3) & 1) * 32 + ((j >> 2) & 1) * 16 + ((j >> 1) & 1) * 8 + (j & 1) * 4; \
                        rq[q] = (unsigned)__builtin_amdgcn_readlane(a8, src) * 0x01010101u; \
                    } \
                    const unsigned rep0 = upper ? rq[2] : rq[0], rep1 = upper ? rq[3] : rq[1]; \
                    i32x8 bop; \
        _Pragma("unroll") \
                    for (int v = 0; v < 8; ++v) bop[v] = (int)((((v >> 1) & 1) ? rep1 : rep0) & bmask[v]); \
                    const i32x8 a0 = {(int)VX[4 * qd], (int)VX[4 * qd + 1], (int)VX[4 * qd + 2], (int)VX[4 * qd + 3], 0, 0, 0, 0}; \
                    const i32x8 a1 = {(int)VY[4 * qd], (int)VY[4 * qd + 1], (int)VY[4 * qd + 2], (int)VY[4 * qd + 3], 0, 0, 0, 0}; \
                    c0 = __builtin_amdgcn_mfma_scale_f32_32x32x64_f8f6f4(a0, bop, c0, 4, 0, 0, 0, 0, 0); \
                    c1 = __builtin_amdgcn_mfma_scale_f32_32x32x64_f8f6f4(a1, bop, c1, 4, 0, 0, 0, 0, 0); \
                } \
    } while (0)
            u32x2 uwa[16], uwb[16]; unsigned vxs[16], vys[16];
#define PEER_LOADU(E0, UW) do { const int es_ = ((E0) < 64) ? e_lo : e_hi; \
        _Pragma("unroll") for (int j = 0; j < 16; ++j) { const int ex = __builtin_amdgcn_readlane(es_, ((E0) + j) & 63); UW[j] = *(const u32x2*)(PU + (size_t)ex * 512 + 8 * lane); } } while (0)
#define PEER_LOADV(E0) do { const int es_ = ((E0) < 64) ? e_lo : e_hi; \
        _Pragma("unroll") for (int j = 0; j < 16; ++j) { const int ex = __builtin_amdgcn_readlane(es_, ((E0) + j) & 63); \
            vxs[j] = *(const unsigned*)(PV + (size_t)ex * 512 + 4 * lane); vys[j] = *(const unsigned*)(PV + (size_t)ex * 512 + 256 + 4 * lane); } } while (0)
            PEER_LOADU(0, uwa);
    #pragma unroll 1
            for (int e0 = 0; e0 < 128; e0 += 32) {
                PEER_LOADV(e0); PEER_LOADU(e0 + 16, uwb);
                __builtin_amdgcn_sched_barrier(0);
                PEER_COMPUTE(e0, uwa, vxs, vys);
                __builtin_amdgcn_sched_barrier(0);
                PEER_LOADV(e0 + 16); if (e0 + 32 < 128) PEER_LOADU(e0 + 32, uwa);
                __builtin_amdgcn_sched_barrier(0);
                PEER_COMPUTE(e0 + 16, uwb, vxs, vys);
                __builtin_amdgcn_sched_barrier(0);
            }
#undef PEER_LOADU
#undef PEER_LOADV
#undef PEER_LOADG
#undef PEER_COMPUTE
            f32x2 acc2[8];
            {
                LAS float* strip = (LAS float*)(lds + 65536 + wid * 4096);
                if (colj < 16) {
    #pragma unroll
                    for (int rg = 0; rg < 16; ++rg) {
                        const int L = (rg & 3) + 8 * (rg >> 2) + 4 * (lane >> 5) + 32 * (colj >> 3);
                        strip[8 * L + (colj & 7)] = c0[rg]; strip[512 + 8 * L + (colj & 7)] = c1[rg];
                    }
                }
                asm volatile("s_waitcnt lgkmcnt(0)" ::: "memory");
    #pragma unroll
                for (int i = 0; i < 4; ++i) {
                    const f32x4 v = *(const LAS f32x4*)(strip + 16 * lane + 4 * i);
                    acc2[2 * i] = (f32x2){v.x * (1.f / 128.f), v.y * (1.f / 128.f)}; acc2[2 * i + 1] = (f32x2){v.z * (1.f / 128.f), v.w * (1.f / 128.f)};
                }
                asm volatile("s_waitcnt lgkmcnt(0)" ::: "memory");
            }
#else
            f32x2 acc2[8];
    #pragma unroll
            for (int i = 0; i < 8; ++i) acc2[i] = (f32x2){0.f, 0.f};
    #pragma unroll 1
            for (int e0 = 0; e0 < 128; e0 += EG) {
                const int esel = (e0 < 64) ? e_lo : e_hi;
                const float gsel = (e0 < 64) ? g_lo : g_hi;
    #if EXPERT_FP4
                u32x2 uw[EG], vw[EG];
    #pragma unroll
                for (int j = 0; j < EG; ++j) {
                    const int ex = __builtin_amdgcn_readlane(esel, (e0 + j) & 63);
                    uw[j] = *(const u32x2*)(PU + (size_t)ex * 512 + 8 * lane);
                    vw[j] = *(const u32x2*)(PV + (size_t)ex * 512 + 8 * lane);
                }
    #define EXP_DECODE fp4x16_to_pairs
    #else
                u32x4 uw[EG], vw[EG];
    #pragma unroll
                for (int j = 0; j < EG; ++j) {
                    const int ex = __builtin_amdgcn_readlane(esel, (e0 + j) & 63);
                    uw[j] = *(const u32x4*)(PU + (size_t)ex * 1024 + 16 * lane);
                    vw[j] = *(const u32x4*)(PV + (size_t)ex * 1024 + 16 * lane);
                }
    #define EXP_DECODE fp8x16_to_pairs
    #endif
                const int my_e = bperm(esel, (e0 + je) & 63);
                const float my_g = bpermf(gsel, (e0 + je) & 63);
                const float my_us = US[my_e], my_vs = VS[my_e];
                float dt[EG];
    #pragma unroll
                for (int j = 0; j < EG; ++j) {
    #if EXPERT_FP4
                    int ah = __builtin_amdgcn_sdot8((int)uw[j].x, (int)xhw[0], 0, false); ah = __builtin_amdgcn_sdot8((int)uw[j].y, (int)xhw[1], ah, false);
                    int al = __builtin_amdgcn_sdot8((int)uw[j].x, (int)xlw[0], 0, false); al = __builtin_amdgcn_sdot8((int)uw[j].y, (int)xlw[1], al, false);
                    dt[j] = (float)((ah << 4) + al);
    #else
                    f32x2 f[8]; EXP_DECODE(uw[j], f);
                    f32x2 d2 = f[0] * x2[0];
    #pragma unroll
                    for (int i = 1; i < 8; ++i) d2 += f[i] * x2[i];
                    dt[j] = d2.x + d2.y;
    #endif
                }
                float d4[4], d2[2];
    #if EXPERT_FP4
                float d8[8];
    #pragma unroll
                for (int i = 0; i < 8; ++i) {
                    const float snd = blendf(dt[i + 8], dt[i], m5);
                    auto rr = __builtin_amdgcn_permlane32_swap(__float_as_uint(snd), __float_as_uint(snd), false, false);
                    d8[i] = blendf(dt[i], dt[i + 8], m5) + blendf(__uint_as_float(rr[1]), __uint_as_float(rr[0]), m5);
                }
    #pragma unroll
                for (int i = 0; i < 4; ++i) d4[i] = blendf(d8[i], d8[i + 4], m4) + swz_xor16(blendf(d8[i + 4], d8[i], m4));
    #pragma unroll
                for (int i = 0; i < 2; ++i) d2[i] = blendf(d4[i], d4[i + 2], m3) + dppf<0x128>(blendf(d4[i + 2], d4[i], m3));
                float d1 = blendf(d2[0], d2[1], m2) + swz_xor4(blendf(d2[1], d2[0], m2));
                d1 += dppf<0x4E>(d1); d1 += dppf<0xB1>(d1);
    #else
    #pragma unroll
                for (int i = 0; i < 4; ++i) {
                    const float snd = blendf(dt[i + 4], dt[i], m5);
                    auto rr = __builtin_amdgcn_permlane32_swap(__float_as_uint(snd), __float_as_uint(snd), false, false);
                    d4[i] = blendf(dt[i], dt[i + 4], m5) + blendf(__uint_as_float(rr[1]), __uint_as_float(rr[0]), m5);
                }
    #pragma unroll
                for (int i = 0; i < 2; ++i) d2[i] = blendf(d4[i], d4[i + 2], m4) + swz_xor16(blendf(d4[i + 2], d4[i], m4));
                float d1 = blendf(d2[0], d2[1], m3) + dppf<0x128>(blendf(d2[1], d2[0], m3));
                d1 += swz_xor4(d1); d1 += dppf<0x4E>(d1); d1 += dppf<0xB1>(d1);
    #endif
    #if EXPERT_FP4
                const float dd = d1 * (my_us * xs);
    #else
                const float dd = d1 * my_us;
    #endif
                const float a = 0.5f * dd * (1.f + erff(dd * 0.7071067811865476f)) * my_g * my_vs;
    #pragma unroll
                for (int j = 0; j < EG; ++j) {
    #if EXPERT_FP4
                    const int src = ((j >> 3) & 1) * 32 + ((j >> 2) & 1) * 16 + ((j >> 1) & 1) * 8 + (j & 1) * 4;
    #else
                    const int src = ((j >> 2) & 1) * 32 + ((j >> 1) & 1) * 16 + (j & 1) * 8;
    #endif
                    const float aj = __uint_as_float(__builtin_amdgcn_readlane(__float_as_uint(a), src));
                    f32x2 f[8]; EXP_DECODE(vw[j], f);
                    const f32x2 aj2 = {aj, aj};
    #pragma unroll
                    for (int i = 0; i < 8; ++i) acc2[i] += aj2 * f[i];
                }
            }
#endif
            float* hr = hout + (size_t)t * DM + 16 * lane;
#if ATTN_PROBE == 9
            { const float fsc = 1.f + (float)((const unsigned*)(p.ws + WS_CTL))[3996];
              _Pragma("unroll") for (int i = 0; i < 8; ++i) acc2[i] = acc2[i] * (f32x2){1.f, 1.f} + (f32x2){0.f, 0.f};
              if (layer == 1) { _Pragma("unroll") for (int i = 0; i < 8; ++i) acc2[i] = acc2[i] * (f32x2){fsc, fsc}; } }
#endif
            f32x4 hv[4]; float ss = 0.f;
    #pragma unroll
            for (int j = 0; j < 4; ++j) {
                hv[j] = *(f32x4*)(hr + 4 * j);
                hv[j] += (f32x4){acc2[2 * j].x, acc2[2 * j].y, acc2[2 * j + 1].x, acc2[2 * j + 1].y};
                *(f32x4*)(hr + 4 * j) = hv[j];
                ss += (hv[j].x * hv[j].x + hv[j].y * hv[j].y) + (hv[j].z * hv[j].z + hv[j].w * hv[j].w);
            }
            if (next_gain) {
                const float rstd = rsqrtf(wave_sum(ss) * (1.f / DM) + EPS);
                u32x4 o0, o1;
                const f32x4 g0 = *(const f32x4*)(next_gain + 16 * lane), g1 = *(const f32x4*)(next_gain + 16 * lane + 4), g2 = *(const f32x4*)(next_gain + 16 * lane + 8), g3 = *(const f32x4*)(next_gain + 16 * lane + 12);
                o0.x = pk2(hv[0].x * rstd * g0.x, hv[0].y * rstd * g0.y); o0.y = pk2(hv[0].z * rstd * g0.z, hv[0].w * rstd * g0.w);
                o0.z = pk2(hv[1].x * rstd * g1.x, hv[1].y * rstd * g1.y); o0.w = pk2(hv[1].z * rstd * g1.z, hv[1].w * rstd * g1.w);
                o1.x = pk2(hv[2].x * rstd * g2.x, hv[2].y * rstd * g2.y); o1.y = pk2(hv[2].z * rstd * g2.z, hv[2].w * rstd * g2.w);
                o1.z = pk2(hv[3].x * rstd * g3.x, hv[3].y * rstd * g3.y); o1.w = pk2(hv[3].z * rstd * g3.z, hv[3].w * rstd * g3.w);
                *(u32x4*)(HN + (size_t)t * DM + 16 * lane) = o0; *(u32x4*)(HN + (size_t)t * DM + 16 * lane + 8) = o1;
            }
        }
    }
}
#define XB_TMO      128
#define XB_XCNT(j)  (256  + 64 * (j))
#define XB_XSUB(j)  (1280 + 64 * (j))
#define XB_XGEN(j)  (2304 + 64 * (j))
#define XB_TOP      3328
#define XB_TOPGEN   3392
#define XCD_BAR_WORDS 3456
#define XB_SPIN_CAP (1u << 18)
DEVI unsigned xb_ld(unsigned* p)              { return __hip_atomic_load(p, __ATOMIC_RELAXED, __HIP_MEMORY_SCOPE_AGENT); }
DEVI unsigned xb_add(unsigned* p, unsigned v) { return __hip_atomic_fetch_add(p, v, __ATOMIC_RELAXED, __HIP_MEMORY_SCOPE_AGENT); }
DEVI unsigned xb_xcc_id() { return (unsigned)__builtin_amdgcn_s_getreg((3 << 11) | 20) & 0xFu; }
#define XB_SPIN(cond, bar) do { unsigned _sp = 0; while (cond) { __builtin_amdgcn_s_sleep(1); \
    if ((++_sp & 255u) == 0u) { if (xb_ld(&(bar)[XB_TMO])) break; if (_sp > XB_SPIN_CAP) { atomicAdd(&(bar)[XB_TMO], 1u); break; } } } } while (0)
struct XcdBarrier { unsigned* bar; unsigned x; volatile LAS unsigned* st; };
DEVI XcdBarrier xcd_barrier_post(unsigned* bar, volatile LAS unsigned* st) {
    XcdBarrier b; b.bar = bar; b.x = xb_xcc_id(); b.st = st;
    if (otid() == 0) (void)xb_add(&bar[XB_XCNT(b.x)], 1u);
    return b;
}
DEVI void xcd_barrier_complete(unsigned* bar, unsigned x, unsigned& nloc, unsigned& nx) {
    const unsigned G = gridDim.x * gridDim.y * gridDim.z;
    unsigned sum, cnt, mine, sp = 0u;
    for (;;) {
        sum = 0u; cnt = 0u; mine = 0u;
#pragma unroll
        for (unsigned j = 0; j < 16; ++j) { const unsigned c = xb_ld(&bar[XB_XCNT(j)]); sum += c; cnt += (c > 0u) ? 1u : 0u; mine = (j == x) ? c : mine; }
        if (sum == G) break;
        __builtin_amdgcn_s_sleep(1);
        if ((++sp & 255u) == 0u) { if (xb_ld(&bar[XB_TMO])) break; if (sp > XB_SPIN_CAP) { atomicAdd(&bar[XB_TMO], 1u); break; } }
    }
    nloc = mine > 0u ? mine : 1u; nx = cnt > 0u ? cnt : 1u;
}
DEVI void xcd_barrier(const XcdBarrier& b) {
    asm volatile("s_waitcnt vmcnt(0)" ::: "memory");
    __syncthreads();
    if (otid() == 0) {
        unsigned* bar = b.bar;
        __builtin_amdgcn_s_waitcnt(0);
        unsigned nloc = b.st[0], nx = b.st[1];
        if (nloc == 0u) { xcd_barrier_complete(bar, b.x, nloc, nx); b.st[0] = nloc; b.st[1] = nx; }
        const unsigned old = xb_add(&bar[XB_XSUB(b.x)], 1u);
        const unsigned gen = old / nloc;
        if (old + 1u == (gen + 1u) * nloc) {
            __builtin_amdgcn_fence(__ATOMIC_RELEASE, "agent");
            asm volatile("s_waitcnt vmcnt(0)" ::: "memory");
            const unsigned og = xb_add(&bar[XB_TOP], 1u);
            const unsigned tg = og / nx;
            if (og + 1u == (tg + 1u) * nx) xb_add(&bar[XB_TOPGEN], 1u);
            else XB_SPIN(xb_ld(&bar[XB_TOPGEN]) == tg, bar);
            __builtin_amdgcn_fence(__ATOMIC_ACQUIRE, "agent");
            xb_add(&bar[XB_XGEN(b.x)], 1u);
            asm volatile("s_waitcnt vmcnt(0)" ::: "memory");
        } else {
            XB_SPIN(xb_ld(&bar[XB_XGEN(b.x)]) == gen, bar);
            __builtin_amdgcn_fence(__ATOMIC_ACQUIRE, "agent");
            asm volatile("s_waitcnt vmcnt(0)" ::: "memory");
        }
    }
    __syncthreads();
}
constexpr int LDS_ST_OFF = LDS_BYTES - 16;

typedef const __attribute__((address_space(4))) Params* kparams_t;
#define KP() ({ kparams_t q_ = (kparams_t)__builtin_amdgcn_kernarg_segment_ptr(); asm volatile("" : "+s"(q_)); q_; })
#define KTEST(HID, B1, B2) if (bad == 12) { int fails = 0; \
                _Pragma("unroll") for (int q = 0; q < 4; ++q) _Pragma("unroll") for (int n = 0; n < 8; ++n) { \
                    i32x8 av = {0, 0, 0, 0, 0, 0, 0, 0}, bv = {0, 0, 0, 0, 0, 0, 0, 0}; \
                    av[q] = 0x2 << (4 * n); \
                    bv[(B1) >> 2] |= 0x38 << (8 * ((B1) & 3)); if ((B2) != (B1)) bv[(B2) >> 2] |= 0x38 << (8 * ((B2) & 3)); \
                    f32x16 cz; _Pragma("unroll") for (int i = 0; i < 16; ++i) cz[i] = 0.f; \
                    cz = __builtin_amdgcn_mfma_scale_f32_32x32x64_f8f6f4(av, bv, cz, 4, 0, 0, 0, 0, 0); \
                    bool ok = true; _Pragma("unroll") for (int i = 0; i < 16; ++i) ok = ok && (cz[i] == 2.f); \
                    if (__any(!ok)) fails += 1; } \
                if (fails == 0) bad = (HID); }

#define KVAL(Q, N, BB, W) { i32x8 av = {0, 0, 0, 0, 0, 0, 0, 0}, bv = {0, 0, 0, 0, 0, 0, 0, 0}; av[Q] = 0x2 << (4 * (N)); bv[(BB) >> 2] = 0x38 << (8 * ((BB) & 3)); \
    f32x16 cz; _Pragma("unroll") for (int i = 0; i < 16; ++i) cz[i] = 0.f; \
    cz = __builtin_amdgcn_mfma_scale_f32_32x32x64_f8f6f4(av, bv, cz, 4, 0, 0, 0, 0, 0); \
    const float v0 = __builtin_amdgcn_readfirstlane(cz[0]); code += (W) * (v0 == 0.f ? 0 : (v0 == 1.f ? 1 : (v0 == 2.f ? 2 : 3))); }

template <int ONLY> __global__ void __launch_bounds__(NTHREADS) fwd_kernel(Params p_) {
#if defined(__HIP_DEVICE_COMPILE__)
    extern __shared__ __attribute__((aligned(16))) unsigned char lds_raw[];
    lchar* lds = (lchar*)lds_raw;
    const int ph_lo = p_.ph_lo, ph_hi = p_.ph_hi;
    int ph = 0;
    if ((threadIdx.x & 63) == 0) ((volatile LAS unsigned char*)(WTAB_OFF))[(unsigned)__builtin_amdgcn_s_getreg((5 << 11) | 4) & 63u] = (unsigned char)(threadIdx.x >> 6);
#if MULTI_LAUNCH
    __syncthreads();
#endif
#if MULTI_LAUNCH
#define GRIDSYNC() do { } while (0)
#else
    XcdBarrier xbar; xbar.bar = (unsigned*)(p_.ws + WS_CTL); xbar.x = 0; xbar.st = (volatile LAS unsigned*)(lds + LDS_ST_OFF);
    if (threadIdx.x < 4) ((volatile LAS unsigned*)(lds + LDS_ST_OFF))[threadIdx.x] = 0u;
    if (blockIdx.x == 0) for (int i = threadIdx.x; i < 4096; i += NTHREADS) __hip_atomic_store(xbar.bar + i, 0u, __ATOMIC_RELAXED, __HIP_MEMORY_SCOPE_AGENT);
    __syncthreads();
    bool first_seam = true;
#define GRIDSYNC() do { if (ph + 1 < ph_hi) { if (first_seam) { cg::this_grid().sync(); xbar = xcd_barrier_post((unsigned*)(p_.ws + WS_CTL), (volatile LAS unsigned*)(lds + LDS_ST_OFF)); first_seam = false; } else xcd_barrier(xbar); } } while (0)
#endif
#define PHASE(KS, ...) do { if ((ONLY < 0 || ONLY == (KS)) && ph_lo <= ph && ph < ph_hi) { for (int rep = ((KS) == REPEAT_PHASE ? 0 : 1); rep < 2; ++rep) { const Params p = *KP(); unsigned char* ws = p.ws; __VA_ARGS__; GRIDSYNC(); } } ++ph; } while (0)
#if ATTN_PROBE == 9
    PHASE(0, { phase_prep(p, lds); phase_rownorm(p.in[0], p.in[2], (bf16_t*)(ws + WS_HN));
        if (obid() == 0 && otid() < 64) {
            int bad = 12;
            {
                int code = 0;
                KVAL(2, 0, 0, 1)
                KVAL(1, 0, 0, 4)
                KVAL(0, 0, 16, 16)
                bad = 1 + code;
            }
            if (otid() == 0) ((unsigned*)(p.ws + WS_CTL))[3996] = (unsigned)bad;
        } });
#else
    PHASE(0, { phase_prep(p, lds); phase_rownorm(p.in[0], p.in[2], (bf16_t*)(ws + WS_HN)); });
#endif
#pragma unroll 1
    for (int layer = 0; layer < NLAYER; ++layer) {
        PHASE(2, { Pg8Epi8<EpiInproj8> E{EpiInproj8{(bf16_t*)(ws + WS_G), (bf16_t*)(ws + WS_P), p.in[4] + layer * GW}};
                pg8::Gemm g{(const bf16_t*)(ws + WS_HN), (const bf16_t*)(ws + WS_WIN) + (size_t)layer * INP * DM, S, INP, DM};
                pg8::StaticOrder so; so.init(S, INP, ogrid(), obid());
                pg8::gemm_phase<Pg8Epi8<EpiInproj8>, pg8::StaticOrder, true, true>((LAS unsigned char*)lds, g, so, E); });
        PHASE(3, phase_post1(p, layer, lds));
#if SELFCHECK
        PHASE(15, phase_check1(p, layer));
#endif
        PHASE(4, { EpiBf16 e1{(bf16_t*)(ws + WS_CQRAW), 384};
                gemm_phase<1>((const bf16_t*)(ws + WS_CQN), 256, (const bf16_t*)(ws + WS_WUQ) + (size_t)layer * 384 * 256, 256, 256, 64, 3, e1, lds);
                EpiBf16 e2{(bf16_t*)(ws + WS_CKVRAW), 512};
                gemm_phase<1>((const bf16_t*)(ws + WS_CKVN), 128, (const bf16_t*)(ws + WS_WUKV) + (size_t)layer * 512 * 128, 128, 128, 64, 4, e2, lds); });
        PHASE(5, phase_post2(p, layer, lds));
#if SELFCHECK
        PHASE(16, phase_check2(p, layer));
#endif
        PHASE(6, phase_attention(p, layer, lds));
#if SELFCHECK
        PHASE(17, phase_check3(p, layer, 0));
#endif
        PHASE(7, phase_bmerge(p, layer));
#if SELFCHECK
        PHASE(18, phase_check3(p, layer, 1));
#endif
        PHASE(8, phase_merge((const bf16_t*)(ws + WS_Y), (const bf16_t*)(ws + WS_WBR) + (size_t)layer * 4 * 1024 * 256, (const bf16_t*)(ws + WS_G), (bf16_t*)(ws + WS_MERGED), lds));
        PHASE(9, { EpiResidual e{(layer == 0) ? p.in[0] : p.out, p.out};
                gemm_phase<2>((const bf16_t*)(ws + WS_MERGED), DM, (const bf16_t*)(ws + WS_WOUT) + (size_t)layer * DM * DM, DM, DM, 64, 4, e, lds); });
        PHASE(10, phase_rownorm(p.out, p.in[20] + layer * DM, (bf16_t*)(ws + WS_HN)));
        PHASE(11, { EpiBf16 e{(bf16_t*)(ws + WS_PQ), DM};
                gemm_phase<2>((const bf16_t*)(ws + WS_HN), DM, (const bf16_t*)(ws + WS_WPQ) + (size_t)layer * DM * DM, DM, DM, 64, 4, e, lds); });
        PHASE(14, phase_peer(p, layer, rep == 0 ? (float*)(ws + WS_G) : p.out, (layer + 1 < NLAYER && rep != 0) ? p.in[2] + (layer + 1) * DM : nullptr, lds));
    }
#if SELFCHECK
    PHASE(19, phase_check_final(p));
#endif
#undef PHASE
#undef GRIDSYNC
#endif
}

typedef void (*phase_fn)(Params);
#if MULTI_LAUNCH
static phase_fn phase_kernels[20] = {fwd_kernel<0>, fwd_kernel<1>, fwd_kernel<2>, fwd_kernel<3>, fwd_kernel<4>, fwd_kernel<5>, fwd_kernel<6>, fwd_kernel<7>,
                                     fwd_kernel<8>, fwd_kernel<9>, fwd_kernel<10>, fwd_kernel<11>, fwd_kernel<12>, fwd_kernel<13>, fwd_kernel<14>,
                                     fwd_kernel<15>, fwd_kernel<16>, fwd_kernel<17>, fwd_kernel<18>, fwd_kernel<19>};
#endif
extern "C" void kernel_launch(void* const* d_in, const int* in_sizes, int n_in, void* d_out, int out_size, void* d_ws, size_t ws_size, hipStream_t stream) {
    static int grid = 0;
    if (grid == 0) {
        if (n_in != 25 || ws_size < WS_END) { fprintf(stderr, "kernel_launch: unexpected n_in %d or ws_size %zu\n", n_in, ws_size); grid = -1; return; }
        int dev = 0, cus = 0, per_cu = 0;
        (void)hipGetDevice(&dev);
        (void)hipDeviceGetAttribute(&cus, hipDeviceAttributeMultiprocessorCount, dev);
#if MULTI_LAUNCH
        for (int k = 0; k < 20; ++k) (void)hipFuncSetAttribute((const void*)phase_kernels[k], hipFuncAttributeMaxDynamicSharedMemorySize, LDS_BYTES);
        per_cu = 1;
#else
        (void)hipFuncSetAttribute((const void*)fwd_kernel<-1>, hipFuncAttributeMaxDynamicSharedMemorySize, LDS_BYTES);
        (void)hipOccupancyMaxActiveBlocksPerMultiprocessor(&per_cu, (const void*)fwd_kernel<-1>, NTHREADS, LDS_BYTES);
#endif
        if (per_cu < 1) per_cu = 1;
        grid = cus * 1;
        (void)hipGetLastError();
    }
    if (grid < 0) return;
    Params p{};
    for (int i = 0; i < 25; ++i) p.in[i] = (const float*)d_in[i];
    p.out = (float*)d_out; p.ws = (unsigned char*)d_ws;
#if MULTI_LAUNCH
    for (int ph = 0; ph < N_PHASES; ++ph) {
        p.ph_lo = ph; p.ph_hi = ph + 1;
#if SELFCHECK
        static const int ks_layer[15] = {2, 3, 15, 4, 5, 16, 6, 17, 7, 18, 8, 9, 10, 11, 14};
        const int ks = (ph == 0) ? 0 : (ph == N_PHASES - 1 ? 19 : ks_layer[(ph - 1) % PH_PER_LAYER]);
#else
        static const int ks_layer[11] = {2, 3, 4, 5, 6, 7, 8, 9, 10, 11, 14};
        const int ks = (ph == 0) ? 0 : ks_layer[(ph - 1) % PH_PER_LAYER];
#endif
        void* args[] = {&p};
        (void)hipLaunchKernel((const void*)phase_kernels[ks], dim3(grid), dim3(NTHREADS), args, LDS_BYTES, stream);
    }
#else
    p.ph_lo = 0; p.ph_hi = N_PHASES;
    void* args[] = {&p};
    hipError_t e = hipLaunchCooperativeKernel((const void*)fwd_kernel<-1>, dim3(grid), dim3(NTHREADS), args, LDS_BYTES, stream);
    if (e != hipSuccess) fprintf(stderr, "cooperative launch failed: %s (grid %d)\n", hipGetErrorString(e), grid);
#endif
}
```

```cpp
#include <hip/hip_runtime.h>
#include <hip/hip_cooperative_groups.h>
#include <stdint.h>
#include <stdio.h>
namespace cg = cooperative_groups;

#ifndef MULTI_LAUNCH
#define MULTI_LAUNCH 0
#endif

#ifndef REPEAT_PHASE
#define REPEAT_PHASE -1
#endif
#ifndef SELFCHECK
#define SELFCHECK 0
#endif
#ifndef ATTN_PROBE
#define ATTN_PROBE 0
#endif
#ifndef EXPERT_FP4
#define EXPERT_FP4 1
#endif
#define DEVI __device__ __forceinline__
#define LAS __attribute__((address_space(3)))
#define SBAR() __builtin_amdgcn_sched_barrier(0)
typedef unsigned short bf16_t;
typedef short bf16x8 __attribute__((ext_vector_type(8)));
typedef short s16x4 __attribute__((ext_vector_type(4)));
typedef float f32x16 __attribute__((ext_vector_type(16)));
typedef float f32x4 __attribute__((ext_vector_type(4)));
typedef float f32x2 __attribute__((ext_vector_type(2)));
typedef unsigned u32x4 __attribute__((ext_vector_type(4)));
typedef unsigned u32x2 __attribute__((ext_vector_type(2)));
typedef LAS char lchar;

constexpr int S = 16384, DM = 1024, NLAYER = 2;
constexpr int INW = 7840, INP = 7936, PW = 3840, GW = 4096, NGATE0 = 3744;
constexpr float WIN_SCALE = 32.f;
constexpr int O_AQ = 0, O_AK = 256, O_AV = 384, O_BQ = 512, O_BK = 1280, O_BV = 2048, O_CQ = 2816, O_CKV = 3072, O_CKR = 3200,
              O_DQ = 3232, O_DK = 3488, O_DV = 3616;
constexpr float EPS = 1e-6f;
constexpr float LOG2E = 1.4426950408889634f;
constexpr int NTHREADS = 512, NWAVES = 8;
constexpr int LDS_BYTES = 151552;

constexpr size_t MiB = 1u << 20;
constexpr size_t WS_CTL = 0;
constexpr size_t WS_WIN = 1 * MiB;
constexpr size_t WS_WUQ = 32 * MiB;
constexpr size_t WS_WUKV = 32 * MiB + 512 * 1024;
constexpr size_t WS_WBR = 33 * MiB;
constexpr size_t WS_WOUT = 37 * MiB;
constexpr size_t WS_WPQ = 41 * MiB;
constexpr size_t WS_KEYS = 45 * MiB;
constexpr size_t WS_CQN = 46 * MiB;
constexpr size_t WS_CKVN = 54 * MiB;
constexpr size_t WS_HN = 58 * MiB;
constexpr size_t WS_P = 90 * MiB;
constexpr size_t WS_G = 210 * MiB;
constexpr size_t WS_QKV = 338 * MiB;
constexpr size_t WS_HN8 = 474 * MiB;
constexpr size_t WS_END = 490 * MiB;
constexpr size_t WS_CQRAW = WS_P;
constexpr size_t WS_CKVRAW = WS_P + 12 * MiB;
constexpr size_t WS_OB = WS_P + 28 * MiB;
constexpr size_t WS_LSE = WS_P + 52 * MiB;
constexpr size_t WS_Y = WS_P + 53 * MiB;
constexpr size_t WS_MERGED = WS_P + 85 * MiB;
constexpr size_t WS_PQ = WS_P;
constexpr size_t WS_IDX = WS_P + 32 * MiB;
constexpr size_t WS_GATE = WS_P + 40 * MiB;
constexpr size_t WS_SCORES = WS_G;
constexpr size_t Q_QA = 0, Q_KA = 8 * MiB, Q_VAT = 12 * MiB, Q_QB = 16 * MiB, Q_KB = 40 * MiB, Q_VBT = 64 * MiB, Q_QC = 88 * MiB,
                 Q_KC = 100 * MiB, Q_VCT = 112 * MiB, Q_QD = 120 * MiB, Q_KD = 128 * MiB, Q_VDT = 132 * MiB;
constexpr size_t WS_PU = WS_QKV, WS_PV = WS_QKV + 16 * MiB;
constexpr size_t WS_US = WS_QKV + 32 * MiB, WS_VS = WS_QKV + 32 * MiB + 65536;

struct Params {
    const float* in[25];
    float* out;
    unsigned char* ws;
    int ph_lo, ph_hi;
};

DEVI unsigned pk2(float lo, float hi) {
    typedef __bf16 bf2 __attribute__((ext_vector_type(2)));
    f32x2 v = {lo, hi};
    bf2 b = __builtin_convertvector(v, bf2);
    return __builtin_bit_cast(unsigned, b);
}
DEVI unsigned short f2bf(float f) { return (unsigned short)(pk2(f, 0.f) & 0xffffu); }
DEVI float bf2f(unsigned short b) { return __uint_as_float(((unsigned)b) << 16); }
DEVI float bflo(unsigned w) { return __uint_as_float(w << 16); }
DEVI float bfhi(unsigned w) { return __uint_as_float(w & 0xffff0000u); }
template <int CTRL> DEVI float dppf(float v) { return __uint_as_float((unsigned)__builtin_amdgcn_update_dpp(0, (int)__float_as_uint(v), CTRL, 0xF, 0xF, false)); }
DEVI float swz_xor16(float v) { return __uint_as_float((unsigned)__builtin_amdgcn_ds_swizzle((int)__float_as_uint(v), 0x401F)); }
DEVI float swz_xor4(float v) { return __uint_as_float((unsigned)__builtin_amdgcn_ds_swizzle((int)__float_as_uint(v), 0x101F)); }
DEVI float wave_sum(float v) {
    v += dppf<0xB1>(v);
    v += dppf<0x4E>(v);
    v += dppf<0x141>(v);
    v += dppf<0x140>(v);
    v += swz_xor16(v);
    auto rr = __builtin_amdgcn_permlane32_swap(__float_as_uint(v), __float_as_uint(v), false, false);
    return __uint_as_float(rr[0]) + __uint_as_float(rr[1]);
}
DEVI float wave_max(float v) {
    v = fmaxf(v, dppf<0xB1>(v)); v = fmaxf(v, dppf<0x4E>(v)); v = fmaxf(v, dppf<0x141>(v)); v = fmaxf(v, dppf<0x140>(v));
    v = fmaxf(v, swz_xor16(v));
    auto rr = __builtin_amdgcn_permlane32_swap(__float_as_uint(v), __float_as_uint(v), false, false);
    return fmaxf(__uint_as_float(rr[0]), __uint_as_float(rr[1]));
}
DEVI float half_max(float v) { auto rr = __builtin_amdgcn_permlane32_swap(__float_as_uint(v), __float_as_uint(v), false, false); return fmaxf(__uint_as_float(rr[0]), __uint_as_float(rr[1])); }
DEVI float half_sum(float v) { auto rr = __builtin_amdgcn_permlane32_swap(__float_as_uint(v), __float_as_uint(v), false, false); return __uint_as_float(rr[0]) + __uint_as_float(rr[1]); }
DEVI int bperm(int v, int src_lane) { return __builtin_amdgcn_ds_bpermute(src_lane << 2, v); }
DEVI float bpermf(float v, int src_lane) { return __uint_as_float((unsigned)__builtin_amdgcn_ds_bpermute(src_lane << 2, (int)__float_as_uint(v))); }
constexpr unsigned WTAB_OFF = LDS_BYTES - 16 - 64;
DEVI int owave() { const unsigned key = (unsigned)__builtin_amdgcn_s_getreg((5 << 11) | 4) & 63u;
    return __builtin_amdgcn_readfirstlane((int)((volatile LAS unsigned char*)(WTAB_OFF))[key]); }
DEVI int olane() { unsigned z = 0u; asm volatile("" : "+v"(z)); return (int)__builtin_amdgcn_mbcnt_hi(~0u, __builtin_amdgcn_mbcnt_lo(~0u, z)); }
DEVI int otid() { return owave() * 64 + olane(); }
DEVI int ogrid() { int g = gridDim.x; asm volatile("" : "+v"(g)); return __builtin_amdgcn_readfirstlane(g); }
DEVI int obid() { int b = blockIdx.x; asm volatile("" : "+v"(b)); return __builtin_amdgcn_readfirstlane(b); }
DEVI int crow(int reg, int h) { return (reg & 3) + 8 * (reg >> 2) + 4 * h; }
DEVI float fast_exp2(float x) { return __builtin_amdgcn_exp2f(x); }

template <bool FP8 = false>
DEVI void transpose_item(const float* W, int ldn, int K, bf16_t* WT, int k0, int n0, int drow0, LAS float* scr, int lane) {
    float wv[32];
#pragma unroll
    for (int i = 0; i < 32; ++i) wv[i] = W[(size_t)(k0 + 2 * i + (lane >> 5)) * ldn + n0 + (lane & 31)];
#pragma unroll
    for (int i = 0; i < 32; ++i) scr[(2 * i + (lane >> 5)) * 33 + (lane & 31)] = wv[i];
    asm volatile("s_waitcnt lgkmcnt(0)" ::: "memory");
    const int c = lane & 7;
#pragma unroll
    for (int j = 0; j < 4; ++j) {
        const int n = (lane >> 3) + 8 * j;
        const LAS float* s = scr + (8 * c) * 33 + n;
        if constexpr (FP8) {
            int w0 = __builtin_amdgcn_cvt_pk_fp8_f32(s[0 * 33] * WIN_SCALE, s[1 * 33] * WIN_SCALE, 0, false); w0 = __builtin_amdgcn_cvt_pk_fp8_f32(s[2 * 33] * WIN_SCALE, s[3 * 33] * WIN_SCALE, w0, true);
            int w1 = __builtin_amdgcn_cvt_pk_fp8_f32(s[4 * 33] * WIN_SCALE, s[5 * 33] * WIN_SCALE, 0, false); w1 = __builtin_amdgcn_cvt_pk_fp8_f32(s[6 * 33] * WIN_SCALE, s[7 * 33] * WIN_SCALE, w1, true);
            *(u32x2*)((unsigned char*)WT + (size_t)(drow0 + n) * K + k0 + 8 * c) = (u32x2){(unsigned)w0, (unsigned)w1};
        } else {
            u32x4 o;
            o.x = pk2(s[0 * 33], s[1 * 33]); o.y = pk2(s[2 * 33], s[3 * 33]); o.z = pk2(s[4 * 33], s[5 * 33]); o.w = pk2(s[6 * 33], s[7 * 33]);
            *(u32x4*)(WT + (size_t)(drow0 + n) * K + k0 + 8 * c) = o;
        }
    }
    asm volatile("s_waitcnt lgkmcnt(0)" ::: "memory");
}
template <bool FP8 = false>
DEVI void transpose_matrix(const float* W, int K, int N, bf16_t* WT, bool remap, LAS float* scr, int gw, int ngw, int lane) {
    const int nblk = N / 32, items = (K / 64) * nblk;
    for (int it = gw; it < items; it += ngw) {
        const int kb = it / nblk, nb = it % nblk, n0 = 32 * nb;
        int drow0 = n0;
        if (remap) drow0 = (n0 >= NGATE0) ? (n0 - NGATE0) : (n0 + GW);
        transpose_item<FP8>(W, N, K, WT, 64 * kb, n0, drow0, scr, lane);
    }
}
DEVI void convert_f32_bf16(const float* src, bf16_t* dst, size_t n, size_t gtid, size_t gthreads) {
    for (size_t i = gtid * 4; i < n; i += gthreads * 4) {
        const f32x4 v = *(const f32x4*)(src + i);
        u32x2 o; o.x = pk2(v.x, v.y); o.y = pk2(v.z, v.w);
        *(u32x2*)(dst + i) = o;
    }
}
DEVI void phase_prep(const Params& p, lchar* lds) {
    const int tid = otid(), lane = tid & 63, wid = tid >> 6;
#if SELFCHECK && MULTI_LAUNCH
    if (obid() == 0 && tid < 8) ((unsigned*)(p.ws + WS_CTL))[3900 + tid] = 0u;
#endif
    const int gw = obid() * NWAVES + wid, ngw = ogrid() * NWAVES;
    LAS float* scr = (LAS float*)(lds + wid * 8704);
    unsigned char* ws = p.ws;
    for (int l = 0; l < NLAYER; ++l) {
        unsigned char* win = ws + WS_WIN + (size_t)l * INP * DM;
        transpose_matrix<true>(p.in[3] + (size_t)l * DM * INW, DM, INW, (bf16_t*)win, true, scr, gw, ngw, lane);
        for (int i = gw * 64 + lane; i < (INP - INW) * DM / 16; i += ngw * 64) *(u32x4*)(win + (size_t)INW * DM + (size_t)i * 16) = (u32x4){0u, 0u, 0u, 0u};
        transpose_matrix(p.in[12] + (size_t)l * 256 * 384, 256, 384, (bf16_t*)(ws + WS_WUQ) + (size_t)l * 384 * 256, false, scr, gw, ngw, lane);
        transpose_matrix(p.in[13] + (size_t)l * 128 * 512, 128, 512, (bf16_t*)(ws + WS_WUKV) + (size_t)l * 512 * 128, false, scr, gw, ngw, lane);
        for (int n = 0; n < 4; ++n)
            transpose_matrix(p.in[18] + ((size_t)l * 4 + n) * 256 * 1024, 256, 1024, (bf16_t*)(ws + WS_WBR) + ((size_t)l * 4 + n) * 1024 * 256, false, scr, gw, ngw, lane);
        transpose_matrix(p.in[19] + (size_t)l * DM * DM, DM, DM, (bf16_t*)(ws + WS_WOUT) + (size_t)l * DM * DM, false, scr, gw, ngw, lane);
        transpose_matrix(p.in[21] + (size_t)l * DM * DM, DM, DM, (bf16_t*)(ws + WS_WPQ) + (size_t)l * DM * DM, false, scr, gw, ngw, lane);
    }
    convert_f32_bf16(p.in[22], (bf16_t*)(ws + WS_KEYS), (size_t)NLAYER * 16 * 128 * 64, (size_t)obid() * NTHREADS + tid, (size_t)ogrid() * NTHREADS);
}

template <bool FP8 = false>
DEVI void phase_rownorm(const float* h, const float* gain, bf16_t* hn) {
    const int tid = otid(), lane = tid & 63, wid = tid >> 6;
    const int gw = obid() * NWAVES + wid, ngw = ogrid() * NWAVES;
    f32x4 g[4];
#pragma unroll
    for (int j = 0; j < 4; ++j) g[j] = *(const f32x4*)(gain + 4 * lane + 256 * j);
    for (int row = gw; row < S; row += ngw) {
        const float* xr = h + (size_t)row * DM;
        f32x4 v[4]; float ss = 0.f;
#pragma unroll
        for (int j = 0; j < 4; ++j) { v[j] = *(const f32x4*)(xr + 4 * lane + 256 * j); ss += (v[j].x * v[j].x + v[j].y * v[j].y) + (v[j].z * v[j].z + v[j].w * v[j].w); }
        const float rstd = rsqrtf(wave_sum(ss) * (1.f / DM) + EPS);
        bf16_t* orow = hn + (size_t)row * DM;
#pragma unroll
        for (int j = 0; j < 4; ++j) {
            if constexpr (FP8) {
                int w8 = __builtin_amdgcn_cvt_pk_fp8_f32(v[j].x * rstd * g[j].x, v[j].y * rstd * g[j].y, 0, false);
                w8 = __builtin_amdgcn_cvt_pk_fp8_f32(v[j].z * rstd * g[j].z, v[j].w * rstd * g[j].w, w8, true);
                *(int*)((unsigned char*)hn + (size_t)row * DM + 4 * lane + 256 * j) = w8;
                continue;
            }
            u32x2 o; o.x = pk2(v[j].x * rstd * g[j].x, v[j].y * rstd * g[j].y); o.y = pk2(v[j].z * rstd * g[j].z, v[j].w * rstd * g[j].w);
            *(u32x2*)(orow + 4 * lane + 256 * j) = o;
        }
    }
}

constexpr int GROW = 144;
template <int NT>
DEVI void gemm_kloop(f32x16 (&acc)[4][NT], const bf16_t* A, int lda, const bf16_t* B, int ldb, int K, lchar* lds) {
    const int tid = otid(), lane = tid & 63, wid = tid >> 6, wm = wid >> 2, wn = wid & 3, r = lane & 31, h = lane >> 5;
    constexpr int NGB = 2 * NT;
    constexpr int ASZ = 256 * 128, STG = ASZ + 128 * NT * 128;
    const int rr = lane >> 3, pp = lane & 7;
    const int skey = ((wid & 1) << 2) | (rr >> 1);
    const bf16_t* ap = A + (size_t)(wid * 8 + rr) * lda + ((pp ^ skey) << 3);
    const bf16_t* bp = B + (size_t)(wid * 8 + rr) * ldb + ((pp ^ skey) << 3);
    const int nk = K / 64;
#define G_DMA(kt, st) do { lchar* as_ = lds + (st) * STG + wid * 1024; lchar* bs_ = as_ + ASZ; \
        _Pragma("unroll") for (int i = 0; i < 4; ++i) __builtin_amdgcn_global_load_lds((const unsigned*)(ap + (size_t)(64 * i) * lda + (kt) * 64), (LAS unsigned*)(as_ + i * 8192), 16, 0, 0); \
        _Pragma("unroll") for (int i = 0; i < NGB; ++i) __builtin_amdgcn_global_load_lds((const unsigned*)(bp + (size_t)(64 * i) * ldb + (kt) * 64), (LAS unsigned*)(bs_ + i * 8192), 16, 0, 0); } while (0)
    __syncthreads();
    G_DMA(0, 0);
    __syncthreads();
    const int xa = (wm * 128 + r) * 128, xb = (wn * 32 * NT + r) * 128, sw = (r >> 1) & 7;
    for (int kt = 0; kt < nk; ++kt) {
        if (kt + 1 < nk) G_DMA(kt + 1, (kt + 1) & 1);
        const lchar* As = lds + (kt & 1) * STG; const lchar* Bs = As + ASZ;
        bf16x8 xf[2][4], wf[2][NT];
#define F_LOAD(ks, S_) do { const int co_ = ((2 * (ks) + h) ^ sw) << 4; \
            _Pragma("unroll") for (int mt = 0; mt < 4; ++mt) xf[S_][mt] = *(const LAS bf16x8*)(As + xa + mt * 32 * 128 + co_); \
            _Pragma("unroll") for (int nt = 0; nt < NT; ++nt) wf[S_][nt] = *(const LAS bf16x8*)(Bs + xb + nt * 32 * 128 + co_); } while (0)
#define F_MMA(S_) do { _Pragma("unroll") for (int mt = 0; mt < 4; ++mt) _Pragma("unroll") for (int nt = 0; nt < NT; ++nt) \
            acc[mt][nt] = __builtin_amdgcn_mfma_f32_32x32x16_bf16(wf[S_][nt], xf[S_][mt], acc[mt][nt], 0, 0, 0); } while (0)
        F_LOAD(0, 0);
        __builtin_amdgcn_sched_barrier(0);
        F_LOAD(1, 1);
        __builtin_amdgcn_sched_barrier(0);
        F_MMA(0);
        __builtin_amdgcn_sched_barrier(0);
        F_LOAD(2, 0);
        __builtin_amdgcn_sched_barrier(0);
        F_MMA(1);
        __builtin_amdgcn_sched_barrier(0);
        F_LOAD(3, 1);
        __builtin_amdgcn_sched_barrier(0);
        F_MMA(0);
        __builtin_amdgcn_sched_barrier(0);
        F_MMA(1);
#undef F_LOAD
#undef F_MMA
        __syncthreads();
    }
#undef G_DMA
}
template <int NT> DEVI void acc_zero(f32x16 (&acc)[4][NT]) {
#pragma unroll
    for (int mt = 0; mt < 4; ++mt)
#pragma unroll
        for (int nt = 0; nt < NT; ++nt)
#pragma unroll
            for (int i = 0; i < 16; ++i) acc[mt][nt][i] = 0.f;
}
template <int NT, class Epi>
DEVI void gemm_phase(const bf16_t* A, int lda, const bf16_t* Bt, int ldb, int K, int tiles_m, int tiles_n, const Epi& epi, lchar* lds) {
    const int tid = otid(), lane = tid & 63, wid = tid >> 6, wm = wid >> 2, wn = wid & 3, r = lane & 31, h = lane >> 5;
    constexpr int BN = 128 * NT;
    for (int t = obid(); t < tiles_m * tiles_n; t += ogrid()) {
        const int tm = t % tiles_m, tn = t / tiles_m;
        f32x16 acc[4][NT];
        acc_zero<NT>(acc);
        gemm_kloop<NT>(acc, A + (size_t)tm * 256 * lda, lda, Bt + (size_t)tn * BN * ldb, ldb, K, lds);
#pragma unroll
        for (int mt = 0; mt < 4; ++mt)
#pragma unroll
            for (int nt = 0; nt < NT; ++nt)
#pragma unroll
                for (int rg = 0; rg < 4; ++rg) {
                    const int row = tm * 256 + wm * 128 + mt * 32 + r;
                    const int col = tn * BN + wn * 32 * NT + nt * 32 + 8 * rg + 4 * h;
                    epi(row, col, (f32x4){acc[mt][nt][4 * rg], acc[mt][nt][4 * rg + 1], acc[mt][nt][4 * rg + 2], acc[mt][nt][4 * rg + 3]});
                }
    }
}
struct EpiInproj {
    bf16_t* G; bf16_t* P; const float* gbias;
    DEVI void operator()(int row, int col, f32x4 v) const {
        if (col < GW) {
            const f32x4 b = *(const f32x4*)(gbias + col);
            f32x4 s;
            s.x = __builtin_amdgcn_rcpf(1.f + fast_exp2(-LOG2E * (v.x + b.x))); s.y = __builtin_amdgcn_rcpf(1.f + fast_exp2(-LOG2E * (v.y + b.y)));
            s.z = __builtin_amdgcn_rcpf(1.f + fast_exp2(-LOG2E * (v.z + b.z))); s.w = __builtin_amdgcn_rcpf(1.f + fast_exp2(-LOG2E * (v.w + b.w)));
            u32x2 o; o.x = pk2(s.x, s.y); o.y = pk2(s.z, s.w);
            *(u32x2*)(G + (size_t)row * GW + col) = o;
        } else {
            u32x2 o; o.x = pk2(v.x, v.y); o.y = pk2(v.z, v.w);
            *(u32x2*)(P + (size_t)row * PW + (col - GW)) = o;
        }
    }
};
struct EpiInproj8 {
    bf16_t* G; bf16_t* P; const float* gbias;
    DEVI void operator()(int row, int col, f32x4 v0, f32x4 v1) const {
        u32x4 o;
        if (col < GW) {
            const f32x4 b0 = *(const f32x4*)(gbias + col), b1 = *(const f32x4*)(gbias + col + 4);
            f32x4 s0, s1;
#define SIGM(V, B) __builtin_amdgcn_rcpf(1.f + fast_exp2((-LOG2E / WIN_SCALE) * (V) - LOG2E * (B)))
            s0.x = SIGM(v0.x, b0.x); s0.y = SIGM(v0.y, b0.y); s0.z = SIGM(v0.z, b0.z); s0.w = SIGM(v0.w, b0.w);
            s1.x = SIGM(v1.x, b1.x); s1.y = SIGM(v1.y, b1.y); s1.z = SIGM(v1.z, b1.z); s1.w = SIGM(v1.w, b1.w);
#undef SIGM
            int w0 = __builtin_amdgcn_cvt_pk_fp8_f32(s0.x, s0.y, 0, false); w0 = __builtin_amdgcn_cvt_pk_fp8_f32(s0.z, s0.w, w0, true);
            int w1 = __builtin_amdgcn_cvt_pk_fp8_f32(s1.x, s1.y, 0, false); w1 = __builtin_amdgcn_cvt_pk_fp8_f32(s1.z, s1.w, w1, true);
            *(u32x2*)((unsigned char*)G + (size_t)row * GW + col) = (u32x2){(unsigned)w0, (unsigned)w1};
        } else {
            constexpr float c = 1.f / WIN_SCALE;
            o.x = pk2(v0.x * c, v0.y * c); o.y = pk2(v0.z * c, v0.w * c); o.z = pk2(v1.x * c, v1.y * c); o.w = pk2(v1.z * c, v1.w * c);
            *(u32x4*)(P + (size_t)row * PW + (col - GW)) = o;
        }
    }
};
struct EpiBf16 {
    bf16_t* C; int ldc;
    DEVI void operator()(int row, int col, f32x4 v) const {
        u32x2 o; o.x = pk2(v.x, v.y); o.y = pk2(v.z, v.w);
        *(u32x2*)(C + (size_t)row * ldc + col) = o;
    }
};
struct EpiResidual {
    const float* hin; float* hout;
    DEVI void operator()(int row, int col, f32x4 v) const {
        const f32x4 b = *(const f32x4*)(hin + (size_t)row * DM + col);
        *(f32x4*)(hout + (size_t)row * DM + col) = b + v;
    }
};
struct EpiF32 {
    float* C; int ldc;
    DEVI void operator()(int row, int col, f32x4 v) const { *(f32x4*)(C + (size_t)row * ldc + col) = v; }
};

DEVI void phase_merge(const bf16_t* Y, const bf16_t* Wbr  , const bf16_t* G, bf16_t* merged, lchar* lds) {
    const int tid = otid(), lane = tid & 63, wid = tid >> 6, wm = wid >> 2, wn = wid & 3, r = lane & 31, h = lane >> 5;
    constexpr int ASZ = 256 * 128, STG = ASZ + 128 * 128;
    static_assert(3 * STG <= LDS_BYTES - 96, "merge ring");
    const int rr = lane >> 3, pp = lane & 7;
    const int skey = ((wid & 1) << 2) | (rr >> 1);
    const int lrow = wid * 8 + rr, lcol = (pp ^ skey) << 3;
    const int bid = obid(), gsz = ogrid();
    const int ntile = (512 - bid + gsz - 1) / gsz, nit = ntile * 16;
    const int xa = (wm * 128 + r) * 128, xb = (wn * 32 + r) * 128, sw = (r >> 1) & 7;
#define M_DMA(q_, st_) do { const int qq_ = (q_) < nit ? (q_) : nit - 1; const int t_ = bid + (qq_ >> 4) * gsz, kt_ = qq_ & 15; \
        const bf16_t* ap_ = Y + ((size_t)(t_ & 63) * 256 + lrow) * DM + kt_ * 64 + lcol; \
        const bf16_t* bp_ = Wbr + ((size_t)(kt_ >> 2) * 1024 + (t_ >> 6) * 128 + lrow) * 256 + (kt_ & 3) * 64 + lcol; \
        lchar* as_ = lds + (st_) * STG + wid * 1024; \
        _Pragma("unroll") for (int i = 0; i < 4; ++i) __builtin_amdgcn_global_load_lds((const unsigned*)(ap_ + (size_t)(64 * i) * DM), (LAS unsigned*)(as_ + i * 8192), 16, 0, 0); \
        _Pragma("unroll") for (int i = 0; i < 2; ++i) __builtin_amdgcn_global_load_lds((const unsigned*)(bp_ + (size_t)(64 * i) * 256), (LAS unsigned*)(as_ + ASZ + i * 8192), 16, 0, 0); } while (0)
    __syncthreads();
    M_DMA(0, 0); M_DMA(1, 1);
    asm volatile("s_waitcnt vmcnt(6)" ::: "memory");
    __builtin_amdgcn_s_barrier();
    SBAR();
    int st = 0;
    f32x16 macc[4], acc[4];
#pragma unroll 1
    for (int qb = 0; qb < nit; qb += 4) {
        const int t = bid + (qb >> 4) * gsz, tm = t & 63, tn = t >> 6, br = (qb >> 2) & 3;
        if (br == 0) {
#pragma unroll
            for (int mt = 0; mt < 4; ++mt)
#pragma unroll
                for (int i = 0; i < 16; ++i) macc[mt][i] = 0.f;
        }
#pragma unroll
        for (int mt = 0; mt < 4; ++mt)
#pragma unroll
            for (int i = 0; i < 16; ++i) acc[mt][i] = 0.f;
        unsigned gq[4][4];
#pragma unroll
        for (int kq = 0; kq < 4; ++kq) {
            const int sn = (st == 0) ? 2 : st - 1;
            M_DMA(qb + kq + 2, sn);
            SBAR();
            if (kq == 0) {
                const unsigned char* gp = (const unsigned char*)G + ((size_t)tm * 256 + wm * 128 + r) * GW + br * 1024 + tn * 128 + wn * 32 + 4 * h;
#pragma unroll
                for (int mt = 0; mt < 4; ++mt)
#pragma unroll
                    for (int rg = 0; rg < 4; ++rg) gq[mt][rg] = *(const unsigned*)(gp + (size_t)mt * 32 * GW + 8 * rg);
                SBAR();
            }
            const lchar* As = lds + st * STG; const lchar* Bs = As + ASZ;
            bf16x8 xf[2][4], wf[2];
#define F_LOAD(ks, S_) do { const int co_ = ((2 * (ks) + h) ^ sw) << 4; \
            _Pragma("unroll") for (int mt = 0; mt < 4; ++mt) xf[S_][mt] = *(const LAS bf16x8*)(As + xa + mt * 32 * 128 + co_); \
            wf[S_] = *(const LAS bf16x8*)(Bs + xb + co_); } while (0)
#define F_MMA(S_) do { _Pragma("unroll") for (int mt = 0; mt < 4; ++mt) acc[mt] = __builtin_amdgcn_mfma_f32_32x32x16_bf16(wf[S_], xf[S_][mt], acc[mt], 0, 0, 0); } while (0)
            F_LOAD(0, 0); SBAR();
            F_LOAD(1, 1); SBAR();
            F_MMA(0); SBAR();
            F_LOAD(2, 0); SBAR();
            F_MMA(1); SBAR();
            F_LOAD(3, 1); SBAR();
            F_MMA(0); SBAR();
            F_MMA(1); SBAR();
#undef F_LOAD
#undef F_MMA
            if (kq == 3) {
#pragma unroll
                for (int mt = 0; mt < 4; ++mt)
#pragma unroll
                    for (int rg = 0; rg < 4; ++rg) {
                        const f32x2 g01 = __builtin_amdgcn_cvt_pk_f32_fp8((int)gq[mt][rg], false), g23 = __builtin_amdgcn_cvt_pk_f32_fp8((int)gq[mt][rg], true);
                        macc[mt][4 * rg + 0] += g01.x * acc[mt][4 * rg + 0];
                        macc[mt][4 * rg + 1] += g01.y * acc[mt][4 * rg + 1];
                        macc[mt][4 * rg + 2] += g23.x * acc[mt][4 * rg + 2];
                        macc[mt][4 * rg + 3] += g23.y * acc[mt][4 * rg + 3];
                    }
            }
            if (kq == 0) asm volatile("s_waitcnt vmcnt(22)" ::: "memory"); else asm volatile("s_waitcnt vmcnt(6)" ::: "memory");
            __builtin_amdgcn_s_barrier();
            SBAR();
            st = (st == 2) ? 0 : st + 1;
        }
        if (br == 3) {
#pragma unroll
            for (int mt = 0; mt < 4; ++mt)
#pragma unroll
                for (int rg = 0; rg < 4; ++rg) {
                    const int row = tm * 256 + wm * 128 + mt * 32 + r;
                    const int col = tn * 128 + wn * 32 + 8 * rg + 4 * h;
                    u32x2 o; o.x = pk2(macc[mt][4 * rg], macc[mt][4 * rg + 1]); o.y = pk2(macc[mt][4 * rg + 2], macc[mt][4 * rg + 3]);
                    *(u32x2*)(merged + (size_t)row * DM + col) = o;
                }
        }
    }
#undef M_DMA
    asm volatile("s_waitcnt vmcnt(0)" ::: "memory");
}

namespace pg8 {
#define PG8_LAS __attribute__((address_space(3)))
typedef unsigned short bf16_t;
typedef short bf16x8 __attribute__((ext_vector_type(8)));
typedef float f32x4 __attribute__((ext_vector_type(4)));
typedef unsigned u32x4 __attribute__((ext_vector_type(4)));
typedef int i32x8_t __attribute__((ext_vector_type(8)));
constexpr int BM = 256, BK = 64, HALF = 128, HTB = HALF * BK * 2  , STAGE_BYTES = 8 * HTB, NXCD = 8, WGM = 8;

__host__ __device__ __forceinline__ int lds_byte(int r, int c) { const int st = (r >> 4) * 2 + (c >> 5), rr = r & 15, cc = c & 31, ob = rr * 64 + cc * 2; return st * 1024 + (ob ^ (((ob >> 9) & 1) << 5)); }
__host__ __device__ __forceinline__ void stage_rc(int b, int& R, int& C) { const int st = b / 1024, sb = b % 1024, swz = sb ^ (((sb >> 9) & 1) << 5); R = (st >> 1) * 16 + swz / 64; C = (st & 1) * 32 + (swz % 64) / 2; }
__host__ __device__ __forceinline__ int perm32(int rho) { const int n = rho >> 4, i = rho & 15; return 8 * (i >> 2) + 4 * n + (i & 3); }

struct Unit { int pm, pn; };
struct Gemm { const bf16_t* A; const bf16_t* Bt; int M, N, K; };

struct StaticOrder {
    int nM, nN, nwg, G, c;
    __host__ __device__ void init(int M, int N, int G_, int c_) { nM = M / BM; nN = N / BM; nwg = nM * nN; G = G_; c = c_; }
    __host__ __device__ bool next(int i, Unit& u) const {
        const long L = (long)i * G + c; if (L >= nwg) return false;
        int wgid = (int)L; { const int q = nwg / NXCD, r = nwg % NXCD, xcd = wgid % NXCD, off = wgid / NXCD; wgid = (xcd < r ? xcd * (q + 1) : r * (q + 1) + (xcd - r) * q) + off; }
        const int nig = WGM * nN, gid = wgid / nig, fm = gid * WGM, gsz = (nM - fm) < WGM ? (nM - fm) : WGM;
        u.pm = fm + ((wgid % nig) % gsz); u.pn = (wgid % nig) / gsz; return true;
    }
    __device__ __forceinline__ void a_ready(const Unit&) const {}
    __device__ __forceinline__ void done(const Unit&) const {}
};

template <class Epi, class Sched, bool ALIGN_EPI = false, bool SP2 = false, bool FP8 = false>
__device__ __forceinline__ void gemm_phase(PG8_LAS unsigned char* lds, const Gemm g, const Sched& S, const Epi& E) {
    const int tid = otid(), wid = __builtin_amdgcn_readfirstlane(tid >> 6), lane = tid & 63, wr = wid >> 2, wc = wid & 3, fr = lane & 15, fq = lane >> 4;
    const int K = g.K, nt = K / BK;
    unsigned voffA[2], voffB[2];
#pragma unroll
    for (int i = 0; i < 2; ++i) { int R, C; stage_rc(tid * 16 + i * 8192, R, C); const int Rb = Epi::PERM ? ((R & ~31) + perm32(R & 31)) : R;
        voffA[i] = (unsigned)(R * K + C) * 2u; voffB[i] = (unsigned)(Rb * K + C) * 2u; }
    const size_t kstep = (size_t)(BK * 2);
    const size_t hstep = (size_t)HALF * K * 2;
    const size_t tstep = 2 * hstep;
    const unsigned ldsw = (unsigned)wid * 1024u;
#define PG8_SA(b, h) (((b) * 2 + (h)) * HTB)
#define PG8_SB(b, h) ((4 + (b) * 2 + (h)) * HTB)
#define PG8_VOFF(voff, i_) ({ unsigned r_; if constexpr (FP8) { int R_, C_; stage_rc(otid() * 16 + (i_) * 8192, R_, C_); \
            const int Rx_ = ((voff) == voffB && Epi::PERM) ? ((R_ & ~31) + perm32(R_ & 31)) : R_; r_ = (unsigned)(Rx_ * K + C_) * 2u; } else r_ = (voff)[i_]; r_; })
#define PG8_STAGE(bufoff, gbase, voff) do { _Pragma("unroll") for (int _i = 0; _i < 2; ++_i) { const unsigned vo_ = PG8_VOFF(voff, _i);     \
        __builtin_amdgcn_global_load_lds((const unsigned*)((const char*)(gbase) + vo_), (PG8_LAS unsigned*)(lds + (bufoff) + ldsw + _i * 8192), 16, 0, 0); } } while (0)
#define PG8_RD8(p_) ({ const u32x4 l0_ = *(const PG8_LAS u32x4*)(p_), l1_ = *(const PG8_LAS u32x4*)((p_) + 1024); \
        (i32x8_t){(int)l0_[0], (int)l0_[1], (int)l0_[2], (int)l0_[3], (int)l1_[0], (int)l1_[1], (int)l1_[2], (int)l1_[3]}; })
#define PG8_LDA(dst, b, h) do { if constexpr (FP8) { _Pragma("unroll") for (int m = 0; m < 4; ++m) dst##8[m] = PG8_RD8(lds + PG8_SA(b, h) + aoff + m * 2048); } \
        else { _Pragma("unroll") for (int m = 0; m < 4; ++m) _Pragma("unroll") for (int k = 0; k < 2; ++k) dst[m][k] = *(const PG8_LAS bf16x8*)(lds + PG8_SA(b, h) + aoff + m * 2048 + k * 1024); } } while (0)
#define PG8_LDB(dst, b, h) do { if constexpr (FP8) { _Pragma("unroll") for (int n = 0; n < 2; ++n) dst##8[n] = PG8_RD8(lds + PG8_SB(b, h) + boff + n * 2048); } \
        else { _Pragma("unroll") for (int n = 0; n < 2; ++n) _Pragma("unroll") for (int k = 0; k < 2; ++k) dst[n][k] = *(const PG8_LAS bf16x8*)(lds + PG8_SB(b, h) + boff + n * 2048 + k * 1024); } } while (0)
#define PG8_CAT(x0, x1) __builtin_bit_cast(i32x8_t, __builtin_shufflevector(x0, x1, 0, 1, 2, 3, 4, 5, 6, 7, 8, 9, 10, 11, 12, 13, 14, 15))
#define PG8_MMA(ai, bj, At, Bt) do { __builtin_amdgcn_s_setprio(1); _Pragma("unroll") for (int m = 0; m < 4; ++m) _Pragma("unroll") for (int n = 0; n < 2; ++n) { \
        if constexpr (FP8) acc[ai][bj][m][n] = __builtin_amdgcn_mfma_scale_f32_16x16x128_f8f6f4(Bt##8[n], At##8[m], acc[ai][bj][m][n], 0, 0, 0, 0, 0, 0); \
        else { _Pragma("unroll") for (int k = 0; k < 2; ++k) acc[ai][bj][m][n] = __builtin_amdgcn_mfma_f32_16x16x32_bf16(Bt[n][k], At[m][k], acc[ai][bj][m][n], 0, 0, 0); } } \
        __builtin_amdgcn_s_setprio(0); } while (0)
#define PG8_WAIT_V(n) asm volatile("s_waitcnt vmcnt(" #n ")" ::: "memory")
#define PG8_WAIT_L(n) asm volatile("s_waitcnt lgkmcnt(" #n ")" ::: "memory")
#define PG8_BAR __builtin_amdgcn_s_barrier()
#define PG8_SCHED __builtin_amdgcn_sched_barrier(0)
    Unit cur, nxt; int ui = 0;
    if (!S.next(0, cur)) return;
    f32x4 acc[2][2][4][2];
#pragma unroll
    for (int a = 0; a < 2; ++a)
#pragma unroll
        for (int b = 0; b < 2; ++b)
#pragma unroll
            for (int m = 0; m < 4; ++m)
#pragma unroll
                for (int n = 0; n < 2; ++n) acc[a][b][m][n] = (f32x4){0.f, 0.f, 0.f, 0.f};
    bf16x8 At[4][2], B0[2][2], B1[2][2];
    i32x8_t At8[4], B08[2], B18[2];
    const char* cA = (const char*)g.A + (size_t)cur.pm * tstep; const char* cB = (const char*)g.Bt + (size_t)cur.pn * tstep;
    S.a_ready(cur);
    if constexpr (SP2) {
        PG8_STAGE(PG8_SB(0, 0), cB, voffB); PG8_STAGE(PG8_SB(0, 1), cB + hstep, voffB); PG8_STAGE(PG8_SA(0, 0), cA, voffA); PG8_STAGE(PG8_SA(0, 1), cA + hstep, voffA);
        if (wr == 1) PG8_BAR;
        PG8_WAIT_V(2); PG8_BAR;
        PG8_STAGE(PG8_SB(1, 0), cB + kstep, voffB); PG8_STAGE(PG8_SA(1, 0), cA + kstep, voffA); PG8_STAGE(PG8_SB(1, 1), cB + hstep + kstep, voffB);
        PG8_WAIT_V(6); PG8_BAR;
    } else {
        PG8_STAGE(PG8_SB(0, 0), cB, voffB); PG8_STAGE(PG8_SA(0, 0), cA, voffA); PG8_STAGE(PG8_SB(0, 1), cB + hstep, voffB); PG8_STAGE(PG8_SA(0, 1), cA + hstep, voffA);
        if (wr == 1) PG8_BAR;
        PG8_WAIT_V(4); PG8_BAR;
        PG8_STAGE(PG8_SB(1, 0), cB + kstep, voffB); PG8_STAGE(PG8_SA(1, 0), cA + kstep, voffA); PG8_STAGE(PG8_SB(1, 1), cB + hstep + kstep, voffB);
        PG8_WAIT_V(6); PG8_BAR;
    }
    int aoff, boff;
    { int fr2 = fr, fq2 = fq; asm volatile("" : "+v"(fr2), "+v"(fq2)); aoff = lds_byte(wr * 64 + fr2, fq2 * 8); boff = lds_byte(wc * 32 + fr2, fq2 * 8); }
    for (;;) {
        const bool has_next = S.next(ui + 1, nxt);
        const char* nA = has_next ? (const char*)g.A + (size_t)nxt.pm * tstep : cA; const char* nB = has_next ? (const char*)g.Bt + (size_t)nxt.pn * tstep : cB;
        for (int t = 0; t < nt; t += 2) {
            const bool last = (t == nt - 2);
            const char* a1 = cA + (size_t)(t + 1) * kstep;
            const char* a2 = last ? nA : cA + (size_t)(t + 2) * kstep; const char* b2 = last ? nB : cB + (size_t)(t + 2) * kstep;
            const char* a3 = a2 + kstep; const char* b3 = b2 + kstep;
            if (last && has_next) S.a_ready(nxt);
            if constexpr (SP2) {
            PG8_LDB(B0, 0, 0); PG8_LDB(B1, 0, 1); PG8_SCHED; PG8_LDA(At, 0, 0); PG8_STAGE(PG8_SA(1, 1), a1 + hstep, voffA);
            PG8_WAIT_V(8); PG8_WAIT_L(0); PG8_BAR; PG8_MMA(0, 0, At, B0); PG8_MMA(0, 1, At, B1); PG8_BAR; PG8_SCHED;
            PG8_LDA(At, 0, 1); PG8_STAGE(PG8_SB(0, 0), b2, voffB); PG8_STAGE(PG8_SB(0, 1), b2 + hstep, voffB); PG8_STAGE(PG8_SA(0, 0), a2, voffA);
            PG8_WAIT_V(8); PG8_WAIT_L(0); PG8_BAR; PG8_MMA(1, 0, At, B0); PG8_MMA(1, 1, At, B1); PG8_BAR; PG8_SCHED;
            PG8_LDB(B0, 1, 0); PG8_LDB(B1, 1, 1); PG8_SCHED; PG8_LDA(At, 1, 0); PG8_STAGE(PG8_SA(0, 1), a2 + hstep, voffA);
            PG8_WAIT_V(8); PG8_WAIT_L(0); PG8_BAR; PG8_MMA(0, 0, At, B0); PG8_MMA(0, 1, At, B1); PG8_BAR; PG8_SCHED;
            PG8_LDA(At, 1, 1); PG8_STAGE(PG8_SB(1, 0), b3, voffB); PG8_STAGE(PG8_SB(1, 1), b3 + hstep, voffB); PG8_STAGE(PG8_SA(1, 0), a3, voffA);
            PG8_WAIT_V(8); PG8_WAIT_L(0); PG8_BAR; PG8_MMA(1, 0, At, B0); PG8_MMA(1, 1, At, B1); PG8_BAR; PG8_SCHED;
            } else {
            PG8_LDB(B0, 0, 0); PG8_SCHED; PG8_LDA(At, 0, 0); PG8_STAGE(PG8_SA(1, 1), a1 + hstep, voffA);
            PG8_WAIT_L(8); PG8_BAR; PG8_WAIT_L(0); PG8_MMA(0, 0, At, B0); PG8_BAR; PG8_SCHED;
            PG8_LDB(B1, 0, 1); PG8_STAGE(PG8_SB(0, 0), b2, voffB);
            PG8_BAR; PG8_WAIT_L(0); PG8_MMA(0, 1, At, B1); PG8_BAR;
            PG8_LDA(At, 0, 1); PG8_STAGE(PG8_SA(0, 0), a2, voffA);
            PG8_BAR; PG8_WAIT_L(0); PG8_MMA(1, 0, At, B0); PG8_BAR; PG8_SCHED;
            PG8_STAGE(PG8_SB(0, 1), b2 + hstep, voffB);
            PG8_WAIT_V(6); PG8_BAR; PG8_MMA(1, 1, At, B1); PG8_BAR;
            PG8_LDB(B0, 1, 0); PG8_SCHED; PG8_LDA(At, 1, 0); PG8_STAGE(PG8_SA(0, 1), a2 + hstep, voffA);
            PG8_WAIT_L(8); PG8_BAR; PG8_WAIT_L(0); PG8_MMA(0, 0, At, B0); PG8_BAR; PG8_SCHED;
            PG8_LDB(B1, 1, 1); PG8_STAGE(PG8_SB(1, 0), b3, voffB);
            PG8_BAR; PG8_WAIT_L(0); PG8_MMA(0, 1, At, B1); PG8_BAR;
            PG8_LDA(At, 1, 1); PG8_STAGE(PG8_SA(1, 0), a3, voffA);
            PG8_BAR; PG8_WAIT_L(0); PG8_MMA(1, 0, At, B0); PG8_BAR; PG8_SCHED;
            PG8_STAGE(PG8_SB(1, 1), b3 + hstep, voffB);
            PG8_WAIT_V(6); PG8_BAR; PG8_MMA(1, 1, At, B1); PG8_BAR;
            }
        }
        if constexpr (ALIGN_EPI) { if (wr == 0) PG8_BAR; }
        if constexpr (!Epi::AFTER_DRAIN) { E(acc, cur, wr, wc, fr, fq); S.done(cur); }
        if (!has_next) break;
#pragma unroll
        for (int a = 0; a < 2; ++a)
#pragma unroll
            for (int b = 0; b < 2; ++b)
#pragma unroll
                for (int m = 0; m < 4; ++m)
#pragma unroll
                    for (int n = 0; n < 2; ++n) acc[a][b][m][n] = (f32x4){0.f, 0.f, 0.f, 0.f};
        cur = nxt; cA = nA; cB = nB; ++ui;
        if constexpr (ALIGN_EPI) { if (wr == 1) PG8_BAR; }
    }
    PG8_WAIT_V(0);
    if constexpr (!ALIGN_EPI) { if (wr == 0) PG8_BAR; }
    PG8_BAR;
    if constexpr (Epi::AFTER_DRAIN) { E.fused(acc, cur, wr, wc, fr, fq, lds, wid, lane); S.done(cur); }
#undef PG8_SA
#undef PG8_SB
#undef PG8_STAGE
#undef PG8_LDA
#undef PG8_LDB
#undef PG8_MMA
#undef PG8_WAIT_V
#undef PG8_WAIT_L
#undef PG8_BAR
#undef PG8_SCHED
}
}

template <class F> struct Pg8Epi8 {
    static constexpr bool PERM = true, AFTER_DRAIN = false;
    F f;
    __device__ __forceinline__ void operator()(const pg8::f32x4 (&acc)[2][2][4][2], const pg8::Unit& u, int wr, int wc, int fr_, int fq_) const {
        const int ln_ = olane(); const int fr = ln_ & 15, fq = ln_ >> 4;
#pragma unroll
        for (int ai = 0; ai < 2; ++ai)
#pragma unroll
            for (int m = 0; m < 4; ++m)
#pragma unroll
                for (int bj = 0; bj < 2; ++bj) {
                    const int row = u.pm * 256 + ai * 128 + wr * 64 + m * 16 + fr;
                    const int col = u.pn * 256 + bj * 128 + wc * 32 + 8 * fq;
                    const pg8::f32x4 a = acc[ai][bj][m][0], b = acc[ai][bj][m][1];
                    f(row, col, (f32x4){a[0], a[1], a[2], a[3]}, (f32x4){b[0], b[1], b[2], b[3]});
                }
    }
};
template <class F> struct Pg8Epi {
    static constexpr bool PERM = false, AFTER_DRAIN = false;
    F f;
    __device__ __forceinline__ void operator()(const pg8::f32x4 (&acc)[2][2][4][2], const pg8::Unit& u, int wr, int wc, int fr, int fq) const {
#pragma unroll
        for (int ai = 0; ai < 2; ++ai)
#pragma unroll
            for (int m = 0; m < 4; ++m)
#pragma unroll
                for (int bj = 0; bj < 2; ++bj)
#pragma unroll
                    for (int n = 0; n < 2; ++n) {
                        const int row = u.pm * 256 + ai * 128 + wr * 64 + m * 16 + fr;
                        const int col = u.pn * 256 + bj * 128 + wc * 32 + n * 16 + 4 * fq;
                        const pg8::f32x4 v = acc[ai][bj][m][n];
                        f(row, col, (f32x4){v[0], v[1], v[2], v[3]});
                    }
    }
};

template <bool PERM = false>
DEVI void vtrans_unit(const bf16_t* src, int pitch, int off, int t0, int dil, bf16_t* VT, LAS bf16_t* T, int lane) {
    constexpr int TS = 68;
    const int cw = 64 / dil;
#pragma unroll
    for (int i = 0; i < 8; ++i) {
        const int tl = i * 8 + (lane >> 3), ch = lane & 7;
        const u32x4 v = *(const u32x4*)(src + (size_t)(t0 + tl) * pitch + off + ch * 8);
        const int tp = (tl % dil) * cw + tl / dil;
        T[(ch * 8 + 0) * TS + tp] = (bf16_t)(v.x & 0xffffu); T[(ch * 8 + 1) * TS + tp] = (bf16_t)(v.x >> 16);
        T[(ch * 8 + 2) * TS + tp] = (bf16_t)(v.y & 0xffffu); T[(ch * 8 + 3) * TS + tp] = (bf16_t)(v.y >> 16);
        T[(ch * 8 + 4) * TS + tp] = (bf16_t)(v.z & 0xffffu); T[(ch * 8 + 5) * TS + tp] = (bf16_t)(v.z >> 16);
        T[(ch * 8 + 6) * TS + tp] = (bf16_t)(v.w & 0xffffu); T[(ch * 8 + 7) * TS + tp] = (bf16_t)(v.w >> 16);
    }
    asm volatile("s_waitcnt lgkmcnt(0)" ::: "memory");
    const int L = S / dil;
#pragma unroll
    for (int i = 0; i < 16; ++i) {
        const int id = i * 64 + lane, d = id >> 4, c = id & 15;
        const u32x2 v = *(const LAS u32x2*)(T + d * TS + c * 4);
        if constexpr (PERM) {
            int w = __builtin_amdgcn_cvt_pk_fp8_f32(bflo(v.x), bfhi(v.x), 0, false);
            w = __builtin_amdgcn_cvt_pk_fp8_f32(bflo(v.y), bfhi(v.y), w, true);
            const int dw = 8 * (c & 1) + 4 * (c >> 3) + ((c & 7) >> 1);
            *(int*)((unsigned char*)VT + (size_t)d * S + t0 + 4 * dw) = w;
        } else {
            const int tp = c * 4, cls = tp / cw, within = tp % cw;
            const int pos = cls * L + t0 / dil + within;
            *(u32x2*)(VT + (size_t)d * S + pos) = v;
        }
    }
    asm volatile("s_waitcnt lgkmcnt(0)" ::: "memory");
}

DEVI float rope_freq16(int i) { return exp2f(-(float)i * (13.287712379549449f / 16.f)); }
DEVI float rope32(float x, int li, float pos) {
    const float xp = swz_xor16(x);
    float rev = pos * rope_freq16(li & 15) * 0.15915494309189535f; rev -= floorf(rev);
    const float c = __builtin_amdgcn_cosf(rev), s = __builtin_amdgcn_sinf(rev);
    return (li < 16) ? (x * c - xp * s) : (xp * s + x * c);
}
DEVI void phase_post1(const Params& p, int layer, lchar* lds) {
    const int tid = otid(), lane = tid & 63, wid = tid >> 6;
    const int gw = obid() * NWAVES + wid, ngw = ogrid() * NWAVES;
    unsigned char* ws = p.ws;
    const bf16_t* P = (const bf16_t*)(ws + WS_P);
    unsigned char* qkv = ws + WS_QKV;
    LAS float* gtab = (LAS float*)(lds + 8 * 8704);
    for (int i = tid; i < 640; i += NTHREADS) {
        const int gi = i >> 6, d = i & 63;
        const float* src = gi == 0 ? p.in[5] + layer * 64 : gi == 1 ? p.in[6] + layer * 64 : gi < 5 ? p.in[8] + (layer * 3 + gi - 2) * 64 : gi < 8 ? p.in[9] + (layer * 3 + gi - 5) * 64
                         : gi == 8 ? p.in[16] + layer * 64 : p.in[17] + layer * 64;
        gtab[i] = src[d];
    }
    __syncthreads();
    const float ckg_pe = p.in[15][layer * 96 + 64 + (lane & 31)];
    f32x4 cqlg = *(const f32x4*)(p.in[10] + layer * 256 + 4 * lane);
    f32x2 ckvlg = *(const f32x2*)(p.in[11] + layer * 128 + 2 * lane);
    const float qs64 = 0.125f * LOG2E;
    const int g4 = lane >> 4, sub = lane & 15;
    for (int t = gw; t < S; t += ngw) {
        const bf16_t* row = P + (size_t)t * PW;
        u32x2 wvs[9];
#pragma unroll
        for (int it = 0; it < 9; ++it) {
            const int hI = it * 4 + g4;
            const int srcc = hI < 6 ? hI * 64 : (hI < 30 ? 512 + (hI - 6) * 64 : 3232 + (hI - 30) * 64);
            wvs[it] = *(const u32x2*)(row + srcc + 4 * sub);
        }
#pragma unroll
        for (int it = 0; it < 9; ++it) {
            const int hI = it * 4 + g4;
            const u32x2 wv = wvs[it];
            float x0 = bflo(wv.x), x1 = bfhi(wv.x), x2 = bflo(wv.y), x3 = bfhi(wv.y);
            float ss = (x0 * x0 + x1 * x1) + (x2 * x2 + x3 * x3);
            ss += dppf<0xB1>(ss); ss += dppf<0x4E>(ss); ss += dppf<0x141>(ss); ss += dppf<0x140>(ss);
            const float rs = rsqrtf(ss * (1.f / 64.f) + EPS);
            const int gi = hI < 4 ? 0 : (hI < 6 ? 1 : (hI < 18 ? 2 + ((hI - 6) >> 2) : (hI < 30 ? 5 + ((hI - 18) >> 2) : (hI < 34 ? 8 : 9))));
            const f32x4 gn = *(const LAS f32x4*)(gtab + gi * 64 + 4 * sub);
            x0 *= rs * gn.x; x1 *= rs * gn.y; x2 *= rs * gn.z; x3 *= rs * gn.w;
            const bool isq = (hI < 4) || (hI >= 6 && hI < 18) || (hI >= 30 && hI < 34);
            if (it >= 7) {
                const float p0 = swz_xor4(x0), p1 = swz_xor4(x1), p2 = swz_xor4(x2), p3 = swz_xor4(x3);
                if (hI >= 30) {
                    const float pos = (sub >> 3) ? (float)(t & 63) : (float)(t >> 6);
                    const bool first = (sub & 4) == 0;
                    const int fi = 4 * (sub & 3);
                    float xs[4] = {x0, x1, x2, x3}; const float ps[4] = {p0, p1, p2, p3};
#pragma unroll
                    for (int q = 0; q < 4; ++q) {
                        float rev = pos * rope_freq16(fi + q) * 0.15915494309189535f; rev -= floorf(rev);
                        const float c = __builtin_amdgcn_cosf(rev), sn = __builtin_amdgcn_sinf(rev);
                        xs[q] = first ? (xs[q] * c - ps[q] * sn) : (ps[q] * sn + xs[q] * c);
                    }
                    x0 = xs[0]; x1 = xs[1]; x2 = xs[2]; x3 = xs[3];
                }
            }
            const float sc = isq ? qs64 : 1.f;
            u32x2 o; o.x = pk2(x0 * sc, x1 * sc); o.y = pk2(x2 * sc, x3 * sc);
            if (it >= 7 && hI >= 30) {
                int w8 = __builtin_amdgcn_cvt_pk_fp8_f32(x0 * sc, x1 * sc, 0, false); w8 = __builtin_amdgcn_cvt_pk_fp8_f32(x2 * sc, x3 * sc, w8, true);
                const size_t d8 = (hI < 34) ? Q_QD + ((size_t)(hI - 30) * S + t) * 64 : Q_KD + ((size_t)(hI - 34) * S + t) * 64;
                *(int*)(qkv + d8 + 4 * sub) = w8;
                continue;
            }
            size_t doff;
            if (hI < 4) doff = Q_QA + ((size_t)hI * S + t) * 128;
            else if (hI < 6) doff = Q_KA + ((size_t)(hI - 4) * S + t) * 128;
            else if (hI < 30) {
                const int gh = (hI < 18) ? hI - 6 : hI - 18, g = gh >> 2;
                const int dil = (g == 0) ? 1 : (g == 1 ? 4 : 16);
                const int pos = (t % dil) * (S / dil) + t / dil;
                doff = ((hI < 18) ? Q_QB : Q_KB) + ((size_t)gh * S + pos) * 128;
            } else if (hI < 34) doff = Q_QD + ((size_t)(hI - 30) * S + t) * 128;
            else doff = Q_KD + ((size_t)(hI - 34) * S + t) * 128;
            *(u32x2*)(qkv + doff + 8 * sub) = o;
        }
        {
            const u32x2 w = *(const u32x2*)(row + O_CQ + 4 * lane);
            const float a = bflo(w.x), b = bfhi(w.x), c = bflo(w.y), d = bfhi(w.y);
            const float rs = rsqrtf(wave_sum(a * a + b * b + c * c + d * d) * (1.f / 256.f) + EPS);
            u32x2 o; o.x = pk2(a * rs * cqlg.x, b * rs * cqlg.y); o.y = pk2(c * rs * cqlg.z, d * rs * cqlg.w);
            *(u32x2*)((bf16_t*)(ws + WS_CQN) + (size_t)t * 256 + 4 * lane) = o;
            const unsigned w2 = *(const unsigned*)(row + O_CKV + 2 * lane);
            const float e = bflo(w2), f = bfhi(w2);
            const float rs2 = rsqrtf(wave_sum(e * e + f * f) * (1.f / 128.f) + EPS);
            *(unsigned*)((bf16_t*)(ws + WS_CKVN) + (size_t)t * 128 + 2 * lane) = pk2(e * rs2 * ckvlg.x, f * rs2 * ckvlg.y);
            float kr = (lane < 32) ? bf2f(row[O_CKR + lane]) : 0.f;
            const float rs3 = rsqrtf(wave_sum(kr * kr) * (1.f / 32.f) + EPS);
            const float y = rope32(kr * rs3 * ckg_pe, lane & 31, (float)t);
            {
                const unsigned char yb = (lane < 32) ? (unsigned char)(__builtin_amdgcn_cvt_pk_fp8_f32(y, 0.f, 0, false) & 0xff) : (unsigned char)0;
#pragma unroll
                for (int hh = 0; hh < 4; ++hh) (qkv + Q_KC)[((size_t)hh * S + t) * 128 + 64 + lane] = yb;
            }
        }
    }
    LAS bf16_t* T = (LAS bf16_t*)(lds + wid * 8704);
    for (int u = gw; u < 16 * 256; u += ngw) {
        const int hd = u >> 8, t0 = (u & 255) * 64;
        if (hd < 2) vtrans_unit(P, PW, O_AV + hd * 64, t0, 1, (bf16_t*)(qkv + Q_VAT) + (size_t)hd * 64 * S, T, lane);
        else if (hd < 14) { const int gh = hd - 2, g = gh >> 2; const int dil = (g == 0) ? 1 : (g == 1 ? 4 : 16);
            vtrans_unit(P, PW, O_BV + gh * 64, t0, dil, (bf16_t*)(qkv + Q_VBT) + (size_t)gh * 64 * S, T, lane); }
        else vtrans_unit<true>(P, PW, O_DV + (hd - 14) * 64, t0, 1, (bf16_t*)(qkv + Q_VDT + (size_t)(hd - 14) * 64 * S), T, lane);
    }
}
DEVI void phase_post2(const Params& p, int layer, lchar* lds) {
    const int tid = otid(), lane = tid & 63, wid = tid >> 6;
    const int gw = obid() * NWAVES + wid, ngw = ogrid() * NWAVES;
    unsigned char* ws = p.ws;
    unsigned char* qkv = ws + WS_QKV;
    const bf16_t* CQ = (const bf16_t*)(ws + WS_CQRAW);
    const bf16_t* CKV = (const bf16_t*)(ws + WS_CKVRAW);
    const float qs96 = 0.10206207261596575f * LOG2E;
    const int g4 = lane >> 4, sub = lane & 15;
    const f32x4 qgn = *(const f32x4*)(p.in[14] + layer * 96 + 4 * sub);
    const f32x4 kgn = *(const f32x4*)(p.in[15] + layer * 96 + 4 * sub);
    const int g8 = lane >> 3, s8 = lane & 7;
    const f32x4 qgp = *(const f32x4*)(p.in[14] + layer * 96 + 64 + 4 * s8);
    for (int t = gw; t < S; t += ngw) {
        {
            const u32x2 wv = *(const u32x2*)(CQ + (size_t)t * 384 + g4 * 96 + 4 * sub);
            float x0 = bflo(wv.x), x1 = bfhi(wv.x), x2 = bflo(wv.y), x3 = bfhi(wv.y);
            float ss = (x0 * x0 + x1 * x1) + (x2 * x2 + x3 * x3);
            ss += dppf<0xB1>(ss); ss += dppf<0x4E>(ss); ss += dppf<0x141>(ss); ss += dppf<0x140>(ss);
            const float rs = rsqrtf(ss * (1.f / 64.f) + EPS) * qs96;
            int w8 = __builtin_amdgcn_cvt_pk_fp8_f32(x0 * rs * qgn.x, x1 * rs * qgn.y, 0, false); w8 = __builtin_amdgcn_cvt_pk_fp8_f32(x2 * rs * qgn.z, x3 * rs * qgn.w, w8, true);
            *(int*)(qkv + Q_QC + ((size_t)g4 * S + t) * 128 + 4 * sub) = w8;
        }
        {
            const u32x2 wv = *(const u32x2*)(CKV + (size_t)t * 512 + g4 * 128 + 4 * sub);
            float x0 = bflo(wv.x), x1 = bfhi(wv.x), x2 = bflo(wv.y), x3 = bfhi(wv.y);
            float ss = (x0 * x0 + x1 * x1) + (x2 * x2 + x3 * x3);
            ss += dppf<0xB1>(ss); ss += dppf<0x4E>(ss); ss += dppf<0x141>(ss); ss += dppf<0x140>(ss);
            const float rs = rsqrtf(ss * (1.f / 64.f) + EPS);
            int w8 = __builtin_amdgcn_cvt_pk_fp8_f32(x0 * rs * kgn.x, x1 * rs * kgn.y, 0, false); w8 = __builtin_amdgcn_cvt_pk_fp8_f32(x2 * rs * kgn.z, x3 * rs * kgn.w, w8, true);
            *(int*)(qkv + Q_KC + ((size_t)g4 * S + t) * 128 + 4 * sub) = w8;
        }
        {
            const int hh = g8 & 3;
            const u32x2 wv = *(const u32x2*)(CQ + (size_t)t * 384 + hh * 96 + 64 + 4 * s8);
            float xs[4] = {bflo(wv.x), bfhi(wv.x), bflo(wv.y), bfhi(wv.y)};
            float ss = (xs[0] * xs[0] + xs[1] * xs[1]) + (xs[2] * xs[2] + xs[3] * xs[3]);
            ss += dppf<0xB1>(ss); ss += dppf<0x4E>(ss); ss += dppf<0x141>(ss);
            const float rs = rsqrtf(ss * (1.f / 32.f) + EPS);
            const float gq[4] = {qgp.x, qgp.y, qgp.z, qgp.w};
            const bool first = (s8 & 4) == 0;
            float ys[4];
#pragma unroll
            for (int q = 0; q < 4; ++q) {
                const float y = xs[q] * rs * gq[q];
                const float yp = swz_xor4(y);
                float rev = (float)t * rope_freq16(4 * (s8 & 3) + q) * 0.15915494309189535f; rev -= floorf(rev);
                const float c = __builtin_amdgcn_cosf(rev), sn = __builtin_amdgcn_sinf(rev);
                ys[q] = (first ? (y * c - yp * sn) : (yp * sn + y * c)) * qs96;
            }
            int w8 = __builtin_amdgcn_cvt_pk_fp8_f32(ys[0], ys[1], 0, false); w8 = __builtin_amdgcn_cvt_pk_fp8_f32(ys[2], ys[3], w8, true);
            *(int*)(qkv + Q_QC + ((size_t)hh * S + t) * 128 + (lane < 32 ? 64 : 96) + 4 * s8) = (lane < 32) ? w8 : 0;
        }
    }
    LAS bf16_t* T = (LAS bf16_t*)(lds + wid * 8704);
    for (int u = gw; u < 4 * 256; u += ngw) {
        const int hd = u >> 8, t0 = (u & 255) * 64;
        vtrans_unit<true>(CKV, 512, hd * 128 + 64, t0, 1, (bf16_t*)(qkv + Q_VCT + (size_t)hd * 64 * S), T, lane);
    }
}

#define PIN(x) asm volatile("" : "+v"(x))
DEVI float max3f(float a, float b, float c) { float r; asm("v_max3_f32 %0, %1, %2, %3" : "=v"(r) : "v"(a), "v"(b), "v"(c)); return r; }
DEVI float max2f(float a, float b) { float r; asm("v_max_f32_e32 %0, %1, %2" : "=v"(r) : "v"(a), "v"(b)); return r; }
DEVI float rowmax32(const f32x16& a, const f32x16& b) {
    float x = max3f(a[0], a[1], a[2]), y = max3f(a[3], a[4], a[5]);
    x = max3f(x, a[6], a[7]); y = max3f(y, a[8], a[9]); x = max3f(x, a[10], a[11]); y = max3f(y, a[12], a[13]); x = max3f(x, a[14], a[15]);
    y = max3f(y, b[0], b[1]); x = max3f(x, b[2], b[3]); y = max3f(y, b[4], b[5]); x = max3f(x, b[6], b[7]); y = max3f(y, b[8], b[9]);
    x = max3f(x, b[10], b[11]); y = max3f(y, b[12], b[13]); x = max3f(x, b[14], b[15]);
    return max2f(x, y);
}
typedef int i32x8 __attribute__((ext_vector_type(8)));
template <int DQ> struct AttnCfg {
    static constexpr int KROWB = (DQ == 64) ? 64 : 128, KST = KROWB / 64, KTB = 64 * KROWB, VTB = 4096, NSLOT = 4, K_RING = 0, V_RING = NSLOT * KTB;
};
struct AttnDma { const unsigned char* kg; const unsigned char* vg; int kd, vd; };
template <int DQ> DEVI void attn_dma_k(const AttnDma& d, int jt, int slot, lchar* lds, int lane) {
    typedef AttnCfg<DQ> C;
    if constexpr (DQ == 64) { if (lane < 32) __builtin_amdgcn_global_load_lds((const unsigned*)(d.kg + (size_t)jt * C::KTB), (LAS unsigned*)(lds + C::K_RING + slot * C::KTB + d.kd), 16, 0, 0); }
    else __builtin_amdgcn_global_load_lds((const unsigned*)(d.kg + (size_t)jt * C::KTB), (LAS unsigned*)(lds + C::K_RING + slot * C::KTB + d.kd), 16, 0, 0);
}
template <int DQ> DEVI void attn_dma_v(const AttnDma& d, int jt, int slot, lchar* lds, int lane) {
    typedef AttnCfg<DQ> C;
    if (lane < 32) __builtin_amdgcn_global_load_lds((const unsigned*)(d.vg + (size_t)jt * 64), (LAS unsigned*)(lds + C::V_RING + slot * C::VTB + d.vd), 16, 0, 0);
}
#define ATTN_WAIT(n) asm volatile("s_waitcnt vmcnt(" #n ")" ::: "memory")
#define MFMA_F8(a, b, c) __builtin_amdgcn_mfma_scale_f32_32x32x64_f8f6f4(a, b, c, 0, 0, 0, 0, 0, 0)
DEVI i32x8 cat8(const u32x4 a, const u32x4 b) { return (i32x8){(int)a.x, (int)a.y, (int)a.z, (int)a.w, (int)b.x, (int)b.y, (int)b.z, (int)b.w}; }
constexpr float ATTN_OFF = 6.f;
#define CVT8(PX, G, DST) do { int w_ = __builtin_amdgcn_cvt_pk_fp8_f32(PX[4 * (G)], PX[4 * (G) + 1], 0, false); \
        w_ = __builtin_amdgcn_cvt_pk_fp8_f32(PX[4 * (G) + 2], PX[4 * (G) + 3], w_, true); DST = w_; } while (0)
template <int DQ>
DEVI void attn_step(int j, int NT, f32x16& pc0, f32x16& pc1, f32x16& sn0, f32x16& sn1, f32x16& negm, f32x16 (&o)[2], f32x16& o2, const i32x8 ones8, float& mhat,
                    const i32x8 (&qf)[AttnCfg<DQ>::KST], const AttnDma& dm, const int (&voff)[2], const int (&koff)[2 * AttnCfg<DQ>::KST], lchar* lds, int lane) {
    typedef AttnCfg<DQ> C;
    constexpr int KST = C::KST;
    constexpr float THR = ATTN_OFF + 2.f;
    {
        const int jk = (j + 3 < NT) ? j + 3 : NT - 1, jv = (j + 2 < NT) ? j + 2 : NT - 1;
        attn_dma_v<DQ>(dm, jv, (j + 2) & 3, lds, lane);
        attn_dma_k<DQ>(dm, jk, (j + 3) & 3, lds, lane);
    }
    const lchar* kbs = lds + C::K_RING + ((j + 1) & 3) * C::KTB;
    const lchar* vbs = lds + C::V_RING + (j & 3) * C::VTB;
    u32x4 kc[2][2 * KST];
#pragma unroll
    for (int t = 0; t < 2; ++t)
#pragma unroll
        for (int c = 0; c < 2 * KST; ++c) kc[t][c] = *(const LAS u32x4*)(kbs + koff[c] + t * 32 * C::KROWB);
    SBAR();
    i32x8 pb;
#define EXD(I) pc1[I] = fast_exp2(pc1[I])
    if constexpr (KST == 1) {
        sn0 = MFMA_F8(cat8(kc[0][0], kc[0][1]), qf[0], negm);
        EXD(8); EXD(9); EXD(10); EXD(11); EXD(12); EXD(13); EXD(14); EXD(15); PIN(pc1); SBAR();
        sn1 = MFMA_F8(cat8(kc[1][0], kc[1][1]), qf[0], negm);
        CVT8(pc0, 0, pb[0]); CVT8(pc0, 1, pb[1]); CVT8(pc0, 2, pb[2]); CVT8(pc0, 3, pb[3]);
        CVT8(pc1, 0, pb[4]); CVT8(pc1, 1, pb[5]); CVT8(pc1, 2, pb[6]); CVT8(pc1, 3, pb[7]); PIN(pb); SBAR();
    } else {
        sn0 = MFMA_F8(cat8(kc[0][0], kc[0][1]), qf[0], negm);
        EXD(8); EXD(9); EXD(10); EXD(11); CVT8(pc0, 0, pb[0]); CVT8(pc0, 1, pb[1]); PIN(pc1); PIN(pb); SBAR();
        sn1 = MFMA_F8(cat8(kc[1][0], kc[1][1]), qf[0], negm);
        EXD(12); EXD(13); EXD(14); EXD(15); CVT8(pc0, 2, pb[2]); CVT8(pc0, 3, pb[3]); PIN(pc1); PIN(pb); SBAR();
        sn0 = MFMA_F8(cat8(kc[0][2], kc[0][3]), qf[1], sn0);
        CVT8(pc1, 0, pb[4]); CVT8(pc1, 1, pb[5]); PIN(pb); SBAR();
        sn1 = MFMA_F8(cat8(kc[1][2], kc[1][3]), qf[1], sn1);
        CVT8(pc1, 2, pb[6]); CVT8(pc1, 3, pb[7]); PIN(pb); SBAR();
    }
#undef EXD
    u32x4 va[2][2];
#define VLD(db, c) va[db][c] = *(const LAS u32x4*)(vbs + voff[c] + (db) * 2048)
    VLD(0, 0); VLD(0, 1); VLD(1, 0); VLD(1, 1);
    asm volatile("s_nop 15\n\ts_nop 15\n\ts_nop 7" : "+v"(sn0), "+v"(sn1));
    float mx = rowmax32(sn0, sn1);
    {
        auto rr = __builtin_amdgcn_permlane32_swap(__float_as_uint(mx), __float_as_uint(mx), false, false);
        mx = max2f(__uint_as_float(rr[0]), __uint_as_float(rr[1]));
    }
    float f = 1.f;
    const bool resc = __any(mx > THR);
    if (__builtin_expect(resc, 0)) {
        const float dl = fmaxf(mx - ATTN_OFF, 0.f);
        mhat += dl;
#pragma unroll
        for (int i = 0; i < 16; ++i) { sn0[i] -= dl; sn1[i] -= dl; negm[i] = -mhat; }
        f = fast_exp2(-dl);
    }
    SBAR();
#define EX1(PX, I) PX[I] = fast_exp2(PX[I])
    o[0] = MFMA_F8(cat8(va[0][0], va[0][1]), pb, o[0]);
    EX1(sn0, 0); EX1(sn0, 1); EX1(sn0, 2); EX1(sn0, 3); EX1(sn0, 4); EX1(sn0, 5); EX1(sn0, 6); EX1(sn0, 7); PIN(sn0); SBAR();
    o[1] = MFMA_F8(cat8(va[1][0], va[1][1]), pb, o[1]);
    EX1(sn0, 8); EX1(sn0, 9); EX1(sn0, 10); EX1(sn0, 11); EX1(sn0, 12); EX1(sn0, 13); EX1(sn0, 14); EX1(sn0, 15); PIN(sn0); SBAR();
    o2 = MFMA_F8(ones8, pb, o2);
    EX1(sn1, 0); EX1(sn1, 1); EX1(sn1, 2); EX1(sn1, 3); EX1(sn1, 4); EX1(sn1, 5); EX1(sn1, 6); EX1(sn1, 7); PIN(sn1); SBAR();
#undef EX1
#undef VLD
    if (__builtin_expect(resc, 0)) {
#pragma unroll
        for (int i = 0; i < 16; ++i) { o[0][i] *= f; o[1][i] *= f; o2[i] *= f; }
    }
    ATTN_WAIT(2);
    __builtin_amdgcn_s_barrier();
    SBAR();
}
template <int DQ>
DEVI void dense_attn_unit(const unsigned char* Q8, const unsigned char* K8, const unsigned char* VT8, bf16_t* Y  , int qb, lchar* lds) {
    typedef AttnCfg<DQ> C;
    constexpr int KST = C::KST;
    const int tid = otid(), lane = tid & 63, wid = tid >> 6, r = lane & 31, h = lane >> 5;
    const int qrow = qb * 256 + wid * 32 + r;
    AttnDma dm;
    {
        const int row8 = wid * 8 + ((lane & 31) >> 2), ch8 = (lane & 3) ^ ((row8 >> 2) & 3);
        dm.vg = VT8 + (size_t)row8 * S + ch8 * 16; dm.vd = wid * 512;
        if constexpr (DQ == 64) { dm.kg = K8 + (size_t)row8 * 64 + ch8 * 16; dm.kd = wid * 512; }
        else { const int krow = wid * 8 + (lane >> 3), kch = (lane & 7) ^ ((krow >> 1) & 7); dm.kg = K8 + (size_t)krow * 128 + kch * 16; dm.kd = wid * 1024; }
    }
    int voff[2], koff[2 * KST];
    {
        const int sw4 = (r >> 2) & 3;
        voff[0] = r * 64 + (((2 * h) ^ sw4) << 4); voff[1] = r * 64 + (((2 * h + 1) ^ sw4) << 4);
        if constexpr (DQ == 64) { koff[0] = voff[0]; koff[1] = voff[1]; }
        else {
            const int m7 = (r >> 1) & 7;
#pragma unroll
            for (int c = 0; c < 4; ++c) koff[c] = r * 128 + (((4 * (c >> 1) + 2 * h + (c & 1)) ^ m7) << 4);
        }
    }
    __syncthreads();
    attn_dma_k<DQ>(dm, 0, 0, lds, lane); attn_dma_v<DQ>(dm, 0, 0, lds, lane);
    attn_dma_k<DQ>(dm, 1, 1, lds, lane); attn_dma_v<DQ>(dm, 1, 1, lds, lane);
    attn_dma_k<DQ>(dm, 2, 2, lds, lane);
    i32x8 qf[KST];
#pragma unroll
    for (int ks = 0; ks < KST; ++ks) {
        const unsigned char* qp = Q8 + (size_t)qrow * C::KROWB + 64 * ks + 32 * h;
        qf[ks] = cat8(*(const u32x4*)qp, *(const u32x4*)(qp + 16));
    }
    ATTN_WAIT(0);
    __builtin_amdgcn_s_barrier();
    SBAR();

    float mhat;
    f32x16 negm, pa0, pa1, pb0, pb1, o[2], o2;
#pragma unroll
    for (int i = 0; i < 16; ++i) { pa0[i] = 0.f; pa1[i] = 0.f; o[0][i] = 0.f; o[1][i] = 0.f; o2[i] = 0.f; }
    const int onew = (r == 0) ? 0x38383838 : 0;
    const i32x8 ones8 = {onew, onew, onew, onew, onew, onew, onew, onew};
#pragma unroll
    for (int ks = 0; ks < KST; ++ks) {
        const lchar* kp0 = lds + C::K_RING;
        pa0 = MFMA_F8(cat8(*(const LAS u32x4*)(kp0 + koff[2 * ks]), *(const LAS u32x4*)(kp0 + koff[2 * ks + 1])), qf[ks], pa0);
        pa1 = MFMA_F8(cat8(*(const LAS u32x4*)(kp0 + koff[2 * ks] + 32 * C::KROWB), *(const LAS u32x4*)(kp0 + koff[2 * ks + 1] + 32 * C::KROWB)), qf[ks], pa1);
    }
    {
        float mx = fmaxf(pa0[0], pa1[0]);
#pragma unroll
        for (int i = 1; i < 16; ++i) mx = fmaxf(mx, fmaxf(pa0[i], pa1[i]));
        auto rr = __builtin_amdgcn_permlane32_swap(__float_as_uint(mx), __float_as_uint(mx), false, false);
        mhat = fmaxf(__uint_as_float(rr[0]), __uint_as_float(rr[1])) - ATTN_OFF;
#pragma unroll
        for (int i = 0; i < 16; ++i) { pa0[i] = fast_exp2(pa0[i] - mhat); pa1[i] = (i < 8) ? fast_exp2(pa1[i] - mhat) : pa1[i] - mhat; negm[i] = -mhat; }
    }
    constexpr int NT = S / 64;
#pragma unroll 1
    for (int j = 0; j < NT - 2; j += 2) {
        attn_step<DQ>(j, NT, pa0, pa1, pb0, pb1, negm, o, o2, ones8, mhat, qf, dm, voff, koff, lds, lane);
        attn_step<DQ>(j + 1, NT, pb0, pb1, pa0, pa1, negm, o, o2, ones8, mhat, qf, dm, voff, koff, lds, lane);
    }
    attn_step<DQ>(NT - 2, NT, pa0, pa1, pb0, pb1, negm, o, o2, ones8, mhat, qf, dm, voff, koff, lds, lane);
    {
        i32x8 pb;
#pragma unroll
        for (int i = 8; i < 16; ++i) pb1[i] = fast_exp2(pb1[i]);
        CVT8(pb0, 0, pb[0]); CVT8(pb0, 1, pb[1]); CVT8(pb0, 2, pb[2]); CVT8(pb0, 3, pb[3]);
        CVT8(pb1, 0, pb[4]); CVT8(pb1, 1, pb[5]); CVT8(pb1, 2, pb[6]); CVT8(pb1, 3, pb[7]);
        const lchar* vb = lds + C::V_RING + ((NT - 1) & 3) * C::VTB;
#pragma unroll
        for (int db = 0; db < 2; ++db)
            o[db] = MFMA_F8(cat8(*(const LAS u32x4*)(vb + voff[0] + db * 2048), *(const LAS u32x4*)(vb + voff[1] + db * 2048)), pb, o[db]);
        o2 = MFMA_F8(ones8, pb, o2);
    }
    ATTN_WAIT(0);
    float l;
    {
        auto rr = __builtin_amdgcn_permlane32_swap(__float_as_uint(o2[0]), __float_as_uint(o2[0]), false, false);
        l = __uint_as_float(rr[0]);
    }
    const float inv = 1.f / l;
    bf16_t* yrow = Y + (size_t)qrow * DM;
#pragma unroll
    for (int db = 0; db < 2; ++db)
#pragma unroll
        for (int rg = 0; rg < 4; ++rg) {
            u32x2 w; w.x = pk2(o[db][4 * rg] * inv, o[db][4 * rg + 1] * inv); w.y = pk2(o[db][4 * rg + 2] * inv, o[db][4 * rg + 3] * inv);
            *(u32x2*)(yrow + db * 32 + 8 * rg + 4 * h) = w;
        }
}

DEVI int rel_bucket(int rel) {
    const int n = rel < 0 ? -rel : rel;
    int b;
    if (n < 8) b = n; else if (n < 15) b = 8; else if (n < 27) b = 9; else if (n < 50) b = 10; else if (n < 91) b = 11; else if (n < 166) b = 12;
    else if (n < 305) b = 13; else if (n < 559) b = 14; else b = 15;
    return b + (rel > 0 ? 16 : 0);
}
template <int HW>
DEVI void banded_block_task(const bf16_t* Q, const bf16_t* K, const bf16_t* VT, int q0, int L, int dil, const float* relb, int bias_col, bool has_sink, float sink2,
                            bf16_t* out, int ld_out, float* lse_out, lchar* lds) {
    constexpr int NK = 256 + 2 * HW, KSTR = 144, VSTR = NK * 2 + 16, NKB = (2 * HW + 32) / 32;
    constexpr int LUTN = 32 * NKB + 32;
    constexpr int K_OFF = 0, V_OFF = NK * KSTR, LUT_OFF = V_OFF + 64 * VSTR;
    static_assert(LUT_OFF + 4 * LUTN * 4 <= LDS_BYTES - 96, "banded LDS footprint");
    constexpr float THR = 8.f;
    const int tid = otid(), lane = tid & 63, wid = tid >> 6, r = lane & 31, h = lane >> 5;
    const int band_lo = q0 - HW;
    const int seg_lo = (q0 / L) * L, seg_hi = seg_lo + L;
    const bool edge = (band_lo < seg_lo) || (band_lo + NK > seg_hi);
    __syncthreads();
#pragma unroll
    for (int i = 0; i < NK * 8 / 512; ++i) {
        const int c = tid + 512 * i, row = c >> 3, cc = c & 7;
        int key = band_lo + row; key = key < 0 ? 0 : (key > S - 1 ? S - 1 : key);
        *(LAS u32x4*)(lds + K_OFF + row * KSTR + cc * 16) = *(const u32x4*)(K + (size_t)key * 64 + cc * 8);
    }
#pragma unroll
    for (int i = 0; i < 64 * (NK / 8) / 512; ++i) {
        const int c = tid + 512 * i, d = c / (NK / 8), kc = c % (NK / 8);
        int key0 = band_lo + kc * 8; key0 = key0 < 0 ? 0 : (key0 > S - 8 ? S - 8 : key0);
        const u32x4 v = *(const u32x4*)(VT + (size_t)d * S + key0);
        *(LAS u32x2*)(lds + V_OFF + d * VSTR + (kc >> 1) * 32 + (kc & 1) * 8) = (u32x2){v.x, v.y};
        *(LAS u32x2*)(lds + V_OFF + d * VSTR + (kc >> 1) * 32 + (kc & 1) * 8 + 16) = (u32x2){v.z, v.w};
    }
    LAS float* lut = (LAS float*)(lds + LUT_OFF);
    for (int e = tid; e < 4 * LUTN; e += NTHREADS) {
        const int sp = e / LUTN, x = e % LUTN + sp - 32;
        float v = -INFINITY;
        if (x >= 0 && x <= 2 * HW) v = relb[rel_bucket((x - HW) * dil) * 16 + bias_col] * LOG2E;
        lut[e] = v;
    }
    const int qw0 = q0 + 32 * wid, qpos = qw0 + r;
    bf16x8 qf[4];
#pragma unroll
    for (int ks = 0; ks < 4; ++ks) qf[ks] = *(const bf16x8*)(Q + (size_t)qpos * 64 + ks * 16 + h * 8);
    const int sp = (4 - (r & 3)) & 3;
    const LAS float* lutl = lut + sp * LUTN + (32 + 4 * h - r - sp);
    __syncthreads();
    float m = has_sink ? sink2 : -64.f;
    float l = (has_sink && h == 0) ? 1.f : 0.f;
    f32x16 o[2];
#pragma unroll
    for (int i = 0; i < 16; ++i) { o[0][i] = 0.f; o[1][i] = 0.f; }
#pragma unroll 1
    for (int i = 0; i < NKB; ++i) {
        const int brow = 32 * wid + 32 * i;
        bf16x8 kf[4]; f32x4 bv[4]; u32x4 vf[2][2];
#pragma unroll
        for (int ks = 0; ks < 4; ++ks) kf[ks] = *(const LAS bf16x8*)(lds + K_OFF + (brow + r) * KSTR + (2 * ks + h) * 16);
#pragma unroll
        for (int g = 0; g < 4; ++g) bv[g] = *(const LAS f32x4*)(lutl + 32 * i + 8 * g);
#pragma unroll
        for (int s2 = 0; s2 < 2; ++s2)
#pragma unroll
            for (int db = 0; db < 2; ++db) vf[s2][db] = *(const LAS u32x4*)(lds + V_OFF + (db * 32 + r) * VSTR + (brow + 16 * s2) * 2 + 16 * h);
        f32x16 pa;
#pragma unroll
        for (int q = 0; q < 16; ++q) pa[q] = -m;
#pragma unroll
        for (int ks = 0; ks < 4; ++ks) pa = __builtin_amdgcn_mfma_f32_32x32x16_bf16(kf[ks], qf[ks], pa, 0, 0, 0);
#pragma unroll
        for (int q = 0; q < 16; ++q) pa[q] += bv[q >> 2][q & 3];
        if (edge) {
            const int kb0 = band_lo + brow + 4 * h;
#pragma unroll
            for (int q = 0; q < 16; ++q) {
                const int kp2 = kb0 + (q & 3) + 8 * (q >> 2);
                pa[q] = (kp2 >= seg_lo && kp2 < seg_hi) ? pa[q] : -INFINITY;
            }
        }
        float mx = fmaxf(fmaxf(pa[0], pa[1]), pa[2]);
#pragma unroll
        for (int q = 3; q < 15; q += 2) mx = fmaxf(fmaxf(mx, pa[q]), pa[q + 1]);
        mx = fmaxf(mx, pa[15]);
        mx = half_max(mx);
        if (__any(mx > THR)) {
            const float dl = fmaxf(mx, 0.f), alpha = fast_exp2(-dl);
            m += dl; l *= alpha;
#pragma unroll
            for (int q = 0; q < 16; ++q) { pa[q] -= dl; o[0][q] *= alpha; o[1][q] *= alpha; }
        }
        float ls = 0.f;
#pragma unroll
        for (int q = 0; q < 16; ++q) { pa[q] = fast_exp2(pa[q]); ls += pa[q]; }
        l += ls;
        bf16x8 pf[2];
        {
            u32x4 w;
            w.x = pk2(pa[0], pa[1]); w.y = pk2(pa[2], pa[3]); w.z = pk2(pa[4], pa[5]); w.w = pk2(pa[6], pa[7]); pf[0] = __builtin_bit_cast(bf16x8, w);
            w.x = pk2(pa[8], pa[9]); w.y = pk2(pa[10], pa[11]); w.z = pk2(pa[12], pa[13]); w.w = pk2(pa[14], pa[15]); pf[1] = __builtin_bit_cast(bf16x8, w);
        }
#pragma unroll
        for (int s2 = 0; s2 < 2; ++s2)
#pragma unroll
            for (int db = 0; db < 2; ++db) o[db] = __builtin_amdgcn_mfma_f32_32x32x16_bf16(__builtin_bit_cast(bf16x8, vf[s2][db]), pf[s2], o[db], 0, 0, 0);
    }
    l = half_sum(l);
    const float inv = 1.f / l;
    const int token = (qpos % L) * dil + qpos / L;
    bf16_t* yrow = out + (size_t)token * ld_out;
#pragma unroll
    for (int db = 0; db < 2; ++db)
#pragma unroll
        for (int rg = 0; rg < 4; ++rg) {
            u32x2 w; w.x = pk2(o[db][4 * rg] * inv, o[db][4 * rg + 1] * inv); w.y = pk2(o[db][4 * rg + 2] * inv, o[db][4 * rg + 3] * inv);
            *(u32x2*)(yrow + db * 32 + 8 * rg + 4 * h) = w;
        }
    if (lse_out && h == 0) lse_out[(size_t)token * 4] = (m + log2f(l)) * 0.6931471805599453f;
}
DEVI void phase_attention(const Params& p, int layer, lchar* lds) {
    unsigned char* ws = p.ws;
    unsigned char* qkv = ws + WS_QKV;
    bf16_t* Y = (bf16_t*)(ws + WS_Y);
    for (int rr_ = 0; rr_ < (REPEAT_PHASE == 61 ? 2 : 1); ++rr_)
    for (int id = obid(); id < 512; id += ogrid()) {
        const int mh = (id & 7) ^ ((id >> 6) & 4), qb = id >> 3;
        if (mh < 4) {
            dense_attn_unit<96>((const unsigned char*)(qkv + Q_QC) + (size_t)mh * S * 128, (const unsigned char*)(qkv + Q_KC) + (size_t)mh * S * 128,
                                (const unsigned char*)(qkv + Q_VCT) + (size_t)mh * 64 * S, Y + 512 + mh * 64, qb, lds);
        } else {
            const int hh = mh - 4;
            dense_attn_unit<64>((const unsigned char*)(qkv + Q_QD) + (size_t)hh * S * 64, (const unsigned char*)(qkv + Q_KD) + (size_t)(hh >> 1) * S * 64,
                                (const unsigned char*)(qkv + Q_VDT) + (size_t)(hh >> 1) * 64 * S, Y + 768 + hh * 64, qb, lds);
        }
    }
    for (int rr_ = 0; rr_ < (REPEAT_PHASE == 62 ? 2 : 1); ++rr_)
    for (int u = obid(); u < 16 * 64; u += ogrid()) {
        const int hd = (u + 4 * (u >> 8)) & 15, ck = u >> 4;
        if (hd < 4) {
            banded_block_task<128>((const bf16_t*)(qkv + Q_QA) + (size_t)hd * S * 64, (const bf16_t*)(qkv + Q_KA) + (size_t)(hd >> 1) * S * 64,
                                   (const bf16_t*)(qkv + Q_VAT) + (size_t)(hd >> 1) * 64 * S, ck * 256, S, 1, p.in[1], hd, true, p.in[7][layer * 4 + hd] * LOG2E,
                                   Y + hd * 64, DM, nullptr, lds);
        } else {
            const int gh = hd - 4, g = gh >> 2, hh = gh & 3; const int dil = (g == 0) ? 1 : (g == 1 ? 4 : 16);
            banded_block_task<64>((const bf16_t*)(qkv + Q_QB) + (size_t)gh * S * 64, (const bf16_t*)(qkv + Q_KB) + (size_t)gh * S * 64,
                                  (const bf16_t*)(qkv + Q_VBT) + (size_t)gh * 64 * S, ck * 256, S / dil, dil, p.in[1], 4 + gh, false, 0.f,
                                  (bf16_t*)(ws + WS_OB) + (size_t)g * S * 256 + hh * 64, 256, (float*)(ws + WS_LSE) + (size_t)g * S * 4 + hh, lds);
        }
    }
}
DEVI void convert_rows_fp8(const float* src, unsigned char* dst, float* inv_scale, int nrows, int gw, int ngw, int lane) {
    for (int row = gw; row < nrows; row += ngw) {
        const float* sp = src + (size_t)row * 1024 + 16 * lane;
        f32x4 v[4]; float mx = 0.f;
#pragma unroll
        for (int j = 0; j < 4; ++j) { v[j] = *(const f32x4*)(sp + 4 * j); mx = fmaxf(mx, fmaxf(fmaxf(fabsf(v[j].x), fabsf(v[j].y)), fmaxf(fabsf(v[j].z), fabsf(v[j].w)))); }
        mx = wave_max(mx);
        const float sc = mx > 0.f ? 384.f / mx : 1.f;
        u32x4 o;
#pragma unroll
        for (int j = 0; j < 4; ++j) {
            int w = 0;
            w = __builtin_amdgcn_cvt_pk_fp8_f32(v[j].x * sc, v[j].y * sc, w, false);
            w = __builtin_amdgcn_cvt_pk_fp8_f32(v[j].z * sc, v[j].w * sc, w, true);
            o[j] = (unsigned)w;
        }
        *(u32x4*)(dst + (size_t)row * 1024 + 16 * lane) = o;
        if (lane == 0) inv_scale[row] = mx > 0.f ? mx * (1.f / 384.f) : 1.f;
    }
}
DEVI void convert_rows_fp4(const float* src, unsigned char* dst, float* inv_scale, int nrows, int gw, int ngw, int lane) {
    for (int row0 = gw; row0 < nrows; row0 += 2 * ngw) {
        const int row1 = row0 + ngw; const bool has1 = row1 < nrows;
        const float* sp0 = src + (size_t)row0 * 1024 + 16 * lane;
        const float* sp1 = src + (size_t)(has1 ? row1 : row0) * 1024 + 16 * lane;
        f32x4 va[4], vb[4];
#pragma unroll
        for (int j = 0; j < 4; ++j) { va[j] = *(const f32x4*)(sp0 + 4 * j); vb[j] = *(const f32x4*)(sp1 + 4 * j); }
#define CONV_ROW(V, ROW, DO) do { float mx = 0.f; \
            _Pragma("unroll") for (int j = 0; j < 4; ++j) mx = fmaxf(mx, fmaxf(fmaxf(fabsf(V[j].x), fabsf(V[j].y)), fmaxf(fabsf(V[j].z), fabsf(V[j].w)))); \
            mx = wave_max(mx); const float sc = mx > 0.f ? 6.f / mx : 1.f; u32x2 o; \
            _Pragma("unroll") for (int j = 0; j < 2; ++j) { unsigned w = 0u; \
                w = __builtin_amdgcn_cvt_scalef32_pk_fp4_f32(w, V[2 * j].x * sc, V[2 * j].y * sc, 1.0f, 0); \
                w = __builtin_amdgcn_cvt_scalef32_pk_fp4_f32(w, V[2 * j].z * sc, V[2 * j].w * sc, 1.0f, 1); \
                w = __builtin_amdgcn_cvt_scalef32_pk_fp4_f32(w, V[2 * j + 1].x * sc, V[2 * j + 1].y * sc, 1.0f, 2); \
                w = __builtin_amdgcn_cvt_scalef32_pk_fp4_f32(w, V[2 * j + 1].z * sc, V[2 * j + 1].w * sc, 1.0f, 3); o[j] = w; } \
            if (DO) { *(u32x2*)(dst + (size_t)(ROW) * 512 + 8 * lane) = o; if (lane == 0) inv_scale[ROW] = mx > 0.f ? mx * (1.f / 6.f) : 1.f; } } while (0)
        CONV_ROW(va, row0, true);
        CONV_ROW(vb, row1, has1);
#undef CONV_ROW
    }
}
DEVI void convert_rows_i4(const float* src, unsigned char* dst, float* inv_scale, int nrows, int gw, int ngw, int lane) {
    for (int row0 = gw; row0 < nrows; row0 += 2 * ngw) {
        const int row1 = row0 + ngw; const bool has1 = row1 < nrows;
        const float* sp0 = src + (size_t)row0 * 1024 + 16 * lane;
        const float* sp1 = src + (size_t)(has1 ? row1 : row0) * 1024 + 16 * lane;
        f32x4 va[4], vb[4];
#pragma unroll
        for (int j = 0; j < 4; ++j) { va[j] = *(const f32x4*)(sp0 + 4 * j); vb[j] = *(const f32x4*)(sp1 + 4 * j); }
#define CONV_ROW(V, ROW, DO) do { float ss = 0.f; \
            _Pragma("unroll") for (int j = 0; j < 4; ++j) ss += (V[j].x * V[j].x + V[j].y * V[j].y) + (V[j].z * V[j].z + V[j].w * V[j].w); \
            ss = wave_sum(ss); const float step = ss > 0.f ? 0.335f * sqrtf(ss * (1.f / 1024.f)) : 1.f, inv = 1.f / step; u32x2 o; \
            _Pragma("unroll") for (int j = 0; j < 2; ++j) { unsigned w = 0u; \
                _Pragma("unroll") for (int e = 0; e < 8; ++e) { const float v = V[2 * j + (e >> 2)][e & 3]; \
                    const int q = (int)fminf(fmaxf(__builtin_rintf(v * inv), -8.f), 7.f); w |= ((unsigned)q & 15u) << (4 * e); } \
                o[j] = w; } \
            if (DO) { *(u32x2*)(dst + (size_t)(ROW) * 512 + 8 * lane) = o; if (lane == 0) inv_scale[ROW] = step; } } while (0)
        CONV_ROW(va, row0, true);
        CONV_ROW(vb, row1, has1);
#undef CONV_ROW
    }
}
DEVI void phase_bmerge(const Params& p, int layer) {
    const int tid = otid();
    unsigned char* ws = p.ws;
    const bf16_t* OB = (const bf16_t*)(ws + WS_OB);
    const float* LSE = (const float*)(ws + WS_LSE);
    bf16_t* Y = (bf16_t*)(ws + WS_Y);
    const size_t gtid = (size_t)obid() * NTHREADS + tid, gthreads = (size_t)ogrid() * NTHREADS;
    for (size_t i = gtid; i < (size_t)S * 32; i += gthreads) {
        const int t = (int)(i >> 5), hh = (int)((i >> 3) & 3), c = (int)(i & 7);
        const float l0 = LSE[(size_t)t * 4 + hh], l1 = LSE[((size_t)S + t) * 4 + hh], l2 = LSE[((size_t)2 * S + t) * 4 + hh];
        const float mx = fmaxf(l0, fmaxf(l1, l2));
        float w0 = __expf(l0 - mx), w1 = __expf(l1 - mx), w2 = __expf(l2 - mx);
        const float inv = 1.f / (w0 + w1 + w2);
        w0 *= inv; w1 *= inv; w2 *= inv;
        const u32x4 a = *(const u32x4*)(OB + (size_t)t * 256 + hh * 64 + c * 8);
        const u32x4 b = *(const u32x4*)(OB + ((size_t)S + t) * 256 + hh * 64 + c * 8);
        const u32x4 d = *(const u32x4*)(OB + ((size_t)2 * S + t) * 256 + hh * 64 + c * 8);
        u32x4 o;
        o.x = pk2(w0 * bflo(a.x) + w1 * bflo(b.x) + w2 * bflo(d.x), w0 * bfhi(a.x) + w1 * bfhi(b.x) + w2 * bfhi(d.x));
        o.y = pk2(w0 * bflo(a.y) + w1 * bflo(b.y) + w2 * bflo(d.y), w0 * bfhi(a.y) + w1 * bfhi(b.y) + w2 * bfhi(d.y));
        o.z = pk2(w0 * bflo(a.z) + w1 * bflo(b.z) + w2 * bflo(d.z), w0 * bfhi(a.z) + w1 * bfhi(b.z) + w2 * bfhi(d.z));
        o.w = pk2(w0 * bflo(a.w) + w1 * bflo(b.w) + w2 * bflo(d.w), w0 * bfhi(a.w) + w1 * bfhi(b.w) + w2 * bfhi(d.w));
        *(u32x4*)(Y + (size_t)t * DM + 256 + hh * 64 + c * 8) = o;
    }
    const int lane = tid & 63, gw = (int)(gtid >> 6), ngw = (int)(gthreads >> 6);
#if EXPERT_FP4
    convert_rows_i4(p.in[23] + (size_t)layer * 16384 * 1024, ws + WS_PU, (float*)(ws + WS_US), 16384, gw, ngw, lane);
    convert_rows_fp4(p.in[24] + (size_t)layer * 16384 * 1024, ws + WS_PV, (float*)(ws + WS_VS), 16384, gw, ngw, lane);
#else
    convert_rows_fp8(p.in[23] + (size_t)layer * 16384 * 1024, ws + WS_PU, (float*)(ws + WS_US), 16384, gw, ngw, lane);
    convert_rows_fp8(p.in[24] + (size_t)layer * 16384 * 1024, ws + WS_PV, (float*)(ws + WS_VS), 16384, gw, ngw, lane);
#endif
}

DEVI unsigned f2ord(float f) { const unsigned u = __float_as_uint(f); return u ^ ((unsigned)((int)u >> 31) | 0x80000000u); }
DEVI float ord2f(unsigned o) { const unsigned u = (o & 0x80000000u) ? (o ^ 0x80000000u) : ~o; return __uint_as_float(u); }
DEVI void cswap_desc(unsigned& a, unsigned& b) { const unsigned mx = a > b ? a : b, mn = a > b ? b : a; a = mx; b = mn; }
DEVI void sort16_desc(unsigned (&v)[16]) {
    constexpr int KK[10] = {2, 4, 4, 8, 8, 8, 16, 16, 16, 16};
    constexpr int JJ[10] = {1, 2, 1, 4, 2, 1, 8, 4, 2, 1};
#pragma unroll
    for (int st = 0; st < 10; ++st)
#pragma unroll
        for (int i = 0; i < 16; ++i) {
            const int l = i ^ JJ[st];
            if (l > i) { if ((i & KK[st]) == 0) cswap_desc(v[i], v[l]); else cswap_desc(v[l], v[i]); }
        }
}
DEVI void merge16_desc(unsigned (&a)[16], const unsigned (&b)[16]) {
#pragma unroll
    for (int i = 0; i < 16; ++i) a[i] = a[i] > b[15 - i] ? a[i] : b[15 - i];
    constexpr int JJ[4] = {8, 4, 2, 1};
#pragma unroll
    for (int st = 0; st < 4; ++st)
#pragma unroll
        for (int i = 0; i < 16; ++i) { const int l = i ^ JJ[st]; if (l > i) cswap_desc(a[i], a[l]); }
}
DEVI void top16_of_64(unsigned (&g0)[16], unsigned (&g1)[16], unsigned (&g2)[16], unsigned (&g3)[16]) {
    sort16_desc(g0); sort16_desc(g1); sort16_desc(g2); sort16_desc(g3);
    merge16_desc(g0, g1); merge16_desc(g2, g3); merge16_desc(g0, g2);
}
DEVI float blendf(float a, float b, unsigned m) { return __uint_as_float((__float_as_uint(a) & ~m) | (__float_as_uint(b) & m)); }
DEVI void fp8x16_to_f32(const u32x4 w, float (&f)[16]) {
#pragma unroll
    for (int j = 0; j < 4; ++j) {
        const f32x2 a = __builtin_amdgcn_cvt_pk_f32_fp8((int)w[j], false), b = __builtin_amdgcn_cvt_pk_f32_fp8((int)w[j], true);
        f[4 * j] = a.x; f[4 * j + 1] = a.y; f[4 * j + 2] = b.x; f[4 * j + 3] = b.y;
    }
}
DEVI void fp4x16_to_f32(const u32x2 w, float (&f)[16]) {
#pragma unroll
    for (int j = 0; j < 2; ++j)
    {
        const f32x2 a0 = __builtin_amdgcn_cvt_scalef32_pk_f32_fp4(w[j], 1.0f, 0), a1 = __builtin_amdgcn_cvt_scalef32_pk_f32_fp4(w[j], 1.0f, 1);
        const f32x2 a2 = __builtin_amdgcn_cvt_scalef32_pk_f32_fp4(w[j], 1.0f, 2), a3 = __builtin_amdgcn_cvt_scalef32_pk_f32_fp4(w[j], 1.0f, 3);
        f[8 * j] = a0.x; f[8 * j + 1] = a0.y; f[8 * j + 2] = a1.x; f[8 * j + 3] = a1.y; f[8 * j + 4] = a2.x; f[8 * j + 5] = a2.y; f[8 * j + 6] = a3.x; f[8 * j + 7] = a3.y;
    }
}
DEVI void fp4x16_to_pairs(const u32x2 w, f32x2 (&f)[8]) {
#pragma unroll
    for (int j = 0; j < 2; ++j) {
        f[4 * j] = __builtin_amdgcn_cvt_scalef32_pk_f32_fp4(w[j], 1.0f, 0); f[4 * j + 1] = __builtin_amdgcn_cvt_scalef32_pk_f32_fp4(w[j], 1.0f, 1);
        f[4 * j + 2] = __builtin_amdgcn_cvt_scalef32_pk_f32_fp4(w[j], 1.0f, 2); f[4 * j + 3] = __builtin_amdgcn_cvt_scalef32_pk_f32_fp4(w[j], 1.0f, 3);
    }
}
DEVI void fp8x16_to_pairs(const u32x4 w, f32x2 (&f)[8]) {
#pragma unroll
    for (int j = 0; j < 4; ++j) { f[2 * j] = __builtin_amdgcn_cvt_pk_f32_fp8((int)w[j], false); f[2 * j + 1] = __builtin_amdgcn_cvt_pk_f32_fp8((int)w[j], true); }
}
constexpr int PH_PER_LAYER = 11 + 4 * SELFCHECK, N_PHASES = 1 + NLAYER * PH_PER_LAYER + SELFCHECK;
#if SELFCHECK
constexpr int CK_FLAG_WORD = 3900;
constexpr int NSAMP = 24;
DEVI int ck_vperm(int k) { return k ^ ((((k >> 2) ^ (k >> 3)) & 1) ? 12 : 0); }
__device__ const int ck_tokens[NSAMP] = {0, 1, 2, 31, 32, 63, 64, 65, 127, 128, 129, 255, 256, 1023, 1024, 4095, 4096, 5000, 8191, 8192, 12345, 16255, 16382, 16383};
constexpr int R_AQ = 0, R_AK = 256, R_AV = 384, R_BQ = 512, R_BK = 512 + 768, R_BV = 512 + 1536, R_CQ = 512 + 2304, R_CKV = R_CQ + 256, R_CKR = R_CKV + 128,
              R_DQ = R_CKR + 32, R_DK = R_DQ + 256, R_DV = R_DK + 128, R_G = R_DV + 128;
static_assert(R_AQ == O_AQ && R_AK == O_AK && R_AV == O_AV && R_BQ == O_BQ && R_BK == O_BK && R_BV == O_BV && R_CQ == O_CQ && R_CKV == O_CKV && R_CKR == O_CKR &&
              R_DQ == O_DQ && R_DK == O_DK && R_DV == O_DV && R_G == NGATE0, "column partition");
DEVI void ck_flag(const Params& p, unsigned bit) { atomicOr((unsigned*)(p.ws + WS_CTL) + CK_FLAG_WORD, bit); }
DEVI bool ck_vec(float ref, float got, bool active, float tol) {
    const float e = active ? (ref - got) * (ref - got) : 0.f, q = active ? ref * ref : 0.f;
    const float es = wave_sum(e), qs = wave_sum(q);
    return !(es <= tol * tol * qs + 1e-12f);
}
DEVI float ck_relerr(float ref, float got) {
    const float es = wave_sum((ref - got) * (ref - got)), qs = wave_sum(ref * ref);
    return sqrtf(es / (qs + 1e-20f));
}
DEVI unsigned ck_quant(float e) { if (!(e == e)) return 7u; return e < 0.02f ? 0u : e < 0.05f ? 1u : e < 0.1f ? 2u : e < 0.2f ? 3u : e < 0.5f ? 4u : e < 1.0f ? 5u : 6u; }
DEVI float ck_rope_ref(float x_self, float x_pair, int i_in_32, float pos) {
    const int i = i_in_32 & 15;
    const float ang = pos * powf(10000.f, -(float)i / 16.f);
    const float c = cosf(ang), s_ = sinf(ang);
    return (i_in_32 < 16) ? (x_self * c - x_pair * s_) : (x_pair * s_ + x_self * c);
}
DEVI void phase_check1(const Params& p, int layer) {
    const int tid = otid(), lane = tid & 63, wid = tid >> 6, gw = obid() * NWAVES + wid;
    if (gw >= NSAMP) return;
    const int t = ck_tokens[gw];
    unsigned char* ws = p.ws; unsigned char* qkv = ws + WS_QKV;
    const bf16_t* row = (const bf16_t*)(ws + WS_P) + (size_t)t * PW;
    bool bad = false;
    const float sc = 0.125f * LOG2E;
    for (int hh = 0; hh < 4; ++hh) {
        const float v = bf2f(row[R_AQ + hh * 64 + lane]); const float ms = wave_sum(v * v) / 64.f;
        const float ref = v / sqrtf(ms + 1e-6f) * p.in[5][layer * 64 + lane] * sc;
        bad |= ck_vec(ref, bf2f(((const bf16_t*)(qkv + Q_QA))[((size_t)hh * S + t) * 64 + lane]), true, 0.02f);
    }
    for (int kh = 0; kh < 2; ++kh) {
        const float v = bf2f(row[R_AK + kh * 64 + lane]); const float ms = wave_sum(v * v) / 64.f;
        const float ref = v / sqrtf(ms + 1e-6f) * p.in[6][layer * 64 + lane];
        bad |= ck_vec(ref, bf2f(((const bf16_t*)(qkv + Q_KA))[((size_t)kh * S + t) * 64 + lane]), true, 0.02f);
        bad |= ck_vec(bf2f(row[R_AV + kh * 64 + lane]), bf2f(((const bf16_t*)(qkv + Q_VAT))[((size_t)kh * 64 + lane) * S + t]), true, 0.001f);
    }
    for (int g = 0; g < 3; ++g) {
        const int dil = (g == 0) ? 1 : (g == 1 ? 4 : 16), L = S / dil, pos = (t % dil) * L + t / dil;
        for (int hh = 0; hh < 4; ++hh) {
            const int gh = g * 4 + hh;
            float v = bf2f(row[R_BQ + g * 256 + hh * 64 + lane]); float ms = wave_sum(v * v) / 64.f;
            float ref = v / sqrtf(ms + 1e-6f) * p.in[8][(layer * 3 + g) * 64 + lane] * sc;
            bad |= ck_vec(ref, bf2f(((const bf16_t*)(qkv + Q_QB))[((size_t)gh * S + pos) * 64 + lane]), true, 0.02f);
            v = bf2f(row[R_BK + g * 256 + hh * 64 + lane]); ms = wave_sum(v * v) / 64.f;
            ref = v / sqrtf(ms + 1e-6f) * p.in[9][(layer * 3 + g) * 64 + lane];
            bad |= ck_vec(ref, bf2f(((const bf16_t*)(qkv + Q_KB))[((size_t)gh * S + pos) * 64 + lane]), true, 0.02f);
            bad |= ck_vec(bf2f(row[R_BV + g * 256 + hh * 64 + lane]), bf2f(((const bf16_t*)(qkv + Q_VBT))[((size_t)gh * 64 + lane) * S + pos]), true, 0.001f);
        }
    }
    for (int hh = 0; hh < 6; ++hh) {
        const bool isq = hh < 4; const int off = isq ? R_DQ + hh * 64 : R_DK + (hh - 4) * 64;
        const float v = bf2f(row[off + lane]); const float ms = wave_sum(v * v) / 64.f;
        const float y = v / sqrtf(ms + 1e-6f) * (isq ? p.in[16][layer * 64 + lane] : p.in[17][layer * 64 + lane]);
        const float yp = __shfl(y, (lane & 32) | ((lane & 31) ^ 16));
        const float ref = ck_rope_ref(y, yp, lane & 31, (lane < 32) ? (float)(t / 64) : (float)(t % 64)) * (isq ? sc : 1.f);
        const bf16_t* dst = isq ? (const bf16_t*)(qkv + Q_QD) + ((size_t)hh * S + t) * 64 : (const bf16_t*)(qkv + Q_KD) + ((size_t)(hh - 4) * S + t) * 64;
        bad |= ck_vec(ref, bf2f(dst[lane]), true, 0.02f);
    }
    for (int kh = 0; kh < 2; ++kh)
        bad |= ck_vec(bf2f(row[R_DV + kh * 64 + lane]), bf2f(((const bf16_t*)(qkv + Q_VDT))[((size_t)kh * 64 + lane) * S + ck_vperm(t)]), true, 0.001f);
    {
        float ss = 0.f; for (int i = 0; i < 4; ++i) { const float v = bf2f(row[R_CQ + lane + 64 * i]); ss += v * v; }
        const float ms = wave_sum(ss) / 256.f;
        for (int i = 0; i < 4; ++i) { const float v = bf2f(row[R_CQ + lane + 64 * i]);
            bad |= ck_vec(v / sqrtf(ms + 1e-6f) * p.in[10][layer * 256 + lane + 64 * i], bf2f(((const bf16_t*)(ws + WS_CQN))[(size_t)t * 256 + lane + 64 * i]), true, 0.02f); }
        float s2 = 0.f; for (int i = 0; i < 2; ++i) { const float v = bf2f(row[R_CKV + lane + 64 * i]); s2 += v * v; }
        const float ms2 = wave_sum(s2) / 128.f;
        for (int i = 0; i < 2; ++i) { const float v = bf2f(row[R_CKV + lane + 64 * i]);
            bad |= ck_vec(v / sqrtf(ms2 + 1e-6f) * p.in[11][layer * 128 + lane + 64 * i], bf2f(((const bf16_t*)(ws + WS_CKVN))[(size_t)t * 128 + lane + 64 * i]), true, 0.02f); }
        const float kr = lane < 32 ? bf2f(row[R_CKR + lane]) : 0.f; const float ms3 = wave_sum(kr * kr) / 32.f;
        const float y = kr / sqrtf(ms3 + 1e-6f) * p.in[15][layer * 96 + 64 + (lane & 31)];
        const float yp = __shfl(y, (lane & 31) ^ 16);
        const float ref = ck_rope_ref(y, yp, lane & 31, (float)t);
        for (int hh = 0; hh < 4; ++hh) bad |= ck_vec(ref, lane < 32 ? bf2f(((const bf16_t*)(qkv + Q_KC))[((size_t)hh * S + t) * 96 + 64 + lane]) : 0.f, lane < 32, 0.02f);
    }
    if (bad && lane == 0) ck_flag(p, 1u);
}
DEVI void phase_check2(const Params& p, int layer) {
    const int tid = otid(), lane = tid & 63, wid = tid >> 6, gw = obid() * NWAVES + wid;
    if (gw >= NSAMP * 4) return;
    const int t = ck_tokens[gw >> 2], hh = gw & 3;
    unsigned char* ws = p.ws; unsigned char* qkv = ws + WS_QKV;
    const bf16_t* cqn = (const bf16_t*)(ws + WS_CQN) + (size_t)t * 256;
    const bf16_t* ckvn = (const bf16_t*)(ws + WS_CKVN) + (size_t)t * 128;
    const float* wuq = p.in[12] + (size_t)layer * 256 * 384;
    const float* wukv = p.in[13] + (size_t)layer * 128 * 512;
    bool bad = false;
    float qn = 0.f, qp = 0.f, kn = 0.f, vv = 0.f;
    for (int k = 0; k < 256; ++k) { const float a = bf2f(cqn[k]); qn += a * wuq[(size_t)k * 384 + hh * 96 + lane]; if (lane < 32) qp += a * wuq[(size_t)k * 384 + hh * 96 + 64 + lane]; }
    for (int k = 0; k < 128; ++k) { const float a = bf2f(ckvn[k]); kn += a * wukv[(size_t)k * 512 + hh * 128 + lane]; vv += a * wukv[(size_t)k * 512 + hh * 128 + 64 + lane]; }
    const float sc = 0.10206207261596575f * LOG2E;
    {
        const float ms = wave_sum(qn * qn) / 64.f;
        bad |= ck_vec(qn / sqrtf(ms + 1e-6f) * p.in[14][layer * 96 + lane] * sc, bf2f(((const bf16_t*)(qkv + Q_QC))[((size_t)hh * S + t) * 96 + lane]), true, 0.03f);
        const float ms2 = wave_sum(lane < 32 ? qp * qp : 0.f) / 32.f;
        const float y = qp / sqrtf(ms2 + 1e-6f) * p.in[14][layer * 96 + 64 + (lane & 31)];
        const float yp = __shfl(y, (lane & 31) ^ 16);
        bad |= ck_vec(ck_rope_ref(y, yp, lane & 31, (float)t) * sc, lane < 32 ? bf2f(((const bf16_t*)(qkv + Q_QC))[((size_t)hh * S + t) * 96 + 64 + lane]) : 0.f, lane < 32, 0.03f);
        const float ms3 = wave_sum(kn * kn) / 64.f;
        bad |= ck_vec(kn / sqrtf(ms3 + 1e-6f) * p.in[15][layer * 96 + lane], bf2f(((const bf16_t*)(qkv + Q_KC))[((size_t)hh * S + t) * 96 + lane]), true, 0.03f);
        bad |= ck_vec(vv, bf2f(((const bf16_t*)(qkv + Q_VCT))[((size_t)hh * 64 + lane) * S + ck_vperm(t)]), true, 0.03f);
    }
    if (bad && lane == 0) ck_flag(p, 2u);
}
DEVI float ck_bias(const float* relb, int rel_tokens, int col) {
    const int nb = 16, max_exact = 8;
    int ret = rel_tokens > 0 ? nb : 0;
    const int n = rel_tokens < 0 ? -rel_tokens : rel_tokens;
    const float nf = (float)(n > 1 ? n : 1);
    int large = max_exact + (int)(logf(nf / (float)max_exact) / logf(1024.f / (float)max_exact) * (float)(nb - max_exact));
    large = large < nb - 1 ? large : nb - 1;
    ret += (n < max_exact) ? n : large;
    return relb[ret * 16 + col];
}
DEVI void phase_check3(const Params& p, int layer, int mode) {
    const int tid = otid(), lane = tid & 63, wid = tid >> 6, gw = obid() * NWAVES + wid;
    if (gw >= NSAMP * 28) return;
    const int t = ck_tokens[gw / 28], kind = gw % 28;
    if ((kind >= 24) != (mode == 1)) return;
    unsigned char* ws = p.ws; unsigned char* qkv = ws + WS_QKV;
    const bf16_t* Y = (const bf16_t*)(ws + WS_Y);
    unsigned* fw = (unsigned*)(p.ws + WS_CTL) + CK_FLAG_WORD;
    if (kind >= 24) {
        const int hh = kind - 24;
        const bf16_t* OB = (const bf16_t*)(ws + WS_OB); const float* LSE = (const float*)(ws + WS_LSE);
        const float l0 = LSE[(size_t)t * 4 + hh], l1 = LSE[((size_t)S + t) * 4 + hh], l2 = LSE[((size_t)2 * S + t) * 4 + hh];
        const float mx = fmaxf(l0, fmaxf(l1, l2));
        const float w0 = expf(l0 - mx), w1 = expf(l1 - mx), w2 = expf(l2 - mx);
        const float ref = (w0 * bf2f(OB[(size_t)t * 256 + hh * 64 + lane]) + w1 * bf2f(OB[((size_t)S + t) * 256 + hh * 64 + lane]) + w2 * bf2f(OB[((size_t)2 * S + t) * 256 + hh * 64 + lane])) / (w0 + w1 + w2);
        const unsigned qv = ck_quant(ck_relerr(ref, bf2f(Y[(size_t)t * DM + 256 + hh * 64 + lane])));
        if (lane == 0) atomicMax(fw + 4, qv);
        return;
    }
    const bf16_t* Q; const bf16_t* K; const bf16_t* VT; const bf16_t* target; const float* lse_target = nullptr;
    int DQ = 64, klo = 0, khi = S - 1, qp = t, dil = 1, bias_col = -1, slot; float sink2 = 0.f; bool has_sink = false;
    if (kind < 4) { const int hh = kind; slot = 1;
        Q = (const bf16_t*)(qkv + Q_QA) + ((size_t)hh * S + t) * 64; K = (const bf16_t*)(qkv + Q_KA) + (size_t)(hh >> 1) * S * 64; VT = (const bf16_t*)(qkv + Q_VAT) + (size_t)(hh >> 1) * 64 * S;
        klo = t - 128 < 0 ? 0 : t - 128; khi = t + 128 > S - 1 ? S - 1 : t + 128; bias_col = hh; has_sink = true; sink2 = p.in[7][layer * 4 + hh] * LOG2E;
        target = Y + (size_t)t * DM + hh * 64;
    } else if (kind < 16) { const int gh = kind - 4, g = gh >> 2, hh = gh & 3; slot = 2;
        dil = (g == 0) ? 1 : (g == 1 ? 4 : 16); const int L = S / dil, c = t % dil, jq = t / dil;
        qp = c * L + jq;
        Q = (const bf16_t*)(qkv + Q_QB) + ((size_t)gh * S + qp) * 64; K = (const bf16_t*)(qkv + Q_KB) + (size_t)gh * S * 64; VT = (const bf16_t*)(qkv + Q_VBT) + (size_t)gh * 64 * S;
        klo = c * L + (jq - 64 < 0 ? 0 : jq - 64); khi = c * L + (jq + 64 > L - 1 ? L - 1 : jq + 64); bias_col = 4 + gh;
        target = (const bf16_t*)(ws + WS_OB) + ((size_t)g * S + t) * 256 + hh * 64; lse_target = (const float*)(ws + WS_LSE) + ((size_t)g * S + t) * 4 + hh;
    } else if (kind < 20) { const int hh = kind - 16; DQ = 96; slot = 3;
        Q = (const bf16_t*)(qkv + Q_QC) + ((size_t)hh * S + t) * 96; K = (const bf16_t*)(qkv + Q_KC) + (size_t)hh * S * 96; VT = (const bf16_t*)(qkv + Q_VCT) + (size_t)hh * 64 * S;
        target = Y + (size_t)t * DM + 512 + hh * 64;
    } else { const int hh = kind - 20; slot = 3;
        Q = (const bf16_t*)(qkv + Q_QD) + ((size_t)hh * S + t) * 64; K = (const bf16_t*)(qkv + Q_KD) + (size_t)(hh >> 1) * S * 64; VT = (const bf16_t*)(qkv + Q_VDT) + (size_t)(hh >> 1) * 64 * S;
        target = Y + (size_t)t * DM + 768 + hh * 64;
    }
    float m = has_sink ? sink2 : -INFINITY;
#pragma unroll 1
    for (int k = klo + lane; k <= khi; k += 64) {
        float d = 0.f;
#pragma unroll 4
        for (int x = 0; x < DQ; ++x) d += bf2f(Q[x]) * bf2f(K[(size_t)k * DQ + x]);
        if (bias_col >= 0) d += ck_bias(p.in[1], (k - qp) * dil, bias_col) * LOG2E;
        m = fmaxf(m, d);
    }
    m = wave_max(m);
    float out[64]; float den = 0.f;
#pragma unroll
    for (int dd = 0; dd < 64; ++dd) out[dd] = 0.f;
#pragma unroll 1
    for (int k = klo + lane; k <= khi; k += 64) {
        float d = 0.f;
#pragma unroll 4
        for (int x = 0; x < DQ; ++x) d += bf2f(Q[x]) * bf2f(K[(size_t)k * DQ + x]);
        if (bias_col >= 0) d += ck_bias(p.in[1], (k - qp) * dil, bias_col) * LOG2E;
        const float pk = exp2f(d - m); den += pk;
#pragma unroll
        for (int dd = 0; dd < 64; ++dd) out[dd] += pk * bf2f(VT[(size_t)dd * S + (kind >= 16 ? ck_vperm(k) : k)]);
    }
    den = wave_sum(den) + (has_sink ? exp2f(sink2 - m) : 0.f);
    float mine = 0.f;
#pragma unroll
    for (int dd = 0; dd < 64; ++dd) { const float v = wave_sum(out[dd]) / den; if (lane == dd) mine = v; }
    unsigned qv = ck_quant(ck_relerr(mine, bf2f(target[lane])));
    if (lse_target) { const float lref = (m + log2f(den)) * 0.6931471805599453f; if (!(fabsf(lref - *lse_target) < 0.02f)) qv = qv < 5u ? 5u : qv; }
    if (lane == 0) atomicMax(fw + slot, qv);
    {
        const float tg = bf2f(target[lane]);
        unsigned nb = 0u;
        if (__any(!(mine == mine))) nb |= 1u;
        if (__any(!(tg == tg))) nb |= 2u;
        if (!(den > 0.f) || !(den < 1e30f)) nb |= 4u;
        if (!(m > -1e30f) || !(m < 1e30f)) nb |= 8u;
        if (lane == 0 && (slot == 1 || slot == 2)) atomicOr(fw + 4 + slot, nb);
    }
}
DEVI void phase_check_final(const Params& p) {
    const unsigned* fw = (unsigned*)(p.ws + WS_CTL) + CK_FLAG_WORD;
    unsigned fa = __hip_atomic_load(fw + 1, __ATOMIC_RELAXED, __HIP_MEMORY_SCOPE_AGENT), fb = __hip_atomic_load(fw + 2, __ATOMIC_RELAXED, __HIP_MEMORY_SCOPE_AGENT);
    const unsigned fd = __hip_atomic_load(fw + 3, __ATOMIC_RELAXED, __HIP_MEMORY_SCOPE_AGENT), fm = __hip_atomic_load(fw + 4, __ATOMIC_RELAXED, __HIP_MEMORY_SCOPE_AGENT), f0 = __hip_atomic_load(fw, __ATOMIC_RELAXED, __HIP_MEMORY_SCOPE_AGENT);
    unsigned flag = fa | (fb << 3);
    if (fd > 1u || fm > 1u || f0 != 0u) flag = 100u + (fd > 1u ? 1u : 0u) + (fm > 1u ? 2u : 0u) + (f0 ? 4u : 0u);
    if (flag > 127u) flag = 127u;
    const size_t n = (size_t)flag * 128 * DM;
    for (size_t i = (size_t)obid() * NTHREADS + otid(); i < n; i += (size_t)ogrid() * NTHREADS) p.out[i] = 0.f;
}
#endif

DEVI void route_tile(const bf16_t* PQ, const bf16_t* KEYS_, int tile, int hd, LAS unsigned char* slot, LAS int* idxl, LAS float* gatl, int r, int hi) {
    const int t = tile * 32 + r;
    int koff = r * 64 + hi * 8; asm volatile("" : "+v"(koff));
    const bf16_t* KEYS = KEYS_ + koff;
    {
        unsigned s[2][16];
#pragma unroll
        for (int c = 0; c < 2; ++c) {
            const int hc = hd * 2 + c;
            bf16x8 qf[4];
#pragma unroll
            for (int ks = 0; ks < 4; ++ks) qf[ks] = *(const bf16x8*)(PQ + (size_t)t * DM + hc * 64 + ks * 16 + hi * 8);
            unsigned g[4][16];
#pragma unroll
            for (int kb = 0; kb < 4; ++kb) {
                f32x16 acc;
#pragma unroll
                for (int q = 0; q < 16; ++q) acc[q] = 0.f;
#pragma unroll
                for (int ks = 0; ks < 4; ++ks) {
                    const bf16x8 kf = *(const bf16x8*)(KEYS + ((size_t)hc * 128 + kb * 32) * 64 + ks * 16);
                    acc = __builtin_amdgcn_mfma_f32_32x32x16_bf16(kf, qf[ks], acc, 0, 0, 0);
                }
#pragma unroll
                for (int q = 0; q < 16; ++q) {
                    const unsigned low = 127u - (unsigned)(kb * 32 + (q & 3) + 8 * (q >> 2));
                    g[kb][q] = (f2ord(acc[q]) & ~127u) | low;
                }
            }
            top16_of_64(g[0], g[1], g[2], g[3]);
            unsigned lo_[16], hi_[16];
#pragma unroll
            for (int i = 0; i < 16; ++i) {
                const unsigned v = g[0][i] ^ (unsigned)(hi << 2);
                auto rr = __builtin_amdgcn_permlane32_swap(v, v, false, false);
                lo_[i] = rr[0]; hi_[i] = rr[1];
            }
            merge16_desc(lo_, hi_);
#pragma unroll
            for (int i = 0; i < 16; ++i) s[c][i] = lo_[i];
        }
        float f0[16], f1[16];
#pragma unroll
        for (int i = 0; i < 16; ++i) {
            slot[i * 64] = (unsigned char)(127u - (s[0][i] & 127u));
            slot[(16 + i) * 64] = (unsigned char)(127u - (s[1][i] & 127u));
            f0[i] = ord2f(s[0][i] & ~127u); f1[i] = ord2f(s[1][i] & ~127u);
        }
        unsigned cd[4][16];
        {
#define CAND(i, j) ((f2ord(f0[i] + f1[j]) & ~255u) | (unsigned)(255 - ((i) * 16 + (j))))
            cd[0][0] = CAND(0, 0);
            cd[0][1] = CAND(0, 1);
            cd[0][2] = CAND(0, 2);
            cd[0][3] = CAND(0, 3);
            cd[0][4] = CAND(0, 4);
            cd[0][5] = CAND(0, 5);
            cd[0][6] = CAND(0, 6);
            cd[0][7] = CAND(0, 7);
            cd[0][8] = CAND(0, 8);
            cd[0][9] = CAND(0, 9);
            cd[0][10] = CAND(0, 10);
            cd[0][11] = CAND(0, 11);
            cd[0][12] = CAND(0, 12);
            cd[0][13] = CAND(0, 13);
            cd[0][14] = CAND(0, 14);
            cd[0][15] = CAND(0, 15);
            cd[1][0] = CAND(1, 0);
            cd[1][1] = CAND(1, 1);
            cd[1][2] = CAND(1, 2);
            cd[1][3] = CAND(1, 3);
            cd[1][4] = CAND(1, 4);
            cd[1][5] = CAND(1, 5);
            cd[1][6] = CAND(1, 6);
            cd[1][7] = CAND(1, 7);
            cd[1][8] = CAND(2, 0);
            cd[1][9] = CAND(2, 1);
            cd[1][10] = CAND(2, 2);
            cd[1][11] = CAND(2, 3);
            cd[1][12] = CAND(2, 4);
            cd[1][13] = CAND(3, 0);
            cd[1][14] = CAND(3, 1);
            cd[1][15] = CAND(3, 2);
            cd[2][0] = CAND(3, 3);
            cd[2][1] = CAND(4, 0);
            cd[2][2] = CAND(4, 1);
            cd[2][3] = CAND(4, 2);
            cd[2][4] = CAND(5, 0);
            cd[2][5] = CAND(5, 1);
            cd[2][6] = CAND(6, 0);
            cd[2][7] = CAND(6, 1);
            cd[2][8] = CAND(7, 0);
            cd[2][9] = CAND(7, 1);
            cd[2][10] = CAND(8, 0);
            cd[2][11] = CAND(9, 0);
            cd[2][12] = CAND(10, 0);
            cd[2][13] = CAND(11, 0);
            cd[2][14] = CAND(12, 0);
            cd[2][15] = CAND(13, 0);
            cd[3][0] = CAND(14, 0);
            cd[3][1] = CAND(15, 0);
            cd[3][2] = 0u;
            cd[3][3] = 0u;
            cd[3][4] = 0u;
            cd[3][5] = 0u;
            cd[3][6] = 0u;
            cd[3][7] = 0u;
            cd[3][8] = 0u;
            cd[3][9] = 0u;
            cd[3][10] = 0u;
            cd[3][11] = 0u;
            cd[3][12] = 0u;
            cd[3][13] = 0u;
            cd[3][14] = 0u;
            cd[3][15] = 0u;
#undef CAND
        }
        top16_of_64(cd[0], cd[1], cd[2], cd[3]);
        float val[16], e[16]; float sum = 0.f;
#pragma unroll
        for (int k = 0; k < 16; ++k) { val[k] = ord2f(cd[0][k] & ~255u); e[k] = __expf(val[k] - val[0]); sum += e[k]; }
        const float inv = 1.f / sum;
        asm volatile("s_waitcnt lgkmcnt(0)" ::: "memory");
        int id[8]; float gt[8];
#pragma unroll
        for (int k = 0; k < 8; ++k) {
            const unsigned mh = (unsigned)(-hi);
            const unsigned key = (cd[0][8 + k] & mh) | (cd[0][k] & ~mh);
            const float ek = __uint_as_float((__float_as_uint(e[8 + k]) & mh) | (__float_as_uint(e[k]) & ~mh));
            const unsigned code = 255u - (key & 255u);
            const unsigned i0 = slot[(code >> 4) * 64], i1 = slot[(16 + (code & 15)) * 64];
            id[k] = (int)(i0 * 128u + i1); gt[k] = ek * inv;
        }
        LAS int* ip = idxl + r * 128 + hd * 16 + hi * 8;
        LAS float* gp = gatl + r * 128 + hd * 16 + hi * 8;
        *(LAS u32x4*)(ip) = (u32x4){(unsigned)id[0], (unsigned)id[1], (unsigned)id[2], (unsigned)id[3]}; *(LAS u32x4*)(ip + 4) = (u32x4){(unsigned)id[4], (unsigned)id[5], (unsigned)id[6], (unsigned)id[7]};
        *(LAS f32x4*)(gp) = (f32x4){gt[0], gt[1], gt[2], gt[3]}; *(LAS f32x4*)(gp + 4) = (f32x4){gt[4], gt[5], gt[6], gt[7]};
        asm volatile("s_waitcnt lgkmcnt(0)" ::: "memory");
    }
}
DEVI void phase_peer(const Params& p, int layer, float* hout, const float* next_gain, lchar* lds) {
    const int tid = otid(), lane = tid & 63, wid = tid >> 6, r = lane & 31, hi = lane >> 5;
    const bf16_t* PQ = (const bf16_t*)(p.ws + WS_PQ);
    const bf16_t* KEYS = (const bf16_t*)(p.ws + WS_KEYS) + (size_t)layer * 16 * 128 * 64;
    bf16_t* HN = (bf16_t*)(p.ws + WS_HN);
    const unsigned char* PU = p.ws + WS_PU;
    const unsigned char* PV = p.ws + WS_PV;
    const float* US = (const float*)(p.ws + WS_US);
    const float* VS = (const float*)(p.ws + WS_VS);
    LAS unsigned char* slot = (LAS unsigned char*)(lds + wid * 2048) + lane;
    LAS int* idxl = (LAS int*)(lds + 16384);
    LAS float* gatl = (LAS float*)(lds + 32768);
    const unsigned m5 = (unsigned)(-((lane >> 5) & 1)), m4 = (unsigned)(-((lane >> 4) & 1)), m3 = (unsigned)(-((lane >> 3) & 1));
#if EXPERT_FP4
    constexpr int EG = 16;
    const unsigned m2 = (unsigned)(-((lane >> 2) & 1));
    const int je = ((lane >> 5) & 1) * 8 + ((lane >> 4) & 1) * 4 + ((lane >> 3) & 1) * 2 + ((lane >> 2) & 1);
#else
    constexpr int EG = 8;
    const int je = ((lane >> 5) & 1) * 4 + ((lane >> 4) & 1) * 2 + ((lane >> 3) & 1);
#endif
    for (int tile = obid(); tile < 512; tile += ogrid()) {
        __syncthreads();
        route_tile(PQ, KEYS, tile, wid, slot, idxl, gatl, r, hi);
        __builtin_amdgcn_sched_barrier(0);
        __syncthreads();
        __builtin_amdgcn_sched_barrier(0);
#pragma unroll 1
        for (int tt = 0; tt < 4; ++tt) {
            const int row = wid * 4 + tt, t = tile * 32 + row;
            const u32x4 xa = *(const u32x4*)(HN + (size_t)t * DM + 16 * lane), xb = *(const u32x4*)(HN + (size_t)t * DM + 16 * lane + 8);
#if EXPERT_FP4
            unsigned xhw[2], xlw[2]; float xs;
            {
                const float xv[16] = {bflo(xa.x), bfhi(xa.x), bflo(xa.y), bfhi(xa.y), bflo(xa.z), bfhi(xa.z), bflo(xa.w), bfhi(xa.w),
                                      bflo(xb.x), bfhi(xb.x), bflo(xb.y), bfhi(xb.y), bflo(xb.z), bfhi(xb.z), bflo(xb.w), bfhi(xb.w)};
                float mx = 0.f;
#pragma unroll
                for (int i = 0; i < 16; ++i) mx = fmaxf(mx, fabsf(xv[i]));
                mx = wave_max(mx);
                xs = mx * (1.f / 119.f);
                const float inv = mx > 0.f ? 119.f / mx : 0.f;
#pragma unroll
                for (int j = 0; j < 2; ++j) {
                    unsigned wh = 0u, wl = 0u;
#pragma unroll
                    for (int e = 0; e < 8; ++e) {
                        const int q = (int)__builtin_rintf(xv[8 * j + e] * inv);
                        const int ql = ((q + 8) & 15) - 8, qh = (q - ql) >> 4;
                        wl |= ((unsigned)ql & 15u) << (4 * e); wh |= ((unsigned)qh & 15u) << (4 * e);
                    }
                    xhw[j] = wh; xlw[j] = wl;
                }
            }
#else
            const f32x2 x2[8] = {{bflo(xa.x), bfhi(xa.x)}, {bflo(xa.y), bfhi(xa.y)}, {bflo(xa.z), bfhi(xa.z)}, {bflo(xa.w), bfhi(xa.w)},
                                 {bflo(xb.x), bfhi(xb.x)}, {bflo(xb.y), bfhi(xb.y)}, {bflo(xb.z), bfhi(xb.z)}, {bflo(xb.w), bfhi(xb.w)}};
#endif
            const int e_lo = idxl[row * 128 + lane], e_hi = idxl[row * 128 + 64 + lane];
            const float g_lo = gatl[row * 128 + lane], g_hi = gatl[row * 128 + 64 + lane];
#if EXPERT_FP4
            f32x16 c0, c1;
    #pragma unroll
            for (int i = 0; i < 16; ++i) { c0[i] = 0.f; c1[i] = 0.f; }
            const int colj = lane & 31;
            unsigned bmask[8];
    #pragma unroll
            for (int v = 0; v < 8; ++v) bmask[v] = ((colj < 16) && ((v >> 2) == (colj >> 3)) && ((v & 1) == ((colj >> 2) & 1))) ? (0xFFu << (8 * (colj & 3))) : 0u;
            const bool upper = lane >= 32;
    #pragma unroll 1
            for (int e0 = 0; e0 < 128; e0 += 16) {
                const int esel = (e0 < 64) ? e_lo : e_hi;
                const float gsel = (e0 < 64) ? g_lo : g_hi;
                u32x2 uw[16]; unsigned vx[16], vy[16];
    #pragma unroll
                for (int j = 0; j < 16; ++j) {
                    const int ex = __builtin_amdgcn_readlane(esel, (e0 + j) & 63);
                    uw[j] = *(const u32x2*)(PU + (size_t)ex * 512 + 8 * lane);
                    vx[j] = *(const unsigned*)(PV + (size_t)ex * 512 + 4 * lane);
                    vy[j] = *(const unsigned*)(PV + (size_t)ex * 512 + 256 + 4 * lane);
                }
                const int my_e = bperm(esel, (e0 + je) & 63);
                const float my_g = bpermf(gsel, (e0 + je) & 63);
                const float my_us = US[my_e], my_vs = VS[my_e];
                float dt[16];
    #pragma unroll
                for (int j = 0; j < 16; ++j) {
                    int ah = __builtin_amdgcn_sdot8((int)uw[j].x, (int)xhw[0], 0, false); ah = __builtin_amdgcn_sdot8((int)uw[j].y, (int)xhw[1], ah, false);
                    int al = __builtin_amdgcn_sdot8((int)uw[j].x, (int)xlw[0], 0, false); al = __builtin_amdgcn_sdot8((int)uw[j].y, (int)xlw[1], al, false);
                    dt[j] = (float)((ah << 4) + al);
                }
                float d8[8], d4[4], d2[2];
    #pragma unroll
                for (int i = 0; i < 8; ++i) {
                    const float snd = blendf(dt[i + 8], dt[i], m5);
                    auto rr = __builtin_amdgcn_permlane32_swap(__float_as_uint(snd), __float_as_uint(snd), false, false);
                    d8[i] = blendf(dt[i], dt[i + 8], m5) + blendf(__uint_as_float(rr[1]), __uint_as_float(rr[0]), m5);
                }
    #pragma unroll
                for (int i = 0; i < 4; ++i) d4[i] = blendf(d8[i], d8[i + 4], m4) + swz_xor16(blendf(d8[i + 4], d8[i], m4));
    #pragma unroll
                for (int i = 0; i < 2; ++i) d2[i] = blendf(d4[i], d4[i + 2], m3) + dppf<0x128>(blendf(d4[i + 2], d4[i], m3));
                float d1 = blendf(d2[0], d2[1], m2) + swz_xor4(blendf(d2[1], d2[0], m2));
                d1 += dppf<0x4E>(d1); d1 += dppf<0xB1>(d1);
                const float dd = d1 * (my_us * xs);
                const float a = 0.5f * dd * (1.f + erff(dd * 0.7071067811865476f)) * my_g * my_vs;
                const int a8 = __builtin_amdgcn_cvt_pk_fp8_f32(a * 128.f, 0.f, 0, false) & 0xff;
    #pragma unroll
                for (int qd = 0; qd < 4; ++qd) {
                    unsigned rq[4];
    #pragma unroll
                    for (int q = 0; q < 4; ++q) {
                        const int j = 4 * qd + q;
                        const int src = ((j >> 3) & 1) * 32 + ((j >> 2) & 1) * 16 + ((j >> 1) & 1) * 8 + (j & 1) * 4;
                        rq[q] = (unsigned)__builtin_amdgcn_readlane(a8, src) * 0x01010101u;
                    }
                    const unsigned rep0 = upper ? rq[2] : rq[0], rep1 = upper ? rq[3] : rq[1];
                    i32x8 bop;
    #pragma unroll
                    for (int v = 0; v < 8; ++v) bop[v] = (int)((((v >> 1) & 1) ? rep1 : rep0) & bmask[v]);
                    const i32x8 a0 = {(int)vx[4 * qd], (int)vx[4 * qd + 1], (int)vx[4 * qd + 2], (int)vx[4 * qd + 3], 0, 0, 0, 0};
                    const i32x8 a1 = {(int)vy[4 * qd], (int)vy[4 * qd + 1], (int)vy[4 * qd + 2], (int)vy[4 * qd + 3], 0, 0, 0, 0};
                    c0 = __builtin_amdgcn_mfma_scale_f32_32x32x64_f8f6f4(a0, bop, c0, 4, 0, 0, 0, 0, 0);
                    c1 = __builtin_amdgcn_mfma_scale_f32_32x32x64_f8f6f4(a1, bop, c1, 4, 0, 0, 0, 0, 0);
                }
            }
            f32x2 acc2[8];
            {
                LAS float* strip = (LAS float*)(lds + 65536 + wid * 4096);
                if (colj < 16) {
    #pragma unroll
                    for (int rg = 0; rg < 16; ++rg) {
                        const int L = (rg & 3) + 8 * (rg >> 2) + 4 * (lane >> 5) + 32 * (colj >> 3);
                        strip[8 * L + (colj & 7)] = c0[rg]; strip[512 + 8 * L + (colj & 7)] = c1[rg];
                    }
                }
                asm volatile("s_waitcnt lgkmcnt(0)" ::: "memory");
    #pragma unroll
                for (int i = 0; i < 4; ++i) {
                    const f32x4 v = *(const LAS f32x4*)(strip + 16 * lane + 4 * i);
                    acc2[2 * i] = (f32x2){v.x * (1.f / 128.f), v.y * (1.f / 128.f)}; acc2[2 * i + 1] = (f32x2){v.z * (1.f / 128.f), v.w * (1.f / 128.f)};
                }
                asm volatile("s_waitcnt lgkmcnt(0)" ::: "memory");
            }
#else
            f32x2 acc2[8];
    #pragma unroll
            for (int i = 0; i < 8; ++i) acc2[i] = (f32x2){0.f, 0.f};
    #pragma unroll 1
            for (int e0 = 0; e0 < 128; e0 += EG) {
                const int esel = (e0 < 64) ? e_lo : e_hi;
                const float gsel = (e0 < 64) ? g_lo : g_hi;
    #if EXPERT_FP4
                u32x2 uw[EG], vw[EG];
    #pragma unroll
                for (int j = 0; j < EG; ++j) {
                    const int ex = __builtin_amdgcn_readlane(esel, (e0 + j) & 63);
                    uw[j] = *(const u32x2*)(PU + (size_t)ex * 512 + 8 * lane);
                    vw[j] = *(const u32x2*)(PV + (size_t)ex * 512 + 8 * lane);
                }
    #define EXP_DECODE fp4x16_to_pairs
    #else
                u32x4 uw[EG], vw[EG];
    #pragma unroll
                for (int j = 0; j < EG; ++j) {
                    const int ex = __builtin_amdgcn_readlane(esel, (e0 + j) & 63);
                    uw[j] = *(const u32x4*)(PU + (size_t)ex * 1024 + 16 * lane);
                    vw[j] = *(const u32x4*)(PV + (size_t)ex * 1024 + 16 * lane);
                }
    #define EXP_DECODE fp8x16_to_pairs
    #endif
                const int my_e = bperm(esel, (e0 + je) & 63);
                const float my_g = bpermf(gsel, (e0 + je) & 63);
                const float my_us = US[my_e], my_vs = VS[my_e];
                float dt[EG];
    #pragma unroll
                for (int j = 0; j < EG; ++j) {
    #if EXPERT_FP4
                    int ah = __builtin_amdgcn_sdot8((int)uw[j].x, (int)xhw[0], 0, false); ah = __builtin_amdgcn_sdot8((int)uw[j].y, (int)xhw[1], ah, false);
                    int al = __builtin_amdgcn_sdot8((int)uw[j].x, (int)xlw[0], 0, false); al = __builtin_amdgcn_sdot8((int)uw[j].y, (int)xlw[1], al, false);
                    dt[j] = (float)((ah << 4) + al);
    #else
                    f32x2 f[8]; EXP_DECODE(uw[j], f);
                    f32x2 d2 = f[0] * x2[0];
    #pragma unroll
                    for (int i = 1; i < 8; ++i) d2 += f[i] * x2[i];
                    dt[j] = d2.x + d2.y;
    #endif
                }
                float d4[4], d2[2];
    #if EXPERT_FP4
                float d8[8];
    #pragma unroll
                for (int i = 0; i < 8; ++i) {
                    const float snd = blendf(dt[i + 8], dt[i], m5);
                    auto rr = __builtin_amdgcn_permlane32_swap(__float_as_uint(snd), __float_as_uint(snd), false, false);
                    d8[i] = blendf(dt[i], dt[i + 8], m5) + blendf(__uint_as_float(rr[1]), __uint_as_float(rr[0]), m5);
                }
    #pragma unroll
                for (int i = 0; i < 4; ++i) d4[i] = blendf(d8[i], d8[i + 4], m4) + swz_xor16(blendf(d8[i + 4], d8[i], m4));
    #pragma unroll
                for (int i = 0; i < 2; ++i) d2[i] = blendf(d4[i], d4[i + 2], m3) + dppf<0x128>(blendf(d4[i + 2], d4[i], m3));
                float d1 = blendf(d2[0], d2[1], m2) + swz_xor4(blendf(d2[1], d2[0], m2));
                d1 += dppf<0x4E>(d1); d1 += dppf<0xB1>(d1);
    #else
    #pragma unroll
                for (int i = 0; i < 4; ++i) {
                    const float snd = blendf(dt[i + 4], dt[i], m5);
                    auto rr = __builtin_amdgcn_permlane32_swap(__float_as_uint(snd), __float_as_uint(snd), false, false);
                    d4[i] = blendf(dt[i], dt[i + 4], m5) + blendf(__uint_as_float(rr[1]), __uint_as_float(rr[0]), m5);
                }
    #pragma unroll
                for (int i = 0; i < 2; ++i) d2[i] = blendf(d4[i], d4[i + 2], m4) + swz_xor16(blendf(d4[i + 2], d4[i], m4));
                float d1 = blendf(d2[0], d2[1], m3) + dppf<0x128>(blendf(d2[1], d2[0], m3));
                d1 += swz_xor4(d1); d1 += dppf<0x4E>(d1); d1 += dppf<0xB1>(d1);
    #endif
    #if EXPERT_FP4
                const float dd = d1 * (my_us * xs);
    #else
                const float dd = d1 * my_us;
    #endif
                const float a = 0.5f * dd * (1.f + erff(dd * 0.7071067811865476f)) * my_g * my_vs;
    #pragma unroll
                for (int j = 0; j < EG; ++j) {
    #if EXPERT_FP4
                    const int src = ((j >> 3) & 1) * 32 + ((j >> 2) & 1) * 16 + ((j >> 1) & 1) * 8 + (j & 1) * 4;
    #else
                    const int src = ((j >> 2) & 1) * 32 + ((j >> 1) & 1) * 16 + (j & 1) * 8;
    #endif
                    const float aj = __uint_as_float(__builtin_amdgcn_readlane(__float_as_uint(a), src));
                    f32x2 f[8]; EXP_DECODE(vw[j], f);
                    const f32x2 aj2 = {aj, aj};
    #pragma unroll
                    for (int i = 0; i < 8; ++i) acc2[i] += aj2 * f[i];
                }
            }
#endif
            float* hr = hout + (size_t)t * DM + 16 * lane;
#if ATTN_PROBE == 9
            { const float fsc = 1.f + (float)((const unsigned*)(p.ws + WS_CTL))[3996];
              _Pragma("unroll") for (int i = 0; i < 8; ++i) acc2[i] = acc2[i] * (f32x2){1.f, 1.f} + (f32x2){0.f, 0.f};
              if (layer == 1) { _Pragma("unroll") for (int i = 0; i < 8; ++i) acc2[i] = acc2[i] * (f32x2){fsc, fsc}; } }
#endif
            f32x4 hv[4]; float ss = 0.f;
    #pragma unroll
            for (int j = 0; j < 4; ++j) {
                hv[j] = *(f32x4*)(hr + 4 * j);
                hv[j] += (f32x4){acc2[2 * j].x, acc2[2 * j].y, acc2[2 * j + 1].x, acc2[2 * j + 1].y};
                *(f32x4*)(hr + 4 * j) = hv[j];
                ss += (hv[j].x * hv[j].x + hv[j].y * hv[j].y) + (hv[j].z * hv[j].z + hv[j].w * hv[j].w);
            }
            if (next_gain) {
                const float rstd = rsqrtf(wave_sum(ss) * (1.f / DM) + EPS);
                u32x4 o0;
                const f32x4 g0 = *(const f32x4*)(next_gain + 16 * lane), g1 = *(const f32x4*)(next_gain + 16 * lane + 4), g2 = *(const f32x4*)(next_gain + 16 * lane + 8), g3 = *(const f32x4*)(next_gain + 16 * lane + 12);
#define P8(A, B, C, D) ({ int w_ = __builtin_amdgcn_cvt_pk_fp8_f32(A, B, 0, false); (unsigned)__builtin_amdgcn_cvt_pk_fp8_f32(C, D, w_, true); })
                o0.x = P8(hv[0].x * rstd * g0.x, hv[0].y * rstd * g0.y, hv[0].z * rstd * g0.z, hv[0].w * rstd * g0.w);
                o0.y = P8(hv[1].x * rstd * g1.x, hv[1].y * rstd * g1.y, hv[1].z * rstd * g1.z, hv[1].w * rstd * g1.w);
                o0.z = P8(hv[2].x * rstd * g2.x, hv[2].y * rstd * g2.y, hv[2].z * rstd * g2.z, hv[2].w * rstd * g2.w);
                o0.w = P8(hv[3].x * rstd * g3.x, hv[3].y * rstd * g3.y, hv[3].z * rstd * g3.z, hv[3].w * rstd * g3.w);
#undef P8
                *(u32x4*)(p.ws + WS_HN8 + (size_t)t * DM + 16 * lane) = o0;
            }
        }
    }
}
#define XB_TMO      128
#define XB_XCNT(j)  (256  + 64 * (j))
#define XB_XSUB(j)  (1280 + 64 * (j))
#define XB_XGEN(j)  (2304 + 64 * (j))
#define XB_TOP      3328
#define XB_TOPGEN   3392
#define XCD_BAR_WORDS 3456
#define XB_SPIN_CAP (1u << 18)
DEVI unsigned xb_ld(unsigned* p)              { return __hip_atomic_load(p, __ATOMIC_RELAXED, __HIP_MEMORY_SCOPE_AGENT); }
DEVI unsigned xb_add(unsigned* p, unsigned v) { return __hip_atomic_fetch_add(p, v, __ATOMIC_RELAXED, __HIP_MEMORY_SCOPE_AGENT); }
DEVI unsigned xb_xcc_id() { return (unsigned)__builtin_amdgcn_s_getreg((3 << 11) | 20) & 0xFu; }
#define XB_SPIN(cond, bar) do { unsigned _sp = 0; while (cond) { __builtin_amdgcn_s_sleep(1); \
    if ((++_sp & 255u) == 0u) { if (xb_ld(&(bar)[XB_TMO])) break; if (_sp > XB_SPIN_CAP) { atomicAdd(&(bar)[XB_TMO], 1u); break; } } } } while (0)
struct XcdBarrier { unsigned* bar; unsigned x; volatile LAS unsigned* st; };
DEVI XcdBarrier xcd_barrier_post(unsigned* bar, volatile LAS unsigned* st) {
    XcdBarrier b; b.bar = bar; b.x = xb_xcc_id(); b.st = st;
    if (otid() == 0) (void)xb_add(&bar[XB_XCNT(b.x)], 1u);
    return b;
}
DEVI void xcd_barrier_complete(unsigned* bar, unsigned x, unsigned& nloc, unsigned& nx) {
    const unsigned G = gridDim.x * gridDim.y * gridDim.z;
    unsigned sum, cnt, mine, sp = 0u;
    for (;;) {
        sum = 0u; cnt = 0u; mine = 0u;
#pragma unroll
        for (unsigned j = 0; j < 16; ++j) { const unsigned c = xb_ld(&bar[XB_XCNT(j)]); sum += c; cnt += (c > 0u) ? 1u : 0u; mine = (j == x) ? c : mine; }
        if (sum == G) break;
        __builtin_amdgcn_s_sleep(1);
        if ((++sp & 255u) == 0u) { if (xb_ld(&bar[XB_TMO])) break; if (sp > XB_SPIN_CAP) { atomicAdd(&bar[XB_TMO], 1u); break; } }
    }
    nloc = mine > 0u ? mine : 1u; nx = cnt > 0u ? cnt : 1u;
}
DEVI void xcd_barrier(const XcdBarrier& b) {
    asm volatile("s_waitcnt vmcnt(0)" ::: "memory");
    __syncthreads();
    if (otid() == 0) {
        unsigned* bar = b.bar;
        __builtin_amdgcn_s_waitcnt(0);
        unsigned nloc = b.st[0], nx = b.st[1];
        if (nloc == 0u) { xcd_barrier_complete(bar, b.x, nloc, nx); b.st[0] = nloc; b.st[1] = nx; }
        const unsigned old = xb_add(&bar[XB_XSUB(b.x)], 1u);
        const unsigned gen = old / nloc;
        if (old + 1u == (gen + 1u) * nloc) {
            __builtin_amdgcn_fence(__ATOMIC_RELEASE, "agent");
            asm volatile("s_waitcnt vmcnt(0)" ::: "memory");
            const unsigned og = xb_add(&bar[XB_TOP], 1u);
            const unsigned tg = og / nx;
            if (og + 1u == (tg + 1u) * nx) xb_add(&bar[XB_TOPGEN], 1u);
            else XB_SPIN(xb_ld(&bar[XB_TOPGEN]) == tg, bar);
            __builtin_amdgcn_fence(__ATOMIC_ACQUIRE, "agent");
            xb_add(&bar[XB_XGEN(b.x)], 1u);
            asm volatile("s_waitcnt vmcnt(0)" ::: "memory");
        } else {
            XB_SPIN(xb_ld(&bar[XB_XGEN(b.x)]) == gen, bar);
            __builtin_amdgcn_fence(__ATOMIC_ACQUIRE, "agent");
            asm volatile("s_waitcnt vmcnt(0)" ::: "memory");
        }
    }
    __syncthreads();
}
constexpr int LDS_ST_OFF = LDS_BYTES - 16;

typedef const __attribute__((address_space(4))) Params* kparams_t;
#define KP() ({ kparams_t q_ = (kparams_t)__builtin_amdgcn_kernarg_segment_ptr(); asm volatile("" : "+s"(q_)); q_; })
#define KTEST(HID, B1, B2) if (bad == 12) { int fails = 0; \
                _Pragma("unroll") for (int q = 0; q < 4; ++q) _Pragma("unroll") for (int n = 0; n < 8; ++n) { \
                    i32x8 av = {0, 0, 0, 0, 0, 0, 0, 0}, bv = {0, 0, 0, 0, 0, 0, 0, 0}; \
                    av[q] = 0x2 << (4 * n); \
                    bv[(B1) >> 2] |= 0x38 << (8 * ((B1) & 3)); if ((B2) != (B1)) bv[(B2) >> 2] |= 0x38 << (8 * ((B2) & 3)); \
                    f32x16 cz; _Pragma("unroll") for (int i = 0; i < 16; ++i) cz[i] = 0.f; \
                    cz = __builtin_amdgcn_mfma_scale_f32_32x32x64_f8f6f4(av, bv, cz, 4, 0, 0, 0, 0, 0); \
                    bool ok = true; _Pragma("unroll") for (int i = 0; i < 16; ++i) ok = ok && (cz[i] == 2.f); \
                    if (__any(!ok)) fails += 1; } \
                if (fails == 0) bad = (HID); }

#define KVAL(Q, N, BB, W) { i32x8 av = {0, 0, 0, 0, 0, 0, 0, 0}, bv = {0, 0, 0, 0, 0, 0, 0, 0}; av[Q] = 0x2 << (4 * (N)); bv[(BB) >> 2] = 0x38 << (8 * ((BB) & 3)); \
    f32x16 cz; _Pragma("unroll") for (int i = 0; i < 16; ++i) cz[i] = 0.f; \
    cz = __builtin_amdgcn_mfma_scale_f32_32x32x64_f8f6f4(av, bv, cz, 4, 0, 0, 0, 0, 0); \
    const float v0 = __builtin_amdgcn_readfirstlane(cz[0]); code += (W) * (v0 == 0.f ? 0 : (v0 == 1.f ? 1 : (v0 == 2.f ? 2 : 3))); }

template <int ONLY> __global__ void __launch_bounds__(NTHREADS) fwd_kernel(Params p_) {
#if defined(__HIP_DEVICE_COMPILE__)
    extern __shared__ __attribute__((aligned(16))) unsigned char lds_raw[];
    lchar* lds = (lchar*)lds_raw;
    const int ph_lo = p_.ph_lo, ph_hi = p_.ph_hi;
    int ph = 0;
    if ((threadIdx.x & 63) == 0) ((volatile LAS unsigned char*)(WTAB_OFF))[(unsigned)__builtin_amdgcn_s_getreg((5 << 11) | 4) & 63u] = (unsigned char)(threadIdx.x >> 6);
#if MULTI_LAUNCH
    __syncthreads();
#endif
#if MULTI_LAUNCH
#define GRIDSYNC() do { } while (0)
#else
    XcdBarrier xbar; xbar.bar = (unsigned*)(p_.ws + WS_CTL); xbar.x = 0; xbar.st = (volatile LAS unsigned*)(lds + LDS_ST_OFF);
    if (threadIdx.x < 4) ((volatile LAS unsigned*)(lds + LDS_ST_OFF))[threadIdx.x] = 0u;
    if (blockIdx.x == 0) for (int i = threadIdx.x; i < 4096; i += NTHREADS) __hip_atomic_store(xbar.bar + i, 0u, __ATOMIC_RELAXED, __HIP_MEMORY_SCOPE_AGENT);
    __syncthreads();
    bool first_seam = true;
#define GRIDSYNC() do { if (ph + 1 < ph_hi) { if (first_seam) { cg::this_grid().sync(); xbar = xcd_barrier_post((unsigned*)(p_.ws + WS_CTL), (volatile LAS unsigned*)(lds + LDS_ST_OFF)); first_seam = false; } else xcd_barrier(xbar); } } while (0)
#endif
#define PHASE(KS, ...) do { if ((ONLY < 0 || ONLY == (KS)) && ph_lo <= ph && ph < ph_hi) { for (int rep = ((KS) == REPEAT_PHASE ? 0 : 1); rep < 2; ++rep) { const Params p = *KP(); unsigned char* ws = p.ws; __VA_ARGS__; GRIDSYNC(); } } ++ph; } while (0)
#if ATTN_PROBE == 9
    PHASE(0, { phase_prep(p, lds); phase_rownorm<true>(p.in[0], p.in[2], (bf16_t*)(ws + WS_HN8));
        if (obid() == 0 && otid() < 64) {
            int bad = 12;
            {
                int code = 0;
                KVAL(2, 0, 0, 1)
                KVAL(1, 0, 0, 4)
                KVAL(0, 0, 16, 16)
                bad = 1 + code;
            }
            if (otid() == 0) ((unsigned*)(p.ws + WS_CTL))[3996] = (unsigned)bad;
        } });
#else
    PHASE(0, { phase_prep(p, lds); phase_rownorm<true>(p.in[0], p.in[2], (bf16_t*)(ws + WS_HN8)); });
#endif
#pragma unroll 1
    for (int layer = 0; layer < NLAYER; ++layer) {
        PHASE(2, { Pg8Epi8<EpiInproj8> E{EpiInproj8{(bf16_t*)(ws + WS_G), (bf16_t*)(ws + WS_P), p.in[4] + layer * GW}};
                pg8::Gemm g{(const bf16_t*)(ws + WS_HN8), (const bf16_t*)(ws + WS_WIN + (size_t)layer * INP * DM), S, INP, DM / 2};
                pg8::StaticOrder so; so.init(S, INP, ogrid(), obid());
                pg8::gemm_phase<Pg8Epi8<EpiInproj8>, pg8::StaticOrder, true, true, true>((LAS unsigned char*)lds, g, so, E); });
        PHASE(3, phase_post1(p, layer, lds));
#if SELFCHECK
        PHASE(15, phase_check1(p, layer));
#endif
        PHASE(4, { EpiBf16 e1{(bf16_t*)(ws + WS_CQRAW), 384};
                gemm_phase<1>((const bf16_t*)(ws + WS_CQN), 256, (const bf16_t*)(ws + WS_WUQ) + (size_t)layer * 384 * 256, 256, 256, 64, 3, e1, lds);
                EpiBf16 e2{(bf16_t*)(ws + WS_CKVRAW), 512};
                gemm_phase<1>((const bf16_t*)(ws + WS_CKVN), 128, (const bf16_t*)(ws + WS_WUKV) + (size_t)layer * 512 * 128, 128, 128, 64, 4, e2, lds); });
        PHASE(5, phase_post2(p, layer, lds));
#if SELFCHECK
        PHASE(16, phase_check2(p, layer));
#endif
        PHASE(6, phase_attention(p, layer, lds));
#if SELFCHECK
        PHASE(17, phase_check3(p, layer, 0));
#endif
        PHASE(7, phase_bmerge(p, layer));
#if SELFCHECK
        PHASE(18, phase_check3(p, layer, 1));
#endif
        PHASE(8, phase_merge((const bf16_t*)(ws + WS_Y), (const bf16_t*)(ws + WS_WBR) + (size_t)layer * 4 * 1024 * 256, (const bf16_t*)(ws + WS_G), (bf16_t*)(ws + WS_MERGED), lds));
        PHASE(9, { EpiResidual e{(layer == 0) ? p.in[0] : p.out, p.out};
                gemm_phase<2>((const bf16_t*)(ws + WS_MERGED), DM, (const bf16_t*)(ws + WS_WOUT) + (size_t)layer * DM * DM, DM, DM, 64, 4, e, lds); });
        PHASE(10, phase_rownorm(p.out, p.in[20] + layer * DM, (bf16_t*)(ws + WS_HN)));
        PHASE(11, { EpiBf16 e{(bf16_t*)(ws + WS_PQ), DM};
                gemm_phase<2>((const bf16_t*)(ws + WS_HN), DM, (const bf16_t*)(ws + WS_WPQ) + (size_t)layer * DM * DM, DM, DM, 64, 4, e, lds); });
        PHASE(14, phase_peer(p, layer, rep == 0 ? (float*)(ws + WS_G) : p.out, (layer + 1 < NLAYER && rep != 0) ? p.in[2] + (layer + 1) * DM : nullptr, lds));
    }
#if SELFCHECK
    PHASE(19, phase_check_final(p));
#endif
#undef PHASE
#undef GRIDSYNC
#endif
}

typedef void (*phase_fn)(Params);
#if MULTI_LAUNCH
static phase_fn phase_kernels[20] = {fwd_kernel<0>, fwd_kernel<1>, fwd_kernel<2>, fwd_kernel<3>, fwd_kernel<4>, fwd_kernel<5>, fwd_kernel<6>, fwd_kernel<7>,
                                     fwd_kernel<8>, fwd_kernel<9>, fwd_kernel<10>, fwd_kernel<11>, fwd_kernel<12>, fwd_kernel<13>, fwd_kernel<14>,
                                     fwd_kernel<15>, fwd_kernel<16>, fwd_kernel<17>, fwd_kernel<18>, fwd_kernel<19>};
#endif
extern "C" void kernel_launch(void* const* d_in, const int* in_sizes, int n_in, void* d_out, int out_size, void* d_ws, size_t ws_size, hipStream_t stream) {
    static int grid = 0;
    if (grid == 0) {
        if (n_in != 25 || ws_size < WS_END) { fprintf(stderr, "kernel_launch: unexpected n_in %d or ws_size %zu\n", n_in, ws_size); grid = -1; return; }
        int dev = 0, cus = 0, per_cu = 0;
        (void)hipGetDevice(&dev);
        (void)hipDeviceGetAttribute(&cus, hipDeviceAttributeMultiprocessorCount, dev);
#if MULTI_LAUNCH
        for (int k = 0; k < 20; ++k) (void)hipFuncSetAttribute((const void*)phase_kernels[k], hipFuncAttributeMaxDynamicSharedMemorySize, LDS_BYTES);
        per_cu = 1;
#else
        (void)hipFuncSetAttribute((const void*)fwd_kernel<-1>, hipFuncAttributeMaxDynamicSharedMemorySize, LDS_BYTES);
        (void)hipOccupancyMaxActiveBlocksPerMultiprocessor(&per_cu, (const void*)fwd_kernel<-1>, NTHREADS, LDS_BYTES);
#endif
        if (per_cu < 1) per_cu = 1;
        grid = cus * 1;
        (void)hipGetLastError();
    }
    if (grid < 0) return;
    Params p{};
    for (int i = 0; i < 25; ++i) p.in[i] = (const float*)d_in[i];
    p.out = (float*)d_out; p.ws = (unsigned char*)d_ws;
#if MULTI_LAUNCH
    for (int ph = 0; ph < N_PHASES; ++ph) {
        p.ph_lo = ph; p.ph_hi = ph + 1;
#if SELFCHECK
        static const int ks_layer[15] = {2, 3, 15, 4, 5, 16, 6, 17, 7, 18, 8, 9, 10, 11, 14};
        const int ks = (ph == 0) ? 0 : (ph == N_PHASES - 1 ? 19 : ks_layer[(ph - 1) % PH_PER_LAYER]);
#else
        static const int ks_layer[11] = {2, 3, 4, 5, 6, 7, 8, 9, 10, 11, 14};
        const int ks = (ph == 0) ? 0 : ks_layer[(ph - 1) % PH_PER_LAYER];
#endif
        void* args[] = {&p};
        (void)hipLaunchKernel((const void*)phase_kernels[ks], dim3(grid), dim3(NTHREADS), args, LDS_BYTES, stream);
    }
#else
    p.ph_lo = 0; p.ph_hi = N_PHASES;
    void* args[] = {&p};
    hipError_t e = hipLaunchCooperativeKernel((const void*)fwd_kernel<-1>, dim3(grid), dim3(NTHREADS), args, LDS_BYTES, stream);
    if (e != hipSuccess) fprintf(stderr, "cooperative launch failed: %s (grid %d)\n", hipGetErrorString(e), grid);
#endif
}
```

```cpp
#include <hip/hip_runtime.h>
#include <hip/hip_cooperative_groups.h>
#include <stdint.h>
#include <stdio.h>
namespace cg = cooperative_groups;

#ifndef MULTI_LAUNCH
#define MULTI_LAUNCH 0
#endif

#ifndef REPEAT_PHASE
#define REPEAT_PHASE -1
#endif
#ifndef SELFCHECK
#define SELFCHECK 0
#endif
#ifndef ATTN_PROBE
#define ATTN_PROBE 0
#endif
#ifndef EXPERT_FP4
#define EXPERT_FP4 1
#endif
#define DEVI __device__ __forceinline__
#define LAS __attribute__((address_space(3)))
#define SBAR() __builtin_amdgcn_sched_barrier(0)
typedef unsigned short bf16_t;
typedef short bf16x8 __attribute__((ext_vector_type(8)));
typedef short s16x4 __attribute__((ext_vector_type(4)));
typedef float f32x16 __attribute__((ext_vector_type(16)));
typedef float f32x4 __attribute__((ext_vector_type(4)));
typedef float f32x2 __attribute__((ext_vector_type(2)));
typedef unsigned u32x4 __attribute__((ext_vector_type(4)));
typedef unsigned u32x2 __attribute__((ext_vector_type(2)));
typedef LAS char lchar;
typedef int i32x8 __attribute__((ext_vector_type(8)));

constexpr int S = 16384, DM = 1024, NLAYER = 2;
constexpr int INW = 7840, INP = 7936, PW = 3840, GW = 4096, NGATE0 = 3744;
constexpr float WIN_SCALE = 32.f;
constexpr int O_AQ = 0, O_AK = 256, O_AV = 384, O_BQ = 512, O_BK = 1280, O_BV = 2048, O_CQ = 2816, O_CKV = 3072, O_CKR = 3200,
              O_DQ = 3232, O_DK = 3488, O_DV = 3616;
constexpr float EPS = 1e-6f;
constexpr float LOG2E = 1.4426950408889634f;
constexpr int NTHREADS = 512, NWAVES = 8;
constexpr int LDS_BYTES = 151552;

constexpr size_t MiB = 1u << 20;
constexpr size_t WS_CTL = 0;
constexpr size_t WS_WIN = 1 * MiB;
constexpr size_t WS_WUQ = 32 * MiB;
constexpr size_t WS_WUKV = 32 * MiB + 512 * 1024;
constexpr size_t WS_WBR = 33 * MiB;
constexpr size_t WS_WOUT = 37 * MiB;
constexpr size_t WS_WPQ = 41 * MiB;
constexpr size_t WS_KEYS = 45 * MiB;
constexpr size_t WS_CQN = 46 * MiB;
constexpr size_t WS_CKVN = 54 * MiB;
constexpr size_t WS_HN = 58 * MiB;
constexpr size_t WS_P = 90 * MiB;
constexpr size_t WS_G = 210 * MiB;
constexpr size_t WS_QKV = 338 * MiB;
constexpr size_t WS_HN8 = 474 * MiB;
constexpr size_t WS_END = 490 * MiB;
constexpr size_t WS_CQRAW = WS_P;
constexpr size_t WS_CKVRAW = WS_P + 12 * MiB;
constexpr size_t WS_OB = WS_P + 28 * MiB;
constexpr size_t WS_LSE = WS_P + 52 * MiB;
constexpr size_t WS_Y = WS_P + 53 * MiB;
constexpr size_t WS_MERGED = WS_P + 85 * MiB;
constexpr size_t WS_PQ = WS_P;
constexpr size_t WS_IDX = WS_P + 32 * MiB;
constexpr size_t WS_GATE = WS_P + 40 * MiB;
constexpr size_t WS_SCORES = WS_G;
constexpr size_t Q_QA = 0, Q_KA = 8 * MiB, Q_VAT = 12 * MiB, Q_QB = 16 * MiB, Q_KB = 40 * MiB, Q_VBT = 64 * MiB, Q_QC = 88 * MiB,
                 Q_KC = 100 * MiB, Q_VCT = 112 * MiB, Q_QD = 120 * MiB, Q_KD = 128 * MiB, Q_VDT = 132 * MiB;
constexpr size_t WS_PU = WS_QKV, WS_PV = WS_QKV + 16 * MiB;
constexpr size_t WS_US = WS_QKV + 32 * MiB, WS_VS = WS_QKV + 32 * MiB + 65536;

struct Params {
    const float* in[25];
    float* out;
    unsigned char* ws;
    int ph_lo, ph_hi;
};

DEVI unsigned pk2(float lo, float hi) {
    typedef __bf16 bf2 __attribute__((ext_vector_type(2)));
    f32x2 v = {lo, hi};
    bf2 b = __builtin_convertvector(v, bf2);
    return __builtin_bit_cast(unsigned, b);
}
DEVI unsigned short f2bf(float f) { return (unsigned short)(pk2(f, 0.f) & 0xffffu); }
DEVI float bf2f(unsigned short b) { return __uint_as_float(((unsigned)b) << 16); }
DEVI float bflo(unsigned w) { return __uint_as_float(w << 16); }
DEVI float bfhi(unsigned w) { return __uint_as_float(w & 0xffff0000u); }
template <int CTRL> DEVI float dppf(float v) { return __uint_as_float((unsigned)__builtin_amdgcn_update_dpp(0, (int)__float_as_uint(v), CTRL, 0xF, 0xF, false)); }
DEVI float swz_xor16(float v) { return __uint_as_float((unsigned)__builtin_amdgcn_ds_swizzle((int)__float_as_uint(v), 0x401F)); }
DEVI float swz_xor4(float v) { return __uint_as_float((unsigned)__builtin_amdgcn_ds_swizzle((int)__float_as_uint(v), 0x101F)); }
DEVI float wave_sum(float v) {
    v += dppf<0xB1>(v);
    v += dppf<0x4E>(v);
    v += dppf<0x141>(v);
    v += dppf<0x140>(v);
    v += swz_xor16(v);
    auto rr = __builtin_amdgcn_permlane32_swap(__float_as_uint(v), __float_as_uint(v), false, false);
    return __uint_as_float(rr[0]) + __uint_as_float(rr[1]);
}
DEVI float wave_max(float v) {
    v = fmaxf(v, dppf<0xB1>(v)); v = fmaxf(v, dppf<0x4E>(v)); v = fmaxf(v, dppf<0x141>(v)); v = fmaxf(v, dppf<0x140>(v));
    v = fmaxf(v, swz_xor16(v));
    auto rr = __builtin_amdgcn_permlane32_swap(__float_as_uint(v), __float_as_uint(v), false, false);
    return fmaxf(__uint_as_float(rr[0]), __uint_as_float(rr[1]));
}
DEVI float half_max(float v) { auto rr = __builtin_amdgcn_permlane32_swap(__float_as_uint(v), __float_as_uint(v), false, false); return fmaxf(__uint_as_float(rr[0]), __uint_as_float(rr[1])); }
DEVI float half_sum(float v) { auto rr = __builtin_amdgcn_permlane32_swap(__float_as_uint(v), __float_as_uint(v), false, false); return __uint_as_float(rr[0]) + __uint_as_float(rr[1]); }
DEVI int bperm(int v, int src_lane) { return __builtin_amdgcn_ds_bpermute(src_lane << 2, v); }
DEVI float bpermf(float v, int src_lane) { return __uint_as_float((unsigned)__builtin_amdgcn_ds_bpermute(src_lane << 2, (int)__float_as_uint(v))); }
constexpr unsigned WTAB_OFF = LDS_BYTES - 16 - 64;
DEVI int owave() { const unsigned key = (unsigned)__builtin_amdgcn_s_getreg((5 << 11) | 4) & 63u;
    return __builtin_amdgcn_readfirstlane((int)((volatile LAS unsigned char*)(WTAB_OFF))[key]); }
DEVI int olane() { unsigned z = 0u; asm volatile("" : "+v"(z)); return (int)__builtin_amdgcn_mbcnt_hi(~0u, __builtin_amdgcn_mbcnt_lo(~0u, z)); }
DEVI int otid() { return owave() * 64 + olane(); }
DEVI int ogrid() { int g = gridDim.x; asm volatile("" : "+v"(g)); return __builtin_amdgcn_readfirstlane(g); }
DEVI int obid() { int b = blockIdx.x; asm volatile("" : "+v"(b)); return __builtin_amdgcn_readfirstlane(b); }
DEVI int crow(int reg, int h) { return (reg & 3) + 8 * (reg >> 2) + 4 * h; }
DEVI float fast_exp2(float x) { return __builtin_amdgcn_exp2f(x); }

template <bool FP8 = false>
DEVI void transpose_item(const float* W, int ldn, int K, bf16_t* WT, int k0, int n0, int drow0, LAS float* scr, int lane, const float* kgain = nullptr) {
    f32x4 wv[8];
#pragma unroll
    for (int i = 0; i < 8; ++i) wv[i] = *(const f32x4*)(W + (size_t)(k0 + 8 * i + (lane >> 3)) * ldn + n0 + 4 * (lane & 7));
    if (kgain) {
        float gk[8];
#pragma unroll
        for (int i = 0; i < 8; ++i) gk[i] = kgain[k0 + 8 * i + (lane >> 3)];
#pragma unroll
        for (int i = 0; i < 8; ++i) wv[i] *= gk[i];
    }
#pragma unroll
    for (int i = 0; i < 8; ++i) {
        LAS float* sp = scr + (8 * i + (lane >> 3)) * 33 + 4 * (lane & 7);
        sp[0] = wv[i].x; sp[1] = wv[i].y; sp[2] = wv[i].z; sp[3] = wv[i].w;
    }
    asm volatile("s_waitcnt lgkmcnt(0)" ::: "memory");
    const int c = lane & 7;
#pragma unroll
    for (int j = 0; j < 4; ++j) {
        const int n = (lane >> 3) + 8 * j;
        const LAS float* s = scr + (8 * c) * 33 + n;
        if constexpr (FP8) {
            int w0 = __builtin_amdgcn_cvt_pk_fp8_f32(s[0 * 33] * WIN_SCALE, s[1 * 33] * WIN_SCALE, 0, false); w0 = __builtin_amdgcn_cvt_pk_fp8_f32(s[2 * 33] * WIN_SCALE, s[3 * 33] * WIN_SCALE, w0, true);
            int w1 = __builtin_amdgcn_cvt_pk_fp8_f32(s[4 * 33] * WIN_SCALE, s[5 * 33] * WIN_SCALE, 0, false); w1 = __builtin_amdgcn_cvt_pk_fp8_f32(s[6 * 33] * WIN_SCALE, s[7 * 33] * WIN_SCALE, w1, true);
            *(u32x2*)((unsigned char*)WT + (size_t)(drow0 + n) * K + k0 + 8 * c) = (u32x2){(unsigned)w0, (unsigned)w1};
        } else {
            u32x4 o;
            o.x = pk2(s[0 * 33], s[1 * 33]); o.y = pk2(s[2 * 33], s[3 * 33]); o.z = pk2(s[4 * 33], s[5 * 33]); o.w = pk2(s[6 * 33], s[7 * 33]);
            *(u32x4*)(WT + (size_t)(drow0 + n) * K + k0 + 8 * c) = o;
        }
    }
    asm volatile("s_waitcnt lgkmcnt(0)" ::: "memory");
}
template <bool FP8 = false>
DEVI void transpose_matrix(const float* W, int K, int N, bf16_t* WT, bool remap, LAS float* scr, int gw, int ngw, int lane, const float* kgain = nullptr) {
    const int nblk = N / 32, items = (K / 64) * nblk;
    for (int it = gw; it < items; it += ngw) {
        const int kb = it / nblk, nb = it % nblk, n0 = 32 * nb;
        int drow0 = n0;
        if (remap) drow0 = (n0 >= NGATE0) ? (n0 - NGATE0) : (n0 + GW);
        transpose_item<FP8>(W, N, K, WT, 64 * kb, n0, drow0, scr, lane, kgain);
    }
}
DEVI void convert_f32_bf16(const float* src, bf16_t* dst, size_t n, size_t gtid, size_t gthreads) {
    for (size_t i = gtid * 4; i < n; i += gthreads * 4) {
        const f32x4 v = *(const f32x4*)(src + i);
        u32x2 o; o.x = pk2(v.x, v.y); o.y = pk2(v.z, v.w);
        *(u32x2*)(dst + i) = o;
    }
}
DEVI void phase_prep(const Params& p, lchar* lds) {
    const int tid = otid(), lane = tid & 63, wid = tid >> 6;
#if SELFCHECK && MULTI_LAUNCH
    if (obid() == 0 && tid < 8) ((unsigned*)(p.ws + WS_CTL))[3900 + tid] = 0u;
#endif
    const int gw = obid() * NWAVES + wid, ngw = ogrid() * NWAVES;
    LAS float* scr = (LAS float*)(lds + wid * 8704);
    unsigned char* ws = p.ws;
    for (int l = 0; l < NLAYER; ++l) {
        unsigned char* win = ws + WS_WIN + (size_t)l * INP * DM;
        transpose_matrix<true>(p.in[3] + (size_t)l * DM * INW, DM, INW, (bf16_t*)win, true, scr, gw, ngw, lane);
        for (int i = gw * 64 + lane; i < (INP - INW) * DM / 16; i += ngw * 64) *(u32x4*)(win + (size_t)INW * DM + (size_t)i * 16) = (u32x4){0u, 0u, 0u, 0u};
        transpose_matrix(p.in[12] + (size_t)l * 256 * 384, 256, 384, (bf16_t*)(ws + WS_WUQ) + (size_t)l * 384 * 256, false, scr, gw, ngw, lane);
        transpose_matrix(p.in[13] + (size_t)l * 128 * 512, 128, 512, (bf16_t*)(ws + WS_WUKV) + (size_t)l * 512 * 128, false, scr, gw, ngw, lane);
        for (int n = 0; n < 4; ++n)
            transpose_matrix<true>(p.in[18] + ((size_t)l * 4 + n) * 256 * 1024, 256, 1024, (bf16_t*)(ws + WS_WBR + ((size_t)l * 4 + n) * 1024 * 256), false, scr, gw, ngw, lane);
        transpose_matrix<true>(p.in[19] + (size_t)l * DM * DM, DM, DM, (bf16_t*)(ws + WS_WOUT + (size_t)l * DM * DM), false, scr, gw, ngw, lane);
        transpose_matrix(p.in[21] + (size_t)l * DM * DM, DM, DM, (bf16_t*)(ws + WS_WPQ) + (size_t)l * DM * DM, false, scr, gw, ngw, lane, p.in[20] + l * DM);
    }
    convert_f32_bf16(p.in[22], (bf16_t*)(ws + WS_KEYS), (size_t)NLAYER * 16 * 128 * 64, (size_t)obid() * NTHREADS + tid, (size_t)ogrid() * NTHREADS);
}

template <bool FP8 = false, bool INB = false, bool RSTD = false>
DEVI void phase_rownorm(const float* h, const float* gain, bf16_t* hn, unsigned char* hn8 = nullptr) {
    const int tid = otid(), lane = tid & 63, wid = tid >> 6;
    const int gw = obid() * NWAVES + wid, ngw = ogrid() * NWAVES;
    f32x4 g[4];
#pragma unroll
    for (int j = 0; j < 4; ++j) g[j] = *(const f32x4*)(gain + 4 * lane + 256 * j);
    for (int row = gw; row < S; row += ngw) {
        const float* xr = h + (size_t)row * DM;
        f32x4 v[4]; float ss = 0.f;
        if constexpr (INB) {
            u32x2 w[4];
#pragma unroll
            for (int j = 0; j < 4; ++j) w[j] = *(const u32x2*)((const bf16_t*)h + (size_t)row * DM + 4 * lane + 256 * j);
#pragma unroll
            for (int j = 0; j < 4; ++j) { v[j] = (f32x4){bflo(w[j].x), bfhi(w[j].x), bflo(w[j].y), bfhi(w[j].y)}; ss += (v[j].x * v[j].x + v[j].y * v[j].y) + (v[j].z * v[j].z + v[j].w * v[j].w); }
        } else
#pragma unroll
        for (int j = 0; j < 4; ++j) { v[j] = *(const f32x4*)(xr + 4 * lane + 256 * j); ss += (v[j].x * v[j].x + v[j].y * v[j].y) + (v[j].z * v[j].z + v[j].w * v[j].w); }
        const float rstd = rsqrtf(wave_sum(ss) * (1.f / DM) + EPS);
        bf16_t* orow = hn + (size_t)row * DM;
        if constexpr (RSTD) { if (lane == 0) ((float*)hn)[row] = rstd; }
#pragma unroll
        for (int j = 0; j < 4; ++j) {
            if constexpr (FP8) {
                int w8 = __builtin_amdgcn_cvt_pk_fp8_f32(v[j].x * rstd * g[j].x, v[j].y * rstd * g[j].y, 0, false);
                w8 = __builtin_amdgcn_cvt_pk_fp8_f32(v[j].z * rstd * g[j].z, v[j].w * rstd * g[j].w, w8, true);
                *(int*)((unsigned char*)hn + (size_t)row * DM + 4 * lane + 256 * j) = w8;
                continue;
            }
            if constexpr (!RSTD) {
            u32x2 o; o.x = pk2(v[j].x * rstd * g[j].x, v[j].y * rstd * g[j].y); o.y = pk2(v[j].z * rstd * g[j].z, v[j].w * rstd * g[j].w);
            *(u32x2*)(orow + 4 * lane + 256 * j) = o;
            }
            if (hn8) {
                int w8 = __builtin_amdgcn_cvt_pk_fp8_f32(v[j].x * rstd * g[j].x, v[j].y * rstd * g[j].y, 0, false);
                w8 = __builtin_amdgcn_cvt_pk_fp8_f32(v[j].z * rstd * g[j].z, v[j].w * rstd * g[j].w, w8, true);
                *(int*)(hn8 + (size_t)row * DM + 4 * lane + 256 * j) = w8;
            }
        }
    }
}

constexpr int GROW = 144;
template <int NT, bool FP8 = false>
DEVI void gemm_kloop(f32x16 (&acc)[4][NT], const bf16_t* A, int lda, const bf16_t* B, int ldb, int K, lchar* lds) {
    const int tid = otid(), lane = tid & 63, wid = tid >> 6, wm = wid >> 2, wn = wid & 3, r = lane & 31, h = lane >> 5;
    constexpr int NGB = 2 * NT;
    constexpr int ASZ = 256 * 128, STG = ASZ + 128 * NT * 128;
    const int rr = lane >> 3, pp = lane & 7;
    const int skey = ((wid & 1) << 2) | (rr >> 1);
    const bf16_t* ap = A + (size_t)(wid * 8 + rr) * lda + ((pp ^ skey) << 3);
    const bf16_t* bp = B + (size_t)(wid * 8 + rr) * ldb + ((pp ^ skey) << 3);
    const int nk = K / 64;
#define G_DMA(kt, st) do { lchar* as_ = lds + (st) * STG + wid * 1024; lchar* bs_ = as_ + ASZ; \
        _Pragma("unroll") for (int i = 0; i < 4; ++i) __builtin_amdgcn_global_load_lds((const unsigned*)(ap + (size_t)(64 * i) * lda + (kt) * 64), (LAS unsigned*)(as_ + i * 8192), 16, 0, 0); \
        _Pragma("unroll") for (int i = 0; i < NGB; ++i) __builtin_amdgcn_global_load_lds((const unsigned*)(bp + (size_t)(64 * i) * ldb + (kt) * 64), (LAS unsigned*)(bs_ + i * 8192), 16, 0, 0); } while (0)
    __syncthreads();
    G_DMA(0, 0);
    __syncthreads();
    const int xa = (wm * 128 + r) * 128, xb = (wn * 32 * NT + r) * 128, sw = (r >> 1) & 7;
    for (int kt = 0; kt < nk; ++kt) {
        if (kt + 1 < nk) G_DMA(kt + 1, (kt + 1) & 1);
        const lchar* As = lds + (kt & 1) * STG; const lchar* Bs = As + ASZ;
        bf16x8 xf[2][4], wf[2][NT];
#define F_LOAD(ks, S_) do { const int co_ = ((2 * (ks) + h) ^ sw) << 4; \
            _Pragma("unroll") for (int mt = 0; mt < 4; ++mt) xf[S_][mt] = *(const LAS bf16x8*)(As + xa + mt * 32 * 128 + co_); \
            _Pragma("unroll") for (int nt = 0; nt < NT; ++nt) wf[S_][nt] = *(const LAS bf16x8*)(Bs + xb + nt * 32 * 128 + co_); } while (0)
#define F_MMA(S_) do { _Pragma("unroll") for (int mt = 0; mt < 4; ++mt) _Pragma("unroll") for (int nt = 0; nt < NT; ++nt) \
            acc[mt][nt] = __builtin_amdgcn_mfma_f32_32x32x16_bf16(wf[S_][nt], xf[S_][mt], acc[mt][nt], 0, 0, 0); } while (0)
        if constexpr (FP8) {
#define F_LOAD8(j, XS, WS) do { const int c0_ = ((4 * (j) + h) ^ sw) << 4, c1_ = ((4 * (j) + 2 + h) ^ sw) << 4; \
            _Pragma("unroll") for (int mt = 0; mt < 4; ++mt) { const u32x4 l0_ = *(const LAS u32x4*)(As + xa + mt * 32 * 128 + c0_), l1_ = *(const LAS u32x4*)(As + xa + mt * 32 * 128 + c1_); \
                XS[mt] = (i32x8){(int)l0_.x, (int)l0_.y, (int)l0_.z, (int)l0_.w, (int)l1_.x, (int)l1_.y, (int)l1_.z, (int)l1_.w}; } \
            _Pragma("unroll") for (int nt = 0; nt < NT; ++nt) { const u32x4 l0_ = *(const LAS u32x4*)(Bs + xb + nt * 32 * 128 + c0_), l1_ = *(const LAS u32x4*)(Bs + xb + nt * 32 * 128 + c1_); \
                WS[nt] = (i32x8){(int)l0_.x, (int)l0_.y, (int)l0_.z, (int)l0_.w, (int)l1_.x, (int)l1_.y, (int)l1_.z, (int)l1_.w}; } } while (0)
#define F_MMA8(XS, WS) do { _Pragma("unroll") for (int mt = 0; mt < 4; ++mt) _Pragma("unroll") for (int nt = 0; nt < NT; ++nt) \
            acc[mt][nt] = __builtin_amdgcn_mfma_scale_f32_32x32x64_f8f6f4(WS[nt], XS[mt], acc[mt][nt], 0, 0, 0, 0, 0, 0); } while (0)
            i32x8 xa8[4], wa8[NT], xb8[4], wb8[NT];
            F_LOAD8(0, xa8, wa8);
            __builtin_amdgcn_sched_barrier(0);
            F_LOAD8(1, xb8, wb8);
            __builtin_amdgcn_sched_barrier(0);
            F_MMA8(xa8, wa8);
            __builtin_amdgcn_sched_barrier(0);
            F_MMA8(xb8, wb8);
#undef F_LOAD8
#undef F_MMA8
        } else {
        F_LOAD(0, 0);
        __builtin_amdgcn_sched_barrier(0);
        F_LOAD(1, 1);
        __builtin_amdgcn_sched_barrier(0);
        F_MMA(0);
        __builtin_amdgcn_sched_barrier(0);
        F_LOAD(2, 0);
        __builtin_amdgcn_sched_barrier(0);
        F_MMA(1);
        __builtin_amdgcn_sched_barrier(0);
        F_LOAD(3, 1);
        __builtin_amdgcn_sched_barrier(0);
        F_MMA(0);
        __builtin_amdgcn_sched_barrier(0);
        F_MMA(1);
        }
#undef F_LOAD
#undef F_MMA
        __syncthreads();
    }
#undef G_DMA
}
template <int NT> DEVI void acc_zero(f32x16 (&acc)[4][NT]) {
#pragma unroll
    for (int mt = 0; mt < 4; ++mt)
#pragma unroll
        for (int nt = 0; nt < NT; ++nt)
#pragma unroll
            for (int i = 0; i < 16; ++i) acc[mt][nt][i] = 0.f;
}
template <int NT, class Epi, bool FP8 = false>
DEVI void gemm_phase(const bf16_t* A, int lda, const bf16_t* Bt, int ldb, int K, int tiles_m, int tiles_n, const Epi& epi, lchar* lds) {
    const int tid = otid(), lane = tid & 63, wid = tid >> 6, wm = wid >> 2, wn = wid & 3, r = lane & 31, h = lane >> 5;
    constexpr int BN = 128 * NT;
    for (int t = obid(); t < tiles_m * tiles_n; t += ogrid()) {
        const int tm = t % tiles_m, tn = t / tiles_m;
        f32x16 acc[4][NT];
        acc_zero<NT>(acc);
        gemm_kloop<NT, FP8>(acc, A + (size_t)tm * 256 * lda, lda, Bt + (size_t)tn * BN * ldb, ldb, K, lds);
        const int el = olane(), r = el & 31, h = el >> 5;
#pragma unroll
        for (int mt = 0; mt < 4; ++mt) {
            const int row = tm * 256 + wm * 128 + mt * 32 + r;
            if constexpr (Epi::HAS_PRE) {
                f32x4 pre[NT][4];
#pragma unroll
                for (int nt = 0; nt < NT; ++nt)
#pragma unroll
                    for (int rg = 0; rg < 4; ++rg) pre[nt][rg] = epi.pre(row, tn * BN + wn * 32 * NT + nt * 32 + 8 * rg + 4 * h);
                __builtin_amdgcn_sched_barrier(0);
                if constexpr (Epi::PAIR16) {
                    float rs = 0.f;
#pragma unroll
                    for (int nt = 0; nt < NT; ++nt)
#pragma unroll
                        for (int rp = 0; rp < 2; ++rp) {
                            const int cb = tn * BN + wn * 32 * NT + nt * 32;
                            const u32x2 pa = epi.pack(row, cb + 16 * rp + 4 * h, (f32x4){acc[mt][nt][8 * rp], acc[mt][nt][8 * rp + 1], acc[mt][nt][8 * rp + 2], acc[mt][nt][8 * rp + 3]}, pre[nt][2 * rp], rs);
                            const u32x2 pb = epi.pack(row, cb + 16 * rp + 8 + 4 * h, (f32x4){acc[mt][nt][8 * rp + 4], acc[mt][nt][8 * rp + 5], acc[mt][nt][8 * rp + 6], acc[mt][nt][8 * rp + 7]}, pre[nt][2 * rp + 1], rs);
                            const auto s0 = __builtin_amdgcn_permlane32_swap(pa.x, pb.x, false, false), s1 = __builtin_amdgcn_permlane32_swap(pa.y, pb.y, false, false);
                            epi.store16(row, cb + 16 * rp + 8 * h, (u32x4){s0[0], s1[0], s0[1], s1[1]});
                        }
                    if constexpr (Epi::HAS_ROWSUM) {
                        rs += __uint_as_float((unsigned)__builtin_amdgcn_ds_bpermute((el ^ 32) << 2, (int)__float_as_uint(rs)));
                        if (h == 0) epi.rowsum(row, tn * 4 + wn, rs);
                    }
                } else if constexpr (Epi::HAS_ROWSUM) {
                    float rs = 0.f;
#pragma unroll
                    for (int nt = 0; nt < NT; ++nt)
#pragma unroll
                        for (int rg = 0; rg < 4; ++rg)
                            rs += epi.post(row, tn * BN + wn * 32 * NT + nt * 32 + 8 * rg + 4 * h, (f32x4){acc[mt][nt][4 * rg], acc[mt][nt][4 * rg + 1], acc[mt][nt][4 * rg + 2], acc[mt][nt][4 * rg + 3]}, pre[nt][rg]);
                    rs += __uint_as_float((unsigned)__builtin_amdgcn_ds_bpermute((el ^ 32) << 2, (int)__float_as_uint(rs)));
                    if (h == 0) epi.rowsum(row, tn * 4 + wn, rs);
                } else {
#pragma unroll
                for (int nt = 0; nt < NT; ++nt)
#pragma unroll
                    for (int rg = 0; rg < 4; ++rg)
                        epi.post(row, tn * BN + wn * 32 * NT + nt * 32 + 8 * rg + 4 * h, (f32x4){acc[mt][nt][4 * rg], acc[mt][nt][4 * rg + 1], acc[mt][nt][4 * rg + 2], acc[mt][nt][4 * rg + 3]}, pre[nt][rg]);
                }
                __builtin_amdgcn_sched_barrier(0);
            } else {
#pragma unroll
                for (int nt = 0; nt < NT; ++nt)
#pragma unroll
                    for (int rg = 0; rg < 4; ++rg) {
                        const int col = tn * BN + wn * 32 * NT + nt * 32 + 8 * rg + 4 * h;
                        epi(row, col, (f32x4){acc[mt][nt][4 * rg], acc[mt][nt][4 * rg + 1], acc[mt][nt][4 * rg + 2], acc[mt][nt][4 * rg + 3]});
                    }
            }
        }
    }
}
struct EpiInproj {
    static constexpr bool HAS_PRE = false;
    bf16_t* G; bf16_t* P; const float* gbias;
    DEVI void operator()(int row, int col, f32x4 v) const {
        if (col < GW) {
            const f32x4 b = *(const f32x4*)(gbias + col);
            f32x4 s;
            s.x = __builtin_amdgcn_rcpf(1.f + fast_exp2(-LOG2E * (v.x + b.x))); s.y = __builtin_amdgcn_rcpf(1.f + fast_exp2(-LOG2E * (v.y + b.y)));
            s.z = __builtin_amdgcn_rcpf(1.f + fast_exp2(-LOG2E * (v.z + b.z))); s.w = __builtin_amdgcn_rcpf(1.f + fast_exp2(-LOG2E * (v.w + b.w)));
            u32x2 o; o.x = pk2(s.x, s.y); o.y = pk2(s.z, s.w);
            *(u32x2*)(G + (size_t)row * GW + col) = o;
        } else {
            u32x2 o; o.x = pk2(v.x, v.y); o.y = pk2(v.z, v.w);
            *(u32x2*)(P + (size_t)row * PW + (col - GW)) = o;
        }
    }
};
struct EpiInproj8 {
    bf16_t* G; bf16_t* P; const float* gbias;
    DEVI void store16(int row, int col, u32x4 w) const {
        if (col < GW) *(u32x4*)((unsigned char*)G + (size_t)row * GW + col) = w;
        else *(u32x4*)((unsigned char*)P + (size_t)row * PW + (col - GW)) = w;
    }
    DEVI u32x2 pack(int col, f32x4 v0, f32x4 v1) const {
        if (col < GW) {
            const f32x4 b0 = *(const f32x4*)(gbias + col), b1 = *(const f32x4*)(gbias + col + 4);
            f32x4 s0, s1;
#define SIGM(V, B) __builtin_amdgcn_rcpf(1.f + fast_exp2((-LOG2E / WIN_SCALE) * (V) - LOG2E * (B)))
            s0.x = SIGM(v0.x, b0.x); s0.y = SIGM(v0.y, b0.y); s0.z = SIGM(v0.z, b0.z); s0.w = SIGM(v0.w, b0.w);
            s1.x = SIGM(v1.x, b1.x); s1.y = SIGM(v1.y, b1.y); s1.z = SIGM(v1.z, b1.z); s1.w = SIGM(v1.w, b1.w);
#undef SIGM
            int w0 = __builtin_amdgcn_cvt_pk_fp8_f32(s0.x, s0.y, 0, false); w0 = __builtin_amdgcn_cvt_pk_fp8_f32(s0.z, s0.w, w0, true);
            int w1 = __builtin_amdgcn_cvt_pk_fp8_f32(s1.x, s1.y, 0, false); w1 = __builtin_amdgcn_cvt_pk_fp8_f32(s1.z, s1.w, w1, true);
            return (u32x2){(unsigned)w0, (unsigned)w1};
        } else {
            constexpr float c = 1.f / WIN_SCALE;
            int w0 = __builtin_amdgcn_cvt_pk_fp8_f32(v0.x * c, v0.y * c, 0, false); w0 = __builtin_amdgcn_cvt_pk_fp8_f32(v0.z * c, v0.w * c, w0, true);
            int w1 = __builtin_amdgcn_cvt_pk_fp8_f32(v1.x * c, v1.y * c, 0, false); w1 = __builtin_amdgcn_cvt_pk_fp8_f32(v1.z * c, v1.w * c, w1, true);
            return (u32x2){(unsigned)w0, (unsigned)w1};
        }
    }
};
struct EpiBf16 {
    static constexpr bool HAS_PRE = false;
    bf16_t* C; int ldc;
    DEVI u32x2 pack(f32x4 v) const { return (u32x2){pk2(v.x, v.y), pk2(v.z, v.w)}; }
    DEVI void store16(int row, int col, u32x4 w) const { *(u32x4*)(C + (size_t)row * ldc + col) = w; }
    DEVI void operator()(int row, int col, f32x4 v) const {
        u32x2 o; o.x = pk2(v.x, v.y); o.y = pk2(v.z, v.w);
        *(u32x2*)(C + (size_t)row * ldc + col) = o;
    }
};
struct EpiBf16S {
    static constexpr bool HAS_PRE = true;
    static constexpr bool HAS_ROWSUM = false;
    static constexpr bool PAIR16 = true;
    DEVI u32x2 pack(int row, int col, f32x4 v, f32x4 b, float&) const { if (col == 0) rs[row] = b.x; return (u32x2){pk2(v.x * b.x, v.y * b.x), pk2(v.z * b.x, v.w * b.x)}; }
    DEVI void store16(int row, int col, u32x4 w) const { *(u32x4*)(C + (size_t)row * ldc + col) = w; }
    bf16_t* C; int ldc; const float* part; float* rs;
    DEVI f32x4 pre(int row, int col) const { const f32x4* q = (const f32x4*)(part + (size_t)row * 16); const f32x4 a = q[0] + q[1] + q[2] + q[3];
        return (f32x4){rsqrtf(((a.x + a.y) + (a.z + a.w)) * (1.f / DM) + EPS), 0.f, 0.f, 0.f}; }
    DEVI void post(int row, int col, f32x4 v, f32x4 b) const { if (col == 0) rs[row] = b.x; u32x2 o; o.x = pk2(v.x * b.x, v.y * b.x); o.y = pk2(v.z * b.x, v.w * b.x); *(u32x2*)(C + (size_t)row * ldc + col) = o; }
    DEVI void operator()(int row, int col, f32x4 v) const { post(row, col, v, pre(row, col)); }
};
struct EpiResidual {
    static constexpr bool PAIR16 = false;
    static constexpr bool HAS_ROWSUM = false;
    static constexpr bool HAS_PRE = true;
    const float* hin; float* hout; float scale;
    DEVI f32x4 pre(int row, int col) const { return *(const f32x4*)(hin + (size_t)row * DM + col); }
    DEVI void post(int row, int col, f32x4 v, f32x4 b) const { *(f32x4*)(hout + (size_t)row * DM + col) = b + v * scale; }
    DEVI void operator()(int row, int col, f32x4 v) const {
        const f32x4 b = *(const f32x4*)(hin + (size_t)row * DM + col);
        *(f32x4*)(hout + (size_t)row * DM + col) = b + v * scale;
    }
};
struct EpiResidualB {
    static constexpr bool HAS_PRE = true;
    static constexpr bool HAS_ROWSUM = true;
    static constexpr bool PAIR16 = true;
    DEVI u32x2 pack(int row, int col, f32x4 v, f32x4 b, float& rs) const { const f32x4 s = b + v * scale; const u32x2 o = {pk2(s.x, s.y), pk2(s.z, s.w)};
        const float a0 = bflo(o.x), a1 = bfhi(o.x), a2 = bflo(o.y), a3 = bfhi(o.y); rs += (a0 * a0 + a1 * a1) + (a2 * a2 + a3 * a3); return o; }
    DEVI void store16(int row, int col, u32x4 w) const { *(u32x4*)(hb + (size_t)row * DM + col) = w; }
    const float* hin; bf16_t* hb; float scale; float* part;
    DEVI void rowsum(int row, int strip, float v) const { part[(size_t)row * 16 + strip] = v; }
    DEVI f32x4 pre(int row, int col) const { return *(const f32x4*)(hin + (size_t)row * DM + col); }
    DEVI float post(int row, int col, f32x4 v, f32x4 b) const { const f32x4 s = b + v * scale; const u32x2 o = {pk2(s.x, s.y), pk2(s.z, s.w)}; *(u32x2*)(hb + (size_t)row * DM + col) = o;
        const float a0 = bflo(o.x), a1 = bfhi(o.x), a2 = bflo(o.y), a3 = bfhi(o.y); return (a0 * a0 + a1 * a1) + (a2 * a2 + a3 * a3); }
    DEVI void operator()(int row, int col, f32x4 v) const { post(row, col, v, pre(row, col)); }
};
struct EpiResidualBB {
    static constexpr bool HAS_PRE = true;
    static constexpr bool HAS_ROWSUM = true;
    static constexpr bool PAIR16 = true;
    DEVI u32x2 pack(int row, int col, f32x4 v, f32x4 b, float& rs) const { const f32x4 s = b + v * scale; const u32x2 o = {pk2(s.x, s.y), pk2(s.z, s.w)};
        const float a0 = bflo(o.x), a1 = bfhi(o.x), a2 = bflo(o.y), a3 = bfhi(o.y); rs += (a0 * a0 + a1 * a1) + (a2 * a2 + a3 * a3); return o; }
    DEVI void store16(int row, int col, u32x4 w) const { *(u32x4*)(hb + (size_t)row * DM + col) = w; }
    const bf16_t* hin; bf16_t* hb; float scale; float* part;
    DEVI void rowsum(int row, int strip, float v) const { part[(size_t)row * 16 + strip] = v; }
    DEVI f32x4 pre(int row, int col) const { const u32x2 w = *(const u32x2*)(hin + (size_t)row * DM + col); return (f32x4){bflo(w.x), bfhi(w.x), bflo(w.y), bfhi(w.y)}; }
    DEVI float post(int row, int col, f32x4 v, f32x4 b) const { const f32x4 s = b + v * scale; const u32x2 o = {pk2(s.x, s.y), pk2(s.z, s.w)}; *(u32x2*)(hb + (size_t)row * DM + col) = o;
        const float a0 = bflo(o.x), a1 = bfhi(o.x), a2 = bflo(o.y), a3 = bfhi(o.y); return (a0 * a0 + a1 * a1) + (a2 * a2 + a3 * a3); }
    DEVI void operator()(int row, int col, f32x4 v) const { post(row, col, v, pre(row, col)); }
};
struct EpiF32 {
    static constexpr bool HAS_PRE = false;
    float* C; int ldc;
    DEVI void operator()(int row, int col, f32x4 v) const { *(f32x4*)(C + (size_t)row * ldc + col) = v; }
};

template <class Epi>
DEVI void gemm_stream(const bf16_t* A, int lda, const bf16_t* Bt, int ldb, int K, int tiles_m, int tiles_n, const Epi& epi, lchar* lds) {
    const int tid = otid(), lane = tid & 63, wid = tid >> 6, wm = wid >> 2, wn = wid & 3, r = lane & 31, h = lane >> 5;
    constexpr int ASZ = 256 * 128, STG = ASZ + 128 * 128;
    static_assert(3 * STG <= LDS_BYTES - 96, "stream ring");
    const int rr = lane >> 3, pp = lane & 7;
    const int skey = ((wid & 1) << 2) | (rr >> 1);
    const int lrow = wid * 8 + rr, lcol = (pp ^ skey) << 3;
    const int bid = obid(), gsz = ogrid(), ntot = tiles_m * tiles_n;
    const int ntile = bid < ntot ? (ntot - bid + gsz - 1) / gsz : 0, nk = K / 64, nit = ntile * nk;
    if (nit == 0) return;
    const int xa = (wm * 128 + r) * 128, xb = (wn * 32 + r) * 128, sw = (r >> 1) & 7;
    int dti = 0, dkt = 0;
#define S_DMA(st_) do { const int t_ = bid + dti * gsz; \
        const bf16_t* ap_ = A + ((size_t)(t_ % tiles_m) * 256 + lrow) * lda + dkt * 64 + lcol; \
        const bf16_t* bp_ = Bt + ((size_t)(t_ / tiles_m) * 128 + lrow) * ldb + dkt * 64 + lcol; \
        lchar* as_ = lds + (st_) * STG + wid * 1024; \
        _Pragma("unroll") for (int i = 0; i < 4; ++i) __builtin_amdgcn_global_load_lds((const unsigned*)(ap_ + (size_t)(64 * i) * lda), (LAS unsigned*)(as_ + i * 8192), 16, 0, 0); \
        _Pragma("unroll") for (int i = 0; i < 2; ++i) __builtin_amdgcn_global_load_lds((const unsigned*)(bp_ + (size_t)(64 * i) * ldb), (LAS unsigned*)(as_ + ASZ + i * 8192), 16, 0, 0); \
        if (dkt + 1 < nk) ++dkt; else if (dti + 1 < ntile) { dkt = 0; ++dti; } } while (0)
    __syncthreads();
    S_DMA(0); S_DMA(1);
    asm volatile("s_waitcnt vmcnt(6)" ::: "memory");
    __builtin_amdgcn_s_barrier();
    SBAR();
    int st = 0, kt = 0, ti = 0;
    f32x16 acc[4];
#pragma unroll
    for (int mt = 0; mt < 4; ++mt)
#pragma unroll
        for (int i = 0; i < 16; ++i) acc[mt][i] = 0.f;
#pragma unroll 1
    for (int q = 0; q < nit; ++q) {
        const int sn = (st == 0) ? 2 : st - 1;
        S_DMA(sn);
        SBAR();
        const lchar* As = lds + st * STG; const lchar* Bs = As + ASZ;
        bf16x8 xf[2][4], wf[2];
#define F_LOAD(ks, S_) do { const int co_ = ((2 * (ks) + h) ^ sw) << 4; \
        _Pragma("unroll") for (int mt = 0; mt < 4; ++mt) xf[S_][mt] = *(const LAS bf16x8*)(As + xa + mt * 32 * 128 + co_); \
        wf[S_] = *(const LAS bf16x8*)(Bs + xb + co_); } while (0)
#define F_MMA(S_) do { _Pragma("unroll") for (int mt = 0; mt < 4; ++mt) acc[mt] = __builtin_amdgcn_mfma_f32_32x32x16_bf16(wf[S_], xf[S_][mt], acc[mt], 0, 0, 0); } while (0)
        F_LOAD(0, 0); SBAR();
        F_LOAD(1, 1); SBAR();
        F_MMA(0); SBAR();
        F_LOAD(2, 0); SBAR();
        F_MMA(1); SBAR();
        F_LOAD(3, 1); SBAR();
        F_MMA(0); SBAR();
        F_MMA(1); SBAR();
#undef F_LOAD
#undef F_MMA
        asm volatile("s_waitcnt vmcnt(6)" ::: "memory");
        __builtin_amdgcn_s_barrier();
        SBAR();
        st = (st == 2) ? 0 : st + 1;
        if (kt + 1 < nk) { ++kt; continue; }
        {
            const int t = bid + ti * gsz, tm = t % tiles_m, tn = t / tiles_m;
#pragma unroll
            for (int mt = 0; mt < 4; ++mt)
#pragma unroll
                for (int rp = 0; rp < 2; ++rp) {
                    const int row = tm * 256 + wm * 128 + mt * 32 + r;
                    const u32x2 pa = epi.pack((f32x4){acc[mt][8 * rp], acc[mt][8 * rp + 1], acc[mt][8 * rp + 2], acc[mt][8 * rp + 3]}), pb = epi.pack((f32x4){acc[mt][8 * rp + 4], acc[mt][8 * rp + 5], acc[mt][8 * rp + 6], acc[mt][8 * rp + 7]});
                    const auto s0 = __builtin_amdgcn_permlane32_swap(pa.x, pb.x, false, false), s1 = __builtin_amdgcn_permlane32_swap(pa.y, pb.y, false, false);
                    epi.store16(row, tn * 128 + wn * 32 + 16 * rp + 8 * h, (u32x4){s0[0], s1[0], s0[1], s1[1]});
                }
#pragma unroll
            for (int mt = 0; mt < 4; ++mt)
#pragma unroll
                for (int i = 0; i < 16; ++i) acc[mt][i] = 0.f;
            kt = 0; ++ti;
        }
    }
#undef S_DMA
    asm volatile("s_waitcnt vmcnt(0)" ::: "memory");
}

DEVI void phase_merge(const bf16_t* Y, const bf16_t* Wbr, const bf16_t* G, bf16_t* merged, lchar* lds) {
    const int tid = otid(), lane = tid & 63, wid = tid >> 6, wm = wid >> 2, wn = wid & 3, r = lane & 31, h = lane >> 5;
    constexpr int ASZ = 256 * 128, STG = ASZ + 128 * 128;
    static_assert(3 * STG <= LDS_BYTES - 96, "merge ring");
    const int rr = lane >> 3, pp = lane & 7;
    const int skey = ((wid & 1) << 2) | (rr >> 1);
    const int lrow = wid * 8 + rr, lcol = (pp ^ skey) << 4;
    const int bid = obid(), gsz = ogrid();
    const int ntile = (512 - bid + gsz - 1) / gsz, nit = ntile * 8;
    const int xa = (wm * 128 + r) * 128, xb = (wn * 32 + r) * 128, sw = (r >> 1) & 7;
    const unsigned char* Y8 = (const unsigned char*)Y; const unsigned char* W8 = (const unsigned char*)Wbr;
#define M_DMA(q_, st_) do { const int qq_ = (q_) < nit ? (q_) : nit - 1; const int t_ = bid + (qq_ >> 3) * gsz, kt_ = qq_ & 7; \
        const unsigned char* ap_ = Y8 + ((size_t)(t_ & 63) * 256 + lrow) * DM + kt_ * 128 + lcol; \
        const unsigned char* bp_ = W8 + ((size_t)(kt_ >> 1) * 1024 + (t_ >> 6) * 128 + lrow) * 256 + (kt_ & 1) * 128 + lcol; \
        lchar* as_ = lds + (st_) * STG + wid * 1024; \
        _Pragma("unroll") for (int i = 0; i < 4; ++i) __builtin_amdgcn_global_load_lds((const unsigned*)(ap_ + (size_t)(64 * i) * DM), (LAS unsigned*)(as_ + i * 8192), 16, 0, 0); \
        _Pragma("unroll") for (int i = 0; i < 2; ++i) __builtin_amdgcn_global_load_lds((const unsigned*)(bp_ + (size_t)(64 * i) * 256), (LAS unsigned*)(as_ + ASZ + i * 8192), 16, 0, 0); } while (0)
    __syncthreads();
    M_DMA(0, 0); M_DMA(1, 1);
    asm volatile("s_waitcnt vmcnt(6)" ::: "memory");
    __builtin_amdgcn_s_barrier();
    SBAR();
    int st = 0;
    f32x16 macc[4], acc[4];
#pragma unroll 1
    for (int qb = 0; qb < nit; qb += 2) {
        const int t = bid + (qb >> 3) * gsz, tm = t & 63, tn = t >> 6, br = (qb >> 1) & 3;
        if (br == 0) {
#pragma unroll
            for (int mt = 0; mt < 4; ++mt)
#pragma unroll
                for (int i = 0; i < 16; ++i) macc[mt][i] = 0.f;
        }
#pragma unroll
        for (int mt = 0; mt < 4; ++mt)
#pragma unroll
            for (int i = 0; i < 16; ++i) acc[mt][i] = 0.f;
        unsigned gq[4][4]; u32x4 gw4[4];
#pragma unroll
        for (int kq = 0; kq < 2; ++kq) {
            const int sn = (st == 0) ? 2 : st - 1;
            M_DMA(qb + kq + 2, sn);
            SBAR();
            if (kq == 0) {
                const unsigned char* gp = (const unsigned char*)G + ((size_t)tm * 256 + wm * 128 + r) * GW + br * 1024 + tn * 128 + wn * 32 + 16 * h;
#pragma unroll
                for (int mt = 0; mt < 4; ++mt) gw4[mt] = *(const u32x4*)(gp + (size_t)mt * 32 * GW);
                SBAR();
            }
            const lchar* As = lds + st * STG; const lchar* Bs = As + ASZ;
            i32x8 xf8[2][4], wf8[2];
#define F_LOAD8(j) do { const int c0_ = ((4 * (j) + h) ^ sw) << 4, c1_ = ((4 * (j) + 2 + h) ^ sw) << 4; \
            _Pragma("unroll") for (int mt = 0; mt < 4; ++mt) { const u32x4 l0_ = *(const LAS u32x4*)(As + xa + mt * 32 * 128 + c0_), l1_ = *(const LAS u32x4*)(As + xa + mt * 32 * 128 + c1_); \
                xf8[j][mt] = (i32x8){(int)l0_.x, (int)l0_.y, (int)l0_.z, (int)l0_.w, (int)l1_.x, (int)l1_.y, (int)l1_.z, (int)l1_.w}; } \
            { const u32x4 l0_ = *(const LAS u32x4*)(Bs + xb + c0_), l1_ = *(const LAS u32x4*)(Bs + xb + c1_); \
                wf8[j] = (i32x8){(int)l0_.x, (int)l0_.y, (int)l0_.z, (int)l0_.w, (int)l1_.x, (int)l1_.y, (int)l1_.z, (int)l1_.w}; } } while (0)
#define F_MMA8(j) do { _Pragma("unroll") for (int mt = 0; mt < 4; ++mt) acc[mt] = __builtin_amdgcn_mfma_scale_f32_32x32x64_f8f6f4(wf8[j], xf8[j][mt], acc[mt], 0, 0, 0, 0, 0, 0); } while (0)
            F_LOAD8(0); SBAR();
            F_LOAD8(1); SBAR();
            F_MMA8(0); SBAR();
            F_MMA8(1); SBAR();
#undef F_LOAD8
#undef F_MMA8
            if (kq == 1) {
#pragma unroll
                for (int mt = 0; mt < 4; ++mt) {
                    const auto s0 = __builtin_amdgcn_permlane32_swap(gw4[mt].x, gw4[mt].y, false, false), s1 = __builtin_amdgcn_permlane32_swap(gw4[mt].z, gw4[mt].w, false, false);
                    gq[mt][0] = s0[0]; gq[mt][2] = s0[1]; gq[mt][1] = s1[0]; gq[mt][3] = s1[1];
                }
#pragma unroll
                for (int mt = 0; mt < 4; ++mt)
#pragma unroll
                    for (int rg = 0; rg < 4; ++rg) {
                        const f32x2 g01 = __builtin_amdgcn_cvt_pk_f32_fp8((int)gq[mt][rg], false), g23 = __builtin_amdgcn_cvt_pk_f32_fp8((int)gq[mt][rg], true);
                        macc[mt][4 * rg + 0] += g01.x * acc[mt][4 * rg + 0];
                        macc[mt][4 * rg + 1] += g01.y * acc[mt][4 * rg + 1];
                        macc[mt][4 * rg + 2] += g23.x * acc[mt][4 * rg + 2];
                        macc[mt][4 * rg + 3] += g23.y * acc[mt][4 * rg + 3];
                    }
            }
            if (kq == 0) asm volatile("s_waitcnt vmcnt(10)" ::: "memory"); else asm volatile("s_waitcnt vmcnt(6)" ::: "memory");
            __builtin_amdgcn_s_barrier();
            SBAR();
            st = (st == 2) ? 0 : st + 1;
        }
        if (br == 3) {
            constexpr float c = 1.f / WIN_SCALE;
#pragma unroll
            for (int mt = 0; mt < 4; ++mt) {
                unsigned w8[4];
#pragma unroll
                for (int rg = 0; rg < 4; ++rg) {
                    int w = __builtin_amdgcn_cvt_pk_fp8_f32(macc[mt][4 * rg] * c, macc[mt][4 * rg + 1] * c, 0, false); w = __builtin_amdgcn_cvt_pk_fp8_f32(macc[mt][4 * rg + 2] * c, macc[mt][4 * rg + 3] * c, w, true);
                    w8[rg] = (unsigned)w;
                }
                const auto s0 = __builtin_amdgcn_permlane32_swap(w8[0], w8[2], false, false), s1 = __builtin_amdgcn_permlane32_swap(w8[1], w8[3], false, false);
                const int row = tm * 256 + wm * 128 + mt * 32 + r;
                *(u32x4*)((unsigned char*)merged + (size_t)row * DM + tn * 128 + wn * 32 + 16 * h) = (u32x4){s0[0], s0[1], s1[0], s1[1]};
            }
        }
    }
#undef M_DMA
    asm volatile("s_waitcnt vmcnt(0)" ::: "memory");
}

namespace pg8 {
#define PG8_LAS __attribute__((address_space(3)))
typedef unsigned short bf16_t;
typedef short bf16x8 __attribute__((ext_vector_type(8)));
typedef float f32x4 __attribute__((ext_vector_type(4)));
typedef unsigned u32x4 __attribute__((ext_vector_type(4)));
typedef int i32x8_t __attribute__((ext_vector_type(8)));
constexpr int BM = 256, BK = 64, HALF = 128, HTB = HALF * BK * 2  , STAGE_BYTES = 8 * HTB, NXCD = 8, WGM = 8;

__host__ __device__ __forceinline__ int lds_byte(int r, int c) { const int st = (r >> 4) * 2 + (c >> 5), rr = r & 15, cc = c & 31, ob = rr * 64 + cc * 2; return st * 1024 + (ob ^ (((ob >> 9) & 1) << 5)); }
__host__ __device__ __forceinline__ void stage_rc(int b, int& R, int& C) { const int st = b / 1024, sb = b % 1024, swz = sb ^ (((sb >> 9) & 1) << 5); R = (st >> 1) * 16 + swz / 64; C = (st & 1) * 32 + (swz % 64) / 2; }
__host__ __device__ __forceinline__ int perm32(int rho) { const int n = rho >> 4, i = rho & 15; return 8 * (i >> 2) + 4 * n + (i & 3); }

struct Unit { int pm, pn; };
struct Gemm { const bf16_t* A; const bf16_t* Bt; int M, N, K; };

struct StaticOrder {
    int nM, nN, nwg, G, c;
    __host__ __device__ void init(int M, int N, int G_, int c_) { nM = M / BM; nN = N / BM; nwg = nM * nN; G = G_; c = c_; }
    __host__ __device__ bool next(int i, Unit& u) const {
        const long L = (long)i * G + c; if (L >= nwg) return false;
        int wgid = (int)L; { const int q = nwg / NXCD, r = nwg % NXCD, xcd = wgid % NXCD, off = wgid / NXCD; wgid = (xcd < r ? xcd * (q + 1) : r * (q + 1) + (xcd - r) * q) + off; }
        const int nig = WGM * nN, gid = wgid / nig, fm = gid * WGM, gsz = (nM - fm) < WGM ? (nM - fm) : WGM;
        u.pm = fm + ((wgid % nig) % gsz); u.pn = (wgid % nig) / gsz; return true;
    }
    __device__ __forceinline__ void a_ready(const Unit&) const {}
    __device__ __forceinline__ void done(const Unit&) const {}
};

template <class Epi, class Sched, bool ALIGN_EPI = false, bool SP2 = false, bool FP8 = false>
__device__ __forceinline__ void gemm_phase(PG8_LAS unsigned char* lds, const Gemm g, const Sched& S, const Epi& E) {
    const int tid = otid(), wid = __builtin_amdgcn_readfirstlane(tid >> 6), lane = tid & 63, wr = wid >> 2, wc = wid & 3, fr = lane & 15, fq = lane >> 4;
    const int K = g.K, nt = K / BK;
    unsigned voffA[2], voffB[2];
#pragma unroll
    for (int i = 0; i < 2; ++i) { int R, C; stage_rc(tid * 16 + i * 8192, R, C); const int Rb = Epi::PERM ? ((R & ~31) + perm32(R & 31)) : R;
        voffA[i] = (unsigned)(R * K + C) * 2u; voffB[i] = (unsigned)(Rb * K + C) * 2u; }
    const size_t kstep = (size_t)(BK * 2);
    const size_t hstep = (size_t)HALF * K * 2;
    const size_t tstep = 2 * hstep;
    const unsigned ldsw = (unsigned)wid * 1024u;
#define PG8_SA(b, h) (((b) * 2 + (h)) * HTB)
#define PG8_SB(b, h) ((4 + (b) * 2 + (h)) * HTB)
#define PG8_STAGE(bufoff, gbase, voff) do { unsigned vo_ = (voff)[0]; if constexpr (FP8) asm volatile("" : "+v"(vo_));     \
        _Pragma("unroll") for (int _i = 0; _i < 2; ++_i) \
        __builtin_amdgcn_global_load_lds((const unsigned*)((const char*)(gbase) + (size_t)_i * (size_t)(128 * K) + vo_), (PG8_LAS unsigned*)(lds + (bufoff) + ldsw + _i * 8192), 16, 0, 0); } while (0)
#define PG8_RD8(p_) ({ const u32x4 l0_ = *(const PG8_LAS u32x4*)(p_), l1_ = *(const PG8_LAS u32x4*)((p_) + 1024); \
        (i32x8_t){(int)l0_[0], (int)l0_[1], (int)l0_[2], (int)l0_[3], (int)l1_[0], (int)l1_[1], (int)l1_[2], (int)l1_[3]}; })
#define PG8_LDA(dst, b, h) do { if constexpr (FP8) { _Pragma("unroll") for (int m = 0; m < 4; ++m) dst##8[m] = PG8_RD8(lds + PG8_SA(b, h) + aoff + m * 2048); } \
        else { _Pragma("unroll") for (int m = 0; m < 4; ++m) _Pragma("unroll") for (int k = 0; k < 2; ++k) dst[m][k] = *(const PG8_LAS bf16x8*)(lds + PG8_SA(b, h) + aoff + m * 2048 + k * 1024); } } while (0)
#define PG8_LDB(dst, b, h) do { if constexpr (FP8) { _Pragma("unroll") for (int n = 0; n < 2; ++n) dst##8[n] = PG8_RD8(lds + PG8_SB(b, h) + boff + n * 2048); } \
        else { _Pragma("unroll") for (int n = 0; n < 2; ++n) _Pragma("unroll") for (int k = 0; k < 2; ++k) dst[n][k] = *(const PG8_LAS bf16x8*)(lds + PG8_SB(b, h) + boff + n * 2048 + k * 1024); } } while (0)
#define PG8_CAT(x0, x1) __builtin_bit_cast(i32x8_t, __builtin_shufflevector(x0, x1, 0, 1, 2, 3, 4, 5, 6, 7, 8, 9, 10, 11, 12, 13, 14, 15))
#define PG8_MMA(ai, bj, At, Bt) do { __builtin_amdgcn_s_setprio(1); _Pragma("unroll") for (int m = 0; m < 4; ++m) _Pragma("unroll") for (int n = 0; n < 2; ++n) { \
        if constexpr (FP8) acc[ai][bj][m][n] = __builtin_amdgcn_mfma_scale_f32_16x16x128_f8f6f4(Bt##8[n], At##8[m], acc[ai][bj][m][n], 0, 0, 0, 0, 0, 0); \
        else { _Pragma("unroll") for (int k = 0; k < 2; ++k) acc[ai][bj][m][n] = __builtin_amdgcn_mfma_f32_16x16x32_bf16(Bt[n][k], At[m][k], acc[ai][bj][m][n], 0, 0, 0); } } \
        __builtin_amdgcn_s_setprio(0); } while (0)
#define PG8_WAIT_V(n) asm volatile("s_waitcnt vmcnt(" #n ")" ::: "memory")
#define PG8_WAIT_L(n) asm volatile("s_waitcnt lgkmcnt(" #n ")" ::: "memory")
#define PG8_BAR __builtin_amdgcn_s_barrier()
#define PG8_SCHED __builtin_amdgcn_sched_barrier(0)
    Unit cur, nxt; int ui = 0;
    if (!S.next(0, cur)) return;
    f32x4 acc[2][2][4][2];
#pragma unroll
    for (int a = 0; a < 2; ++a)
#pragma unroll
        for (int b = 0; b < 2; ++b)
#pragma unroll
            for (int m = 0; m < 4; ++m)
#pragma unroll
                for (int n = 0; n < 2; ++n) acc[a][b][m][n] = (f32x4){0.f, 0.f, 0.f, 0.f};
    bf16x8 At[4][2], B0[2][2], B1[2][2];
    i32x8_t At8[4], B08[2], B18[2];
    const char* cA = (const char*)g.A + (size_t)cur.pm * tstep; const char* cB = (const char*)g.Bt + (size_t)cur.pn * tstep;
    S.a_ready(cur);
    if constexpr (SP2) {
        PG8_STAGE(PG8_SB(0, 0), cB, voffB); PG8_STAGE(PG8_SB(0, 1), cB + hstep, voffB); PG8_STAGE(PG8_SA(0, 0), cA, voffA); PG8_STAGE(PG8_SA(0, 1), cA + hstep, voffA);
        if (wr == 1) PG8_BAR;
        PG8_WAIT_V(2); PG8_BAR;
        PG8_STAGE(PG8_SB(1, 0), cB + kstep, voffB); PG8_STAGE(PG8_SA(1, 0), cA + kstep, voffA); PG8_STAGE(PG8_SB(1, 1), cB + hstep + kstep, voffB);
        PG8_WAIT_V(6); PG8_BAR;
    } else {
        PG8_STAGE(PG8_SB(0, 0), cB, voffB); PG8_STAGE(PG8_SA(0, 0), cA, voffA); PG8_STAGE(PG8_SB(0, 1), cB + hstep, voffB); PG8_STAGE(PG8_SA(0, 1), cA + hstep, voffA);
        if (wr == 1) PG8_BAR;
        PG8_WAIT_V(4); PG8_BAR;
        PG8_STAGE(PG8_SB(1, 0), cB + kstep, voffB); PG8_STAGE(PG8_SA(1, 0), cA + kstep, voffA); PG8_STAGE(PG8_SB(1, 1), cB + hstep + kstep, voffB);
        PG8_WAIT_V(6); PG8_BAR;
    }
    int aoff, boff;
    { int fr2 = fr, fq2 = fq; asm volatile("" : "+v"(fr2), "+v"(fq2)); aoff = lds_byte(wr * 64 + fr2, fq2 * 8); boff = lds_byte(wc * 32 + fr2, fq2 * 8); }
    for (;;) {
        const bool has_next = S.next(ui + 1, nxt);
        const char* nA = has_next ? (const char*)g.A + (size_t)nxt.pm * tstep : cA; const char* nB = has_next ? (const char*)g.Bt + (size_t)nxt.pn * tstep : cB;
        for (int t = 0; t < nt; t += 2) {
            const bool last = (t == nt - 2);
            const char* a1 = cA + (size_t)(t + 1) * kstep;
            const char* a2 = last ? nA : cA + (size_t)(t + 2) * kstep; const char* b2 = last ? nB : cB + (size_t)(t + 2) * kstep;
            const char* a3 = a2 + kstep; const char* b3 = b2 + kstep;
            if (last && has_next) S.a_ready(nxt);
            if constexpr (SP2) {
            PG8_LDB(B0, 0, 0); PG8_LDB(B1, 0, 1); PG8_SCHED; PG8_LDA(At, 0, 0); PG8_STAGE(PG8_SA(1, 1), a1 + hstep, voffA);
            PG8_WAIT_V(8); PG8_WAIT_L(0); PG8_BAR; PG8_MMA(0, 0, At, B0); PG8_MMA(0, 1, At, B1); PG8_BAR; PG8_SCHED;
            PG8_LDA(At, 0, 1); PG8_STAGE(PG8_SB(0, 0), b2, voffB); PG8_STAGE(PG8_SB(0, 1), b2 + hstep, voffB); PG8_STAGE(PG8_SA(0, 0), a2, voffA);
            PG8_WAIT_V(8); PG8_WAIT_L(0); PG8_BAR; PG8_MMA(1, 0, At, B0); PG8_MMA(1, 1, At, B1); PG8_BAR; PG8_SCHED;
            PG8_LDB(B0, 1, 0); PG8_LDB(B1, 1, 1); PG8_SCHED; PG8_LDA(At, 1, 0); PG8_STAGE(PG8_SA(0, 1), a2 + hstep, voffA);
            PG8_WAIT_V(8); PG8_WAIT_L(0); PG8_BAR; PG8_MMA(0, 0, At, B0); PG8_MMA(0, 1, At, B1); PG8_BAR; PG8_SCHED;
            PG8_LDA(At, 1, 1); PG8_STAGE(PG8_SB(1, 0), b3, voffB); PG8_STAGE(PG8_SB(1, 1), b3 + hstep, voffB); PG8_STAGE(PG8_SA(1, 0), a3, voffA);
            PG8_WAIT_V(8); PG8_WAIT_L(0); PG8_BAR; PG8_MMA(1, 0, At, B0); PG8_MMA(1, 1, At, B1); PG8_BAR; PG8_SCHED;
            } else {
            PG8_LDB(B0, 0, 0); PG8_SCHED; PG8_LDA(At, 0, 0); PG8_STAGE(PG8_SA(1, 1), a1 + hstep, voffA);
            PG8_WAIT_L(8); PG8_BAR; PG8_WAIT_L(0); PG8_MMA(0, 0, At, B0); PG8_BAR; PG8_SCHED;
            PG8_LDB(B1, 0, 1); PG8_STAGE(PG8_SB(0, 0), b2, voffB);
            PG8_BAR; PG8_WAIT_L(0); PG8_MMA(0, 1, At, B1); PG8_BAR;
            PG8_LDA(At, 0, 1); PG8_STAGE(PG8_SA(0, 0), a2, voffA);
            PG8_BAR; PG8_WAIT_L(0); PG8_MMA(1, 0, At, B0); PG8_BAR; PG8_SCHED;
            PG8_STAGE(PG8_SB(0, 1), b2 + hstep, voffB);
            PG8_WAIT_V(6); PG8_BAR; PG8_MMA(1, 1, At, B1); PG8_BAR;
            PG8_LDB(B0, 1, 0); PG8_SCHED; PG8_LDA(At, 1, 0); PG8_STAGE(PG8_SA(0, 1), a2 + hstep, voffA);
            PG8_WAIT_L(8); PG8_BAR; PG8_WAIT_L(0); PG8_MMA(0, 0, At, B0); PG8_BAR; PG8_SCHED;
            PG8_LDB(B1, 1, 1); PG8_STAGE(PG8_SB(1, 0), b3, voffB);
            PG8_BAR; PG8_WAIT_L(0); PG8_MMA(0, 1, At, B1); PG8_BAR;
            PG8_LDA(At, 1, 1); PG8_STAGE(PG8_SA(1, 0), a3, voffA);
            PG8_BAR; PG8_WAIT_L(0); PG8_MMA(1, 0, At, B0); PG8_BAR; PG8_SCHED;
            PG8_STAGE(PG8_SB(1, 1), b3 + hstep, voffB);
            PG8_WAIT_V(6); PG8_BAR; PG8_MMA(1, 1, At, B1); PG8_BAR;
            }
        }
        if constexpr (ALIGN_EPI) { if (wr == 0) PG8_BAR; }
        if constexpr (!Epi::AFTER_DRAIN) { E(acc, cur, wr, wc, fr, fq); S.done(cur); }
        if (!has_next) break;
#pragma unroll
        for (int a = 0; a < 2; ++a)
#pragma unroll
            for (int b = 0; b < 2; ++b)
#pragma unroll
                for (int m = 0; m < 4; ++m)
#pragma unroll
                    for (int n = 0; n < 2; ++n) acc[a][b][m][n] = (f32x4){0.f, 0.f, 0.f, 0.f};
        cur = nxt; cA = nA; cB = nB; ++ui;
        if constexpr (ALIGN_EPI) { if (wr == 1) PG8_BAR; }
    }
    PG8_WAIT_V(0);
    if constexpr (!ALIGN_EPI) { if (wr == 0) PG8_BAR; }
    PG8_BAR;
    if constexpr (Epi::AFTER_DRAIN) { E.fused(acc, cur, wr, wc, fr, fq, lds, wid, lane); S.done(cur); }
#undef PG8_SA
#undef PG8_SB
#undef PG8_STAGE
#undef PG8_LDA
#undef PG8_LDB
#undef PG8_MMA
#undef PG8_WAIT_V
#undef PG8_WAIT_L
#undef PG8_BAR
#undef PG8_SCHED
}
}

template <class F> struct Pg8Epi8 {
    static constexpr bool PERM = true, AFTER_DRAIN = false;
    F f;
    __device__ __forceinline__ void operator()(const pg8::f32x4 (&acc)[2][2][4][2], const pg8::Unit& u, int wr, int wc, int fr_, int fq_) const {
        const int ln_ = olane(); const int fr = ln_ & 15, fq = ln_ >> 4;
#pragma unroll
        for (int ai = 0; ai < 2; ++ai)
#pragma unroll
            for (int m = 0; m < 4; ++m) {
                const int row = u.pm * 256 + ai * 128 + wr * 64 + m * 16 + fr;
                const int cb = u.pn * 256 + wc * 32;
                const pg8::f32x4 a0 = acc[ai][0][m][0], b0 = acc[ai][0][m][1], a1 = acc[ai][1][m][0], b1 = acc[ai][1][m][1];
                const u32x2 pa = f.pack(cb + 8 * fq, (f32x4){a0[0], a0[1], a0[2], a0[3]}, (f32x4){b0[0], b0[1], b0[2], b0[3]});
                const u32x2 pb = f.pack(cb + 128 + 8 * fq, (f32x4){a1[0], a1[1], a1[2], a1[3]}, (f32x4){b1[0], b1[1], b1[2], b1[3]});
                const auto s0 = __builtin_amdgcn_permlane16_swap(pa.x, pb.x, false, false), s1 = __builtin_amdgcn_permlane16_swap(pa.y, pb.y, false, false);
                f.store16(row, cb + (fq & 1) * 128 + 16 * (fq >> 1), (u32x4){s0[0], s1[0], s0[1], s1[1]});
            }
    }
};
template <class F> struct Pg8Epi {
    static constexpr bool PERM = false, AFTER_DRAIN = false;
    F f;
    __device__ __forceinline__ void operator()(const pg8::f32x4 (&acc)[2][2][4][2], const pg8::Unit& u, int wr, int wc, int fr, int fq) const {
#pragma unroll
        for (int ai = 0; ai < 2; ++ai)
#pragma unroll
            for (int m = 0; m < 4; ++m)
#pragma unroll
                for (int bj = 0; bj < 2; ++bj)
#pragma unroll
                    for (int n = 0; n < 2; ++n) {
                        const int row = u.pm * 256 + ai * 128 + wr * 64 + m * 16 + fr;
                        const int col = u.pn * 256 + bj * 128 + wc * 32 + n * 16 + 4 * fq;
                        const pg8::f32x4 v = acc[ai][bj][m][n];
                        f(row, col, (f32x4){v[0], v[1], v[2], v[3]});
                    }
    }
};

template <bool PERM = false, bool SRC8 = false>
DEVI void vtrans_unit(const bf16_t* src, int pitch, int off, int t0, int dil, bf16_t* VT, LAS bf16_t* T, int lane) {
    constexpr int TS = 68;
    const int cw = 64 / dil;
    u32x4 vin[8];
#pragma unroll
    for (int i = 0; i < 8; ++i) {
        const int tl = i * 8 + (lane >> 3), ch = lane & 7;
        if constexpr (SRC8) { const u32x2 v8 = *(const u32x2*)((const unsigned char*)src + (size_t)(t0 + tl) * pitch + off + ch * 8); vin[i] = (u32x4){v8.x, v8.y, 0u, 0u}; }
        else vin[i] = *(const u32x4*)(src + (size_t)(t0 + tl) * pitch + off + ch * 8);
    }
    __builtin_amdgcn_sched_barrier(0);
#pragma unroll
    for (int i = 0; i < 8; ++i) {
        const int tl = i * 8 + (lane >> 3), ch = lane & 7;
        u32x4 v;
        if constexpr (SRC8) {
            const f32x2 a0 = __builtin_amdgcn_cvt_pk_f32_fp8((int)vin[i].x, false), a1 = __builtin_amdgcn_cvt_pk_f32_fp8((int)vin[i].x, true);
            const f32x2 a2 = __builtin_amdgcn_cvt_pk_f32_fp8((int)vin[i].y, false), a3 = __builtin_amdgcn_cvt_pk_f32_fp8((int)vin[i].y, true);
            v.x = pk2(a0.x, a0.y); v.y = pk2(a1.x, a1.y); v.z = pk2(a2.x, a2.y); v.w = pk2(a3.x, a3.y);
        } else v = vin[i];
        const int tp = (tl % dil) * cw + tl / dil;
        T[(ch * 8 + 0) * TS + tp] = (bf16_t)(v.x & 0xffffu); T[(ch * 8 + 1) * TS + tp] = (bf16_t)(v.x >> 16);
        T[(ch * 8 + 2) * TS + tp] = (bf16_t)(v.y & 0xffffu); T[(ch * 8 + 3) * TS + tp] = (bf16_t)(v.y >> 16);
        T[(ch * 8 + 4) * TS + tp] = (bf16_t)(v.z & 0xffffu); T[(ch * 8 + 5) * TS + tp] = (bf16_t)(v.z >> 16);
        T[(ch * 8 + 6) * TS + tp] = (bf16_t)(v.w & 0xffffu); T[(ch * 8 + 7) * TS + tp] = (bf16_t)(v.w >> 16);
    }
    asm volatile("s_waitcnt lgkmcnt(0)" ::: "memory");
    const int L = S / dil;
#pragma unroll
    for (int i = 0; i < 16; ++i) {
        const int id = i * 64 + lane, d = id >> 4, c = id & 15;
        const u32x2 v = *(const LAS u32x2*)(T + d * TS + c * 4);
        if constexpr (PERM) {
            int w = __builtin_amdgcn_cvt_pk_fp8_f32(bflo(v.x), bfhi(v.x), 0, false);
            w = __builtin_amdgcn_cvt_pk_fp8_f32(bflo(v.y), bfhi(v.y), w, true);
            const int dw = 8 * (c & 1) + 4 * (c >> 3) + ((c & 7) >> 1);
            *(int*)((unsigned char*)VT + (size_t)d * S + t0 + 4 * dw) = w;
        } else {
            const int tp = c * 4, cls = tp / cw, within = tp % cw;
            const int pos = cls * L + t0 / dil + within;
            *(u32x2*)(VT + (size_t)d * S + pos) = v;
        }
    }
    asm volatile("s_waitcnt lgkmcnt(0)" ::: "memory");
}

DEVI float rope_freq16(int i) { return exp2f(-(float)i * (13.287712379549449f / 16.f)); }
DEVI float rope32(float x, int li, float pos) {
    const float xp = swz_xor16(x);
    float rev = pos * rope_freq16(li & 15) * 0.15915494309189535f; rev -= floorf(rev);
    const float c = __builtin_amdgcn_cosf(rev), s = __builtin_amdgcn_sinf(rev);
    return (li < 16) ? (x * c - xp * s) : (xp * s + x * c);
}
DEVI void phase_post1(const Params& p, int layer, lchar* lds) {
    const int tid = otid(), lane = tid & 63, wid = tid >> 6;
    const int gw = obid() * NWAVES + wid, ngw = ogrid() * NWAVES;
    unsigned char* ws = p.ws;
    const bf16_t* P = (const bf16_t*)(ws + WS_P);
    unsigned char* qkv = ws + WS_QKV;
    LAS float* gtab = (LAS float*)(lds + 8 * 8704);
    for (int i = tid; i < 640; i += NTHREADS) {
        const int gi = i >> 6, d = i & 63;
        const float* src = gi == 0 ? p.in[5] + layer * 64 : gi == 1 ? p.in[6] + layer * 64 : gi < 5 ? p.in[8] + (layer * 3 + gi - 2) * 64 : gi < 8 ? p.in[9] + (layer * 3 + gi - 5) * 64
                         : gi == 8 ? p.in[16] + layer * 64 : p.in[17] + layer * 64;
        gtab[i] = src[d];
    }
    __syncthreads();
    const float ckg_pe = p.in[15][layer * 96 + 64 + (lane & 31)];
    f32x4 cqlg = *(const f32x4*)(p.in[10] + layer * 256 + 4 * lane);
    f32x2 ckvlg = *(const f32x2*)(p.in[11] + layer * 128 + 2 * lane);
    const float qs64 = 0.125f * LOG2E;
    const int g4 = lane >> 4, sub = lane & 15;
    for (int t = gw; t < S; t += ngw) {
        const unsigned char* row = (const unsigned char*)P + (size_t)t * PW;
        unsigned wvs[9];
#pragma unroll
        for (int it = 0; it < 9; ++it) {
            const int hI = it * 4 + g4;
            const int srcc = hI < 6 ? hI * 64 : (hI < 30 ? 512 + (hI - 6) * 64 : 3232 + (hI - 30) * 64);
            wvs[it] = *(const unsigned*)(row + srcc + 4 * sub);
        }
#pragma unroll
        for (int it = 0; it < 9; ++it) {
            const int hI = it * 4 + g4;
            const f32x2 wlo = __builtin_amdgcn_cvt_pk_f32_fp8((int)wvs[it], false), whi = __builtin_amdgcn_cvt_pk_f32_fp8((int)wvs[it], true);
            float x0 = wlo.x, x1 = wlo.y, x2 = whi.x, x3 = whi.y;
            float ss = (x0 * x0 + x1 * x1) + (x2 * x2 + x3 * x3);
            ss += dppf<0xB1>(ss); ss += dppf<0x4E>(ss); ss += dppf<0x141>(ss); ss += dppf<0x140>(ss);
            const float rs = rsqrtf(ss * (1.f / 64.f) + EPS);
            const int gi = hI < 4 ? 0 : (hI < 6 ? 1 : (hI < 18 ? 2 + ((hI - 6) >> 2) : (hI < 30 ? 5 + ((hI - 18) >> 2) : (hI < 34 ? 8 : 9))));
            const f32x4 gn = *(const LAS f32x4*)(gtab + gi * 64 + 4 * sub);
            x0 *= rs * gn.x; x1 *= rs * gn.y; x2 *= rs * gn.z; x3 *= rs * gn.w;
            const bool isq = (hI < 4) || (hI >= 6 && hI < 18) || (hI >= 30 && hI < 34);
            if (it >= 7) {
                const float p0 = swz_xor4(x0), p1 = swz_xor4(x1), p2 = swz_xor4(x2), p3 = swz_xor4(x3);
                if (hI >= 30) {
                    const float pos = (sub >> 3) ? (float)(t & 63) : (float)(t >> 6);
                    const bool first = (sub & 4) == 0;
                    const int fi = 4 * (sub & 3);
                    float xs[4] = {x0, x1, x2, x3}; const float ps[4] = {p0, p1, p2, p3};
#pragma unroll
                    for (int q = 0; q < 4; ++q) {
                        float rev = pos * rope_freq16(fi + q) * 0.15915494309189535f; rev -= floorf(rev);
                        const float c = __builtin_amdgcn_cosf(rev), sn = __builtin_amdgcn_sinf(rev);
                        xs[q] = first ? (xs[q] * c - ps[q] * sn) : (ps[q] * sn + xs[q] * c);
                    }
                    x0 = xs[0]; x1 = xs[1]; x2 = xs[2]; x3 = xs[3];
                }
            }
            const float sc = isq ? qs64 : 1.f;
            u32x2 o; o.x = pk2(x0 * sc, x1 * sc); o.y = pk2(x2 * sc, x3 * sc);
            if (it >= 7 && hI >= 30) {
                int w8 = __builtin_amdgcn_cvt_pk_fp8_f32(x0 * sc, x1 * sc, 0, false); w8 = __builtin_amdgcn_cvt_pk_fp8_f32(x2 * sc, x3 * sc, w8, true);
                const size_t d8 = (hI < 34) ? Q_QD + ((size_t)(hI - 30) * S + t) * 64 : Q_KD + ((size_t)(hI - 34) * S + t) * 64;
                *(int*)(qkv + d8 + 4 * sub) = w8;
                continue;
            }
            size_t doff;
            if (hI < 4) doff = Q_QA + ((size_t)hI * S + t) * 128;
            else if (hI < 6) doff = Q_KA + ((size_t)(hI - 4) * S + t) * 128;
            else if (hI < 30) {
                const int gh = (hI < 18) ? hI - 6 : hI - 18, g = gh >> 2;
                const int dil = (g == 0) ? 1 : (g == 1 ? 4 : 16);
                const int pos = (t % dil) * (S / dil) + t / dil;
                doff = ((hI < 18) ? Q_QB : Q_KB) + ((size_t)gh * S + pos) * 128;
            } else if (hI < 34) doff = Q_QD + ((size_t)(hI - 30) * S + t) * 128;
            else doff = Q_KD + ((size_t)(hI - 34) * S + t) * 128;
            *(u32x2*)(qkv + doff + 8 * sub) = o;
        }
        {
            const int w = *(const int*)(row + O_CQ + 4 * lane);
            const f32x2 wab = __builtin_amdgcn_cvt_pk_f32_fp8(w, false), wcd = __builtin_amdgcn_cvt_pk_f32_fp8(w, true);
            const float a = wab.x, b = wab.y, c = wcd.x, d = wcd.y;
            const float rs = rsqrtf(wave_sum(a * a + b * b + c * c + d * d) * (1.f / 256.f) + EPS);
            u32x2 o; o.x = pk2(a * rs * cqlg.x, b * rs * cqlg.y); o.y = pk2(c * rs * cqlg.z, d * rs * cqlg.w);
            *(u32x2*)((bf16_t*)(ws + WS_CQN) + (size_t)t * 256 + 4 * lane) = o;
            const f32x2 wef = __builtin_amdgcn_cvt_pk_f32_fp8((int)*(const unsigned short*)(row + O_CKV + 2 * lane), false);
            const float e = wef.x, f = wef.y;
            const float rs2 = rsqrtf(wave_sum(e * e + f * f) * (1.f / 128.f) + EPS);
            *(unsigned*)((bf16_t*)(ws + WS_CKVN) + (size_t)t * 128 + 2 * lane) = pk2(e * rs2 * ckvlg.x, f * rs2 * ckvlg.y);
            const f32x2 wkr = __builtin_amdgcn_cvt_pk_f32_fp8((int)row[O_CKR + (lane & 31)], false);
            float kr = (lane < 32) ? wkr.x : 0.f;
            const float rs3 = rsqrtf(wave_sum(kr * kr) * (1.f / 32.f) + EPS);
            const float y = rope32(kr * rs3 * ckg_pe, lane & 31, (float)t);
            {
                const unsigned char yb = (lane < 32) ? (unsigned char)(__builtin_amdgcn_cvt_pk_fp8_f32(y, 0.f, 0, false) & 0xff) : (unsigned char)0;
#pragma unroll
                for (int hh = 0; hh < 4; ++hh) (qkv + Q_KC)[((size_t)hh * S + t) * 128 + 64 + lane] = yb;
            }
        }
    }
    LAS bf16_t* T = (LAS bf16_t*)(lds + wid * 8704);
    for (int u = gw; u < 16 * 256; u += ngw) {
        const int hd = u >> 8, t0 = (u & 255) * 64;
        if (hd < 2) vtrans_unit<false, true>(P, PW, O_AV + hd * 64, t0, 1, (bf16_t*)(qkv + Q_VAT) + (size_t)hd * 64 * S, T, lane);
        else if (hd < 14) { const int gh = hd - 2, g = gh >> 2; const int dil = (g == 0) ? 1 : (g == 1 ? 4 : 16);
            vtrans_unit<false, true>(P, PW, O_BV + gh * 64, t0, dil, (bf16_t*)(qkv + Q_VBT) + (size_t)gh * 64 * S, T, lane); }
        else vtrans_unit<true, true>(P, PW, O_DV + (hd - 14) * 64, t0, 1, (bf16_t*)(qkv + Q_VDT + (size_t)(hd - 14) * 64 * S), T, lane);
    }
}
DEVI void phase_post2(const Params& p, int layer, lchar* lds) {
    const int tid = otid(), lane = tid & 63, wid = tid >> 6;
    const int gw = obid() * NWAVES + wid, ngw = ogrid() * NWAVES;
    unsigned char* ws = p.ws;
    unsigned char* qkv = ws + WS_QKV;
    const bf16_t* CQ = (const bf16_t*)(ws + WS_CQRAW);
    const bf16_t* CKV = (const bf16_t*)(ws + WS_CKVRAW);
    const float qs96 = 0.10206207261596575f * LOG2E;
    const int g4 = lane >> 4, sub = lane & 15;
    const f32x4 qgn = *(const f32x4*)(p.in[14] + layer * 96 + 4 * sub);
    const f32x4 kgn = *(const f32x4*)(p.in[15] + layer * 96 + 4 * sub);
    const int g8 = lane >> 3, s8 = lane & 7;
    const f32x4 qgp = *(const f32x4*)(p.in[14] + layer * 96 + 64 + 4 * s8);
    for (int t = gw; t < S; t += ngw) {
        const u32x2 wv_q = *(const u32x2*)(CQ + (size_t)t * 384 + g4 * 96 + 4 * sub);
        const u32x2 wv_k = *(const u32x2*)(CKV + (size_t)t * 512 + g4 * 128 + 4 * sub);
        const u32x2 wv_p = *(const u32x2*)(CQ + (size_t)t * 384 + (g8 & 3) * 96 + 64 + 4 * s8);
        __builtin_amdgcn_sched_barrier(0);
        {
            const u32x2 wv = wv_q;
            float x0 = bflo(wv.x), x1 = bfhi(wv.x), x2 = bflo(wv.y), x3 = bfhi(wv.y);
            float ss = (x0 * x0 + x1 * x1) + (x2 * x2 + x3 * x3);
            ss += dppf<0xB1>(ss); ss += dppf<0x4E>(ss); ss += dppf<0x141>(ss); ss += dppf<0x140>(ss);
            const float rs = rsqrtf(ss * (1.f / 64.f) + EPS) * qs96;
            int w8 = __builtin_amdgcn_cvt_pk_fp8_f32(x0 * rs * qgn.x, x1 * rs * qgn.y, 0, false); w8 = __builtin_amdgcn_cvt_pk_fp8_f32(x2 * rs * qgn.z, x3 * rs * qgn.w, w8, true);
            *(int*)(qkv + Q_QC + ((size_t)g4 * S + t) * 128 + 4 * sub) = w8;
        }
        {
            const u32x2 wv = wv_k;
            float x0 = bflo(wv.x), x1 = bfhi(wv.x), x2 = bflo(wv.y), x3 = bfhi(wv.y);
            float ss = (x0 * x0 + x1 * x1) + (x2 * x2 + x3 * x3);
            ss += dppf<0xB1>(ss); ss += dppf<0x4E>(ss); ss += dppf<0x141>(ss); ss += dppf<0x140>(ss);
            const float rs = rsqrtf(ss * (1.f / 64.f) + EPS);
            int w8 = __builtin_amdgcn_cvt_pk_fp8_f32(x0 * rs * kgn.x, x1 * rs * kgn.y, 0, false); w8 = __builtin_amdgcn_cvt_pk_fp8_f32(x2 * rs * kgn.z, x3 * rs * kgn.w, w8, true);
            *(int*)(qkv + Q_KC + ((size_t)g4 * S + t) * 128 + 4 * sub) = w8;
        }
        {
            const int hh = g8 & 3;
            const u32x2 wv = wv_p;
            float xs[4] = {bflo(wv.x), bfhi(wv.x), bflo(wv.y), bfhi(wv.y)};
            float ss = (xs[0] * xs[0] + xs[1] * xs[1]) + (xs[2] * xs[2] + xs[3] * xs[3]);
            ss += dppf<0xB1>(ss); ss += dppf<0x4E>(ss); ss += dppf<0x141>(ss);
            const float rs = rsqrtf(ss * (1.f / 32.f) + EPS);
            const float gq[4] = {qgp.x, qgp.y, qgp.z, qgp.w};
            const bool first = (s8 & 4) == 0;
            float ys[4];
#pragma unroll
            for (int q = 0; q < 4; ++q) {
                const float y = xs[q] * rs * gq[q];
                const float yp = swz_xor4(y);
                float rev = (float)t * rope_freq16(4 * (s8 & 3) + q) * 0.15915494309189535f; rev -= floorf(rev);
                const float c = __builtin_amdgcn_cosf(rev), sn = __builtin_amdgcn_sinf(rev);
                ys[q] = (first ? (y * c - yp * sn) : (yp * sn + y * c)) * qs96;
            }
            int w8 = __builtin_amdgcn_cvt_pk_fp8_f32(ys[0], ys[1], 0, false); w8 = __builtin_amdgcn_cvt_pk_fp8_f32(ys[2], ys[3], w8, true);
            *(int*)(qkv + Q_QC + ((size_t)hh * S + t) * 128 + (lane < 32 ? 64 : 96) + 4 * s8) = (lane < 32) ? w8 : 0;
        }
    }
    LAS bf16_t* T = (LAS bf16_t*)(lds + wid * 8704);
    for (int u = gw; u < 4 * 256; u += ngw) {
        const int hd = u >> 8, t0 = (u & 255) * 64;
        vtrans_unit<true>(CKV, 512, hd * 128 + 64, t0, 1, (bf16_t*)(qkv + Q_VCT + (size_t)hd * 64 * S), T, lane);
    }
}

#define PIN(x) asm volatile("" : "+v"(x))
DEVI float max3f(float a, float b, float c) { float r; asm("v_max3_f32 %0, %1, %2, %3" : "=v"(r) : "v"(a), "v"(b), "v"(c)); return r; }
DEVI float max2f(float a, float b) { float r; asm("v_max_f32_e32 %0, %1, %2" : "=v"(r) : "v"(a), "v"(b)); return r; }
DEVI float rowmax32(const f32x16& a, const f32x16& b) {
    float x = max3f(a[0], a[1], a[2]), y = max3f(a[3], a[4], a[5]);
    x = max3f(x, a[6], a[7]); y = max3f(y, a[8], a[9]); x = max3f(x, a[10], a[11]); y = max3f(y, a[12], a[13]); x = max3f(x, a[14], a[15]);
    y = max3f(y, b[0], b[1]); x = max3f(x, b[2], b[3]); y = max3f(y, b[4], b[5]); x = max3f(x, b[6], b[7]); y = max3f(y, b[8], b[9]);
    x = max3f(x, b[10], b[11]); y = max3f(y, b[12], b[13]); x = max3f(x, b[14], b[15]);
    return max2f(x, y);
}
template <int DQ> struct AttnCfg {
    static constexpr int KROWB = (DQ == 64) ? 64 : 128, KST = KROWB / 64, KTB = 64 * KROWB, VTB = 4096, NSLOT = 4, K_RING = 0, V_RING = NSLOT * KTB;
};
struct AttnDma { const unsigned char* kg; const unsigned char* vg; int kd, vd; };
template <int DQ> DEVI void attn_dma_k(const AttnDma& d, int jt, int slot, lchar* lds, int lane) {
    typedef AttnCfg<DQ> C;
    if constexpr (DQ == 64) { if (lane < 32) __builtin_amdgcn_global_load_lds((const unsigned*)(d.kg + (size_t)jt * C::KTB), (LAS unsigned*)(lds + C::K_RING + slot * C::KTB + d.kd), 16, 0, 0); }
    else __builtin_amdgcn_global_load_lds((const unsigned*)(d.kg + (size_t)jt * C::KTB), (LAS unsigned*)(lds + C::K_RING + slot * C::KTB + d.kd), 16, 0, 0);
}
template <int DQ> DEVI void attn_dma_v(const AttnDma& d, int jt, int slot, lchar* lds, int lane) {
    typedef AttnCfg<DQ> C;
    if (lane < 32) __builtin_amdgcn_global_load_lds((const unsigned*)(d.vg + (size_t)jt * 64), (LAS unsigned*)(lds + C::V_RING + slot * C::VTB + d.vd), 16, 0, 0);
}
#define ATTN_WAIT(n) asm volatile("s_waitcnt vmcnt(" #n ")" ::: "memory")
#define MFMA_F8(a, b, c) __builtin_amdgcn_mfma_scale_f32_32x32x64_f8f6f4(a, b, c, 0, 0, 0, 0, 0, 0)
DEVI i32x8 cat8(const u32x4 a, const u32x4 b) { return (i32x8){(int)a.x, (int)a.y, (int)a.z, (int)a.w, (int)b.x, (int)b.y, (int)b.z, (int)b.w}; }
constexpr float ATTN_OFF = 6.f;
#define CVT8(PX, G, DST) do { int w_ = __builtin_amdgcn_cvt_pk_fp8_f32(PX[4 * (G)], PX[4 * (G) + 1], 0, false); \
        w_ = __builtin_amdgcn_cvt_pk_fp8_f32(PX[4 * (G) + 2], PX[4 * (G) + 3], w_, true); DST = w_; } while (0)
template <int DQ>
DEVI void attn_step(int j, int NT, f32x16& pc0, f32x16& pc1, f32x16& sn0, f32x16& sn1, f32x16& negm, f32x16 (&o)[2], f32x16& o2, const i32x8 ones8, float& mhat,
                    const i32x8 (&qf)[AttnCfg<DQ>::KST], const AttnDma& dm, const int (&voff)[2], const int (&koff)[2 * AttnCfg<DQ>::KST], lchar* lds, int lane) {
    typedef AttnCfg<DQ> C;
    constexpr int KST = C::KST;
    constexpr float THR = ATTN_OFF + 2.f;
    {
        const int jk = (j + 3 < NT) ? j + 3 : NT - 1, jv = (j + 2 < NT) ? j + 2 : NT - 1;
        attn_dma_v<DQ>(dm, jv, (j + 2) & 3, lds, lane);
        attn_dma_k<DQ>(dm, jk, (j + 3) & 3, lds, lane);
    }
    const lchar* kbs = lds + C::K_RING + ((j + 1) & 3) * C::KTB;
    const lchar* vbs = lds + C::V_RING + (j & 3) * C::VTB;
    u32x4 kc[2][2 * KST];
#pragma unroll
    for (int t = 0; t < 2; ++t)
#pragma unroll
        for (int c = 0; c < 2 * KST; ++c) kc[t][c] = *(const LAS u32x4*)(kbs + koff[c] + t * 32 * C::KROWB);
    SBAR();
    i32x8 pb;
#define EXD(I) pc1[I] = fast_exp2(pc1[I])
    if constexpr (KST == 1) {
        sn0 = MFMA_F8(cat8(kc[0][0], kc[0][1]), qf[0], negm);
        EXD(8); EXD(9); EXD(10); EXD(11); EXD(12); EXD(13); EXD(14); EXD(15); PIN(pc1); SBAR();
        sn1 = MFMA_F8(cat8(kc[1][0], kc[1][1]), qf[0], negm);
        CVT8(pc0, 0, pb[0]); CVT8(pc0, 1, pb[1]); CVT8(pc0, 2, pb[2]); CVT8(pc0, 3, pb[3]);
        CVT8(pc1, 0, pb[4]); CVT8(pc1, 1, pb[5]); CVT8(pc1, 2, pb[6]); CVT8(pc1, 3, pb[7]); PIN(pb); SBAR();
    } else {
        sn0 = MFMA_F8(cat8(kc[0][0], kc[0][1]), qf[0], negm);
        EXD(8); EXD(9); EXD(10); EXD(11); CVT8(pc0, 0, pb[0]); CVT8(pc0, 1, pb[1]); PIN(pc1); PIN(pb); SBAR();
        sn1 = MFMA_F8(cat8(kc[1][0], kc[1][1]), qf[0], negm);
        EXD(12); EXD(13); EXD(14); EXD(15); CVT8(pc0, 2, pb[2]); CVT8(pc0, 3, pb[3]); PIN(pc1); PIN(pb); SBAR();
        sn0 = MFMA_F8(cat8(kc[0][2], kc[0][3]), qf[1], sn0);
        CVT8(pc1, 0, pb[4]); CVT8(pc1, 1, pb[5]); PIN(pb); SBAR();
        sn1 = MFMA_F8(cat8(kc[1][2], kc[1][3]), qf[1], sn1);
        CVT8(pc1, 2, pb[6]); CVT8(pc1, 3, pb[7]); PIN(pb); SBAR();
    }
#undef EXD
    u32x4 va[2][2];
#define VLD(db, c) va[db][c] = *(const LAS u32x4*)(vbs + voff[c] + (db) * 2048)
    VLD(0, 0); VLD(0, 1); VLD(1, 0); VLD(1, 1);
    if constexpr (KST == 1) asm volatile("s_nop 3" : "+v"(sn0), "+v"(sn1)); else asm volatile("s_nop 15" : "+v"(sn0), "+v"(sn1));
    float mx = rowmax32(sn0, sn1);
    {
        auto rr = __builtin_amdgcn_permlane32_swap(__float_as_uint(mx), __float_as_uint(mx), false, false);
        mx = max2f(__uint_as_float(rr[0]), __uint_as_float(rr[1]));
    }
    float f = 1.f;
    const bool resc = __any(mx > THR);
    if (__builtin_expect(resc, 0)) {
        const float dl = fmaxf(mx - ATTN_OFF, 0.f);
        mhat += dl;
#pragma unroll
        for (int i = 0; i < 16; ++i) { sn0[i] -= dl; sn1[i] -= dl; negm[i] = -mhat; }
        f = fast_exp2(-dl);
    }
    SBAR();
#define EX1(PX, I) PX[I] = fast_exp2(PX[I])
    o[0] = MFMA_F8(cat8(va[0][0], va[0][1]), pb, o[0]);
    EX1(sn0, 0); EX1(sn0, 1); EX1(sn0, 2); EX1(sn0, 3); EX1(sn0, 4); EX1(sn0, 5); EX1(sn0, 6); EX1(sn0, 7); PIN(sn0); SBAR();
    o[1] = MFMA_F8(cat8(va[1][0], va[1][1]), pb, o[1]);
    EX1(sn0, 8); EX1(sn0, 9); EX1(sn0, 10); EX1(sn0, 11); EX1(sn0, 12); EX1(sn0, 13); EX1(sn0, 14); EX1(sn0, 15); PIN(sn0); SBAR();
    o2 = MFMA_F8(ones8, pb, o2);
    EX1(sn1, 0); EX1(sn1, 1); EX1(sn1, 2); EX1(sn1, 3); EX1(sn1, 4); EX1(sn1, 5); EX1(sn1, 6); EX1(sn1, 7); PIN(sn1); SBAR();
#undef EX1
#undef VLD
    if (__builtin_expect(resc, 0)) {
#pragma unroll
        for (int i = 0; i < 16; ++i) { o[0][i] *= f; o[1][i] *= f; o2[i] *= f; }
    }
    ATTN_WAIT(2);
    __builtin_amdgcn_s_barrier();
    SBAR();
}
template <int DQ>
DEVI void dense_attn_unit(const unsigned char* Q8, const unsigned char* K8, const unsigned char* VT8, bf16_t* Y  , int qb, lchar* lds) {
    typedef AttnCfg<DQ> C;
    constexpr int KST = C::KST;
    const int tid = otid(), lane = tid & 63, wid = tid >> 6, r = lane & 31, h = lane >> 5;
    const int qrow = qb * 256 + wid * 32 + r;
    AttnDma dm;
    {
        const int row8 = wid * 8 + ((lane & 31) >> 2), ch8 = (lane & 3) ^ ((row8 >> 2) & 3);
        dm.vg = VT8 + (size_t)row8 * S + ch8 * 16; dm.vd = wid * 512;
        if constexpr (DQ == 64) { dm.kg = K8 + (size_t)row8 * 64 + ch8 * 16; dm.kd = wid * 512; }
        else { const int krow = wid * 8 + (lane >> 3), kch = (lane & 7) ^ ((krow >> 1) & 7); dm.kg = K8 + (size_t)krow * 128 + kch * 16; dm.kd = wid * 1024; }
    }
    int voff[2], koff[2 * KST];
    {
        const int sw4 = (r >> 2) & 3;
        voff[0] = r * 64 + (((2 * h) ^ sw4) << 4); voff[1] = r * 64 + (((2 * h + 1) ^ sw4) << 4);
        if constexpr (DQ == 64) { koff[0] = voff[0]; koff[1] = voff[1]; }
        else {
            const int m7 = (r >> 1) & 7;
#pragma unroll
            for (int c = 0; c < 4; ++c) koff[c] = r * 128 + (((4 * (c >> 1) + 2 * h + (c & 1)) ^ m7) << 4);
        }
    }
    __syncthreads();
    attn_dma_k<DQ>(dm, 0, 0, lds, lane); attn_dma_v<DQ>(dm, 0, 0, lds, lane);
    attn_dma_k<DQ>(dm, 1, 1, lds, lane); attn_dma_v<DQ>(dm, 1, 1, lds, lane);
    attn_dma_k<DQ>(dm, 2, 2, lds, lane);
    i32x8 qf[KST];
#pragma unroll
    for (int ks = 0; ks < KST; ++ks) {
        const unsigned char* qp = Q8 + (size_t)qrow * C::KROWB + 64 * ks + 32 * h;
        qf[ks] = cat8(*(const u32x4*)qp, *(const u32x4*)(qp + 16));
    }
    ATTN_WAIT(0);
    __builtin_amdgcn_s_barrier();
    SBAR();

    float mhat;
    f32x16 negm, pa0, pa1, pb0, pb1, o[2], o2;
#pragma unroll
    for (int i = 0; i < 16; ++i) { pa0[i] = 0.f; pa1[i] = 0.f; o[0][i] = 0.f; o[1][i] = 0.f; o2[i] = 0.f; }
    const int onew = (r == 0) ? 0x38383838 : 0;
    const i32x8 ones8 = {onew, onew, onew, onew, onew, onew, onew, onew};
#pragma unroll
    for (int ks = 0; ks < KST; ++ks) {
        const lchar* kp0 = lds + C::K_RING;
        pa0 = MFMA_F8(cat8(*(const LAS u32x4*)(kp0 + koff[2 * ks]), *(const LAS u32x4*)(kp0 + koff[2 * ks + 1])), qf[ks], pa0);
        pa1 = MFMA_F8(cat8(*(const LAS u32x4*)(kp0 + koff[2 * ks] + 32 * C::KROWB), *(const LAS u32x4*)(kp0 + koff[2 * ks + 1] + 32 * C::KROWB)), qf[ks], pa1);
    }
    {
        float mx = fmaxf(pa0[0], pa1[0]);
#pragma unroll
        for (int i = 1; i < 16; ++i) mx = fmaxf(mx, fmaxf(pa0[i], pa1[i]));
        auto rr = __builtin_amdgcn_permlane32_swap(__float_as_uint(mx), __float_as_uint(mx), false, false);
        mhat = fmaxf(__uint_as_float(rr[0]), __uint_as_float(rr[1])) - ATTN_OFF;
#pragma unroll
        for (int i = 0; i < 16; ++i) { pa0[i] = fast_exp2(pa0[i] - mhat); pa1[i] = (i < 8) ? fast_exp2(pa1[i] - mhat) : pa1[i] - mhat; negm[i] = -mhat; }
    }
    constexpr int NT = S / 64;
#pragma unroll 1
    for (int j = 0; j < NT - 2; j += 2) {
        attn_step<DQ>(j, NT, pa0, pa1, pb0, pb1, negm, o, o2, ones8, mhat, qf, dm, voff, koff, lds, lane);
        attn_step<DQ>(j + 1, NT, pb0, pb1, pa0, pa1, negm, o, o2, ones8, mhat, qf, dm, voff, koff, lds, lane);
    }
    attn_step<DQ>(NT - 2, NT, pa0, pa1, pb0, pb1, negm, o, o2, ones8, mhat, qf, dm, voff, koff, lds, lane);
    {
        i32x8 pb;
#pragma unroll
        for (int i = 8; i < 16; ++i) pb1[i] = fast_exp2(pb1[i]);
        CVT8(pb0, 0, pb[0]); CVT8(pb0, 1, pb[1]); CVT8(pb0, 2, pb[2]); CVT8(pb0, 3, pb[3]);
        CVT8(pb1, 0, pb[4]); CVT8(pb1, 1, pb[5]); CVT8(pb1, 2, pb[6]); CVT8(pb1, 3, pb[7]);
        const lchar* vb = lds + C::V_RING + ((NT - 1) & 3) * C::VTB;
#pragma unroll
        for (int db = 0; db < 2; ++db)
            o[db] = MFMA_F8(cat8(*(const LAS u32x4*)(vb + voff[0] + db * 2048), *(const LAS u32x4*)(vb + voff[1] + db * 2048)), pb, o[db]);
        o2 = MFMA_F8(ones8, pb, o2);
    }
    ATTN_WAIT(0);
    float l;
    {
        auto rr = __builtin_amdgcn_permlane32_swap(__float_as_uint(o2[0]), __float_as_uint(o2[0]), false, false);
        l = __uint_as_float(rr[0]);
    }
    const float inv = 1.f / l;
    unsigned char* yrow = (unsigned char*)Y + (size_t)qrow * DM;
#pragma unroll
    for (int db = 0; db < 2; ++db) {
        unsigned w8[4];
#pragma unroll
        for (int rg = 0; rg < 4; ++rg) {
            int w = __builtin_amdgcn_cvt_pk_fp8_f32(o[db][4 * rg] * inv, o[db][4 * rg + 1] * inv, 0, false); w = __builtin_amdgcn_cvt_pk_fp8_f32(o[db][4 * rg + 2] * inv, o[db][4 * rg + 3] * inv, w, true);
            w8[rg] = (unsigned)w;
        }
        const auto s0 = __builtin_amdgcn_permlane32_swap(w8[0], w8[2], false, false), s1 = __builtin_amdgcn_permlane32_swap(w8[1], w8[3], false, false);
        *(u32x4*)(yrow + db * 32 + 16 * h) = (u32x4){s0[0], s0[1], s1[0], s1[1]};
    }
}

DEVI int rel_bucket(int rel) {
    const int n = rel < 0 ? -rel : rel;
    int b;
    if (n < 8) b = n; else if (n < 15) b = 8; else if (n < 27) b = 9; else if (n < 50) b = 10; else if (n < 91) b = 11; else if (n < 166) b = 12;
    else if (n < 305) b = 13; else if (n < 559) b = 14; else b = 15;
    return b + (rel > 0 ? 16 : 0);
}
template <int HW, bool OUT8 = false>
DEVI void banded_block_task(const bf16_t* Q, const bf16_t* K, const bf16_t* VT, int q0, int L, int dil, const float* relb, int bias_col, bool has_sink, float sink2,
                            bf16_t* out, int ld_out, float* lse_out, lchar* lds) {
    constexpr int NK = 256 + 2 * HW, KSTR = 144, VSTR = NK * 2 + 16, NKB = (2 * HW + 32) / 32;
    constexpr int LUTN = 32 * NKB + 32;
    constexpr int K_OFF = 0, V_OFF = NK * KSTR, LUT_OFF = V_OFF + 64 * VSTR;
    static_assert(LUT_OFF + 4 * LUTN * 4 <= LDS_BYTES - 96, "banded LDS footprint");
    constexpr float THR = 8.f;
    const int tid = otid(), lane = tid & 63, wid = tid >> 6, r = lane & 31, h = lane >> 5;
    const int band_lo = q0 - HW;
    const int seg_lo = (q0 / L) * L, seg_hi = seg_lo + L;
    const bool edge = (band_lo < seg_lo) || (band_lo + NK > seg_hi);
    __syncthreads();
    u32x4 kst[NK * 8 / 512], vst[64 * (NK / 8) / 512];
#pragma unroll
    for (int i = 0; i < NK * 8 / 512; ++i) {
        const int c = tid + 512 * i, row = c >> 3, cc = c & 7;
        int key = band_lo + row; key = key < 0 ? 0 : (key > S - 1 ? S - 1 : key);
        kst[i] = *(const u32x4*)(K + (size_t)key * 64 + cc * 8);
    }
#pragma unroll
    for (int i = 0; i < 64 * (NK / 8) / 512; ++i) {
        const int c = tid + 512 * i, d = c / (NK / 8), kc = c % (NK / 8);
        int key0 = band_lo + kc * 8; key0 = key0 < 0 ? 0 : (key0 > S - 8 ? S - 8 : key0);
        vst[i] = *(const u32x4*)(VT + (size_t)d * S + key0);
    }
    __builtin_amdgcn_sched_barrier(0);
#pragma unroll
    for (int i = 0; i < NK * 8 / 512; ++i) {
        const int c = tid + 512 * i, row = c >> 3, cc = c & 7;
        *(LAS u32x4*)(lds + K_OFF + row * KSTR + cc * 16) = kst[i];
    }
#pragma unroll
    for (int i = 0; i < 64 * (NK / 8) / 512; ++i) {
        const int c = tid + 512 * i, d = c / (NK / 8), kc = c % (NK / 8);
        const u32x4 v = vst[i];
        *(LAS u32x2*)(lds + V_OFF + d * VSTR + (kc >> 1) * 32 + (kc & 1) * 8) = (u32x2){v.x, v.y};
        *(LAS u32x2*)(lds + V_OFF + d * VSTR + (kc >> 1) * 32 + (kc & 1) * 8 + 16) = (u32x2){v.z, v.w};
    }
    LAS float* lut = (LAS float*)(lds + LUT_OFF);
    for (int e = tid; e < 4 * LUTN; e += NTHREADS) {
        const int sp = e / LUTN, x = e % LUTN + sp - 32;
        float v = -INFINITY;
        if (x >= 0 && x <= 2 * HW) v = relb[rel_bucket((x - HW) * dil) * 16 + bias_col] * LOG2E;
        lut[e] = v;
    }
    const int qw0 = q0 + 32 * wid, qpos = qw0 + r;
    bf16x8 qf[4];
#pragma unroll
    for (int ks = 0; ks < 4; ++ks) qf[ks] = *(const bf16x8*)(Q + (size_t)qpos * 64 + ks * 16 + h * 8);
    const int sp = (4 - (r & 3)) & 3;
    const LAS float* lutl = lut + sp * LUTN + (32 + 4 * h - r - sp);
    __syncthreads();
    float m = has_sink ? sink2 : -64.f;
    float l = (has_sink && h == 0) ? 1.f : 0.f;
    f32x16 o[2];
#pragma unroll
    for (int i = 0; i < 16; ++i) { o[0][i] = 0.f; o[1][i] = 0.f; }
#pragma unroll 1
    for (int i = 0; i < NKB; ++i) {
        const int brow = 32 * wid + 32 * i;
        bf16x8 kf[4]; f32x4 bv[4]; u32x4 vf[2][2];
#pragma unroll
        for (int ks = 0; ks < 4; ++ks) kf[ks] = *(const LAS bf16x8*)(lds + K_OFF + (brow + r) * KSTR + (2 * ks + h) * 16);
#pragma unroll
        for (int g = 0; g < 4; ++g) bv[g] = *(const LAS f32x4*)(lutl + 32 * i + 8 * g);
#pragma unroll
        for (int s2 = 0; s2 < 2; ++s2)
#pragma unroll
            for (int db = 0; db < 2; ++db) vf[s2][db] = *(const LAS u32x4*)(lds + V_OFF + (db * 32 + r) * VSTR + (brow + 16 * s2) * 2 + 16 * h);
        f32x16 pa;
#pragma unroll
        for (int q = 0; q < 16; ++q) pa[q] = -m;
#pragma unroll
        for (int ks = 0; ks < 4; ++ks) pa = __builtin_amdgcn_mfma_f32_32x32x16_bf16(kf[ks], qf[ks], pa, 0, 0, 0);
#pragma unroll
        for (int q = 0; q < 16; ++q) pa[q] += bv[q >> 2][q & 3];
        if (edge) {
            const int kb0 = band_lo + brow + 4 * h;
#pragma unroll
            for (int q = 0; q < 16; ++q) {
                const int kp2 = kb0 + (q & 3) + 8 * (q >> 2);
                pa[q] = (kp2 >= seg_lo && kp2 < seg_hi) ? pa[q] : -INFINITY;
            }
        }
        float mx = fmaxf(fmaxf(pa[0], pa[1]), pa[2]);
#pragma unroll
        for (int q = 3; q < 15; q += 2) mx = fmaxf(fmaxf(mx, pa[q]), pa[q + 1]);
        mx = fmaxf(mx, pa[15]);
        mx = half_max(mx);
        if (__any(mx > THR)) {
            const float dl = fmaxf(mx, 0.f), alpha = fast_exp2(-dl);
            m += dl; l *= alpha;
#pragma unroll
            for (int q = 0; q < 16; ++q) { pa[q] -= dl; o[0][q] *= alpha; o[1][q] *= alpha; }
        }
        float ls = 0.f;
#pragma unroll
        for (int q = 0; q < 16; ++q) { pa[q] = fast_exp2(pa[q]); ls += pa[q]; }
        l += ls;
        bf16x8 pf[2];
        {
            u32x4 w;
            w.x = pk2(pa[0], pa[1]); w.y = pk2(pa[2], pa[3]); w.z = pk2(pa[4], pa[5]); w.w = pk2(pa[6], pa[7]); pf[0] = __builtin_bit_cast(bf16x8, w);
            w.x = pk2(pa[8], pa[9]); w.y = pk2(pa[10], pa[11]); w.z = pk2(pa[12], pa[13]); w.w = pk2(pa[14], pa[15]); pf[1] = __builtin_bit_cast(bf16x8, w);
        }
#pragma unroll
        for (int s2 = 0; s2 < 2; ++s2)
#pragma unroll
            for (int db = 0; db < 2; ++db) o[db] = __builtin_amdgcn_mfma_f32_32x32x16_bf16(__builtin_bit_cast(bf16x8, vf[s2][db]), pf[s2], o[db], 0, 0, 0);
    }
    l = half_sum(l);
    const float inv = 1.f / l;
    const int token = (qpos % L) * dil + qpos / L;
#pragma unroll
    for (int db = 0; db < 2; ++db) {
        if constexpr (OUT8) {
            unsigned w8[4];
#pragma unroll
            for (int rg = 0; rg < 4; ++rg) {
                int w = __builtin_amdgcn_cvt_pk_fp8_f32(o[db][4 * rg] * inv, o[db][4 * rg + 1] * inv, 0, false); w = __builtin_amdgcn_cvt_pk_fp8_f32(o[db][4 * rg + 2] * inv, o[db][4 * rg + 3] * inv, w, true);
                w8[rg] = (unsigned)w;
            }
            const auto s0 = __builtin_amdgcn_permlane32_swap(w8[0], w8[2], false, false), s1 = __builtin_amdgcn_permlane32_swap(w8[1], w8[3], false, false);
            *(u32x4*)((unsigned char*)out + (size_t)token * ld_out + db * 32 + 16 * h) = (u32x4){s0[0], s0[1], s1[0], s1[1]};
        }
#pragma unroll
        for (int rg = 0; rg < 4; ++rg) {
            if constexpr (OUT8) {
            } else {
                u32x2 w; w.x = pk2(o[db][4 * rg] * inv, o[db][4 * rg + 1] * inv); w.y = pk2(o[db][4 * rg + 2] * inv, o[db][4 * rg + 3] * inv);
                *(u32x2*)(out + (size_t)token * ld_out + db * 32 + 8 * rg + 4 * h) = w;
            }
        }
    }
    if (lse_out && h == 0) lse_out[(size_t)token * 4] = (m + log2f(l)) * 0.6931471805599453f;
}
DEVI void phase_attention(const Params& p, int layer, lchar* lds) {
    unsigned char* ws = p.ws;
    unsigned char* qkv = ws + WS_QKV;
    bf16_t* Y = (bf16_t*)(ws + WS_Y);
    for (int rr_ = 0; rr_ < (REPEAT_PHASE == 61 ? 2 : 1); ++rr_)
    for (int id = obid(); id < 512; id += ogrid()) {
        const int mh = (id & 7) ^ ((id >> 6) & 4), qb = id >> 3;
        if (mh < 4) {
            dense_attn_unit<96>((const unsigned char*)(qkv + Q_QC) + (size_t)mh * S * 128, (const unsigned char*)(qkv + Q_KC) + (size_t)mh * S * 128,
                                (const unsigned char*)(qkv + Q_VCT) + (size_t)mh * 64 * S, (bf16_t*)((unsigned char*)Y + 512 + mh * 64), qb, lds);
        } else {
            const int hh = mh - 4;
            dense_attn_unit<64>((const unsigned char*)(qkv + Q_QD) + (size_t)hh * S * 64, (const unsigned char*)(qkv + Q_KD) + (size_t)(hh >> 1) * S * 64,
                                (const unsigned char*)(qkv + Q_VDT) + (size_t)(hh >> 1) * 64 * S, (bf16_t*)((unsigned char*)Y + 768 + hh * 64), qb, lds);
        }
    }
    for (int rr_ = 0; rr_ < (REPEAT_PHASE == 62 ? 2 : 1); ++rr_)
    for (int u = obid(); u < 16 * 64; u += ogrid()) {
        const int hd = (u + 4 * (u >> 8)) & 15, ck = u >> 4;
        if (hd < 4) {
            banded_block_task<128, true>((const bf16_t*)(qkv + Q_QA) + (size_t)hd * S * 64, (const bf16_t*)(qkv + Q_KA) + (size_t)(hd >> 1) * S * 64,
                                   (const bf16_t*)(qkv + Q_VAT) + (size_t)(hd >> 1) * 64 * S, ck * 256, S, 1, p.in[1], hd, true, p.in[7][layer * 4 + hd] * LOG2E,
                                   (bf16_t*)((unsigned char*)Y + hd * 64), DM, nullptr, lds);
        } else {
            const int gh = hd - 4, g = gh >> 2, hh = gh & 3; const int dil = (g == 0) ? 1 : (g == 1 ? 4 : 16);
            banded_block_task<64>((const bf16_t*)(qkv + Q_QB) + (size_t)gh * S * 64, (const bf16_t*)(qkv + Q_KB) + (size_t)gh * S * 64,
                                  (const bf16_t*)(qkv + Q_VBT) + (size_t)gh * 64 * S, ck * 256, S / dil, dil, p.in[1], 4 + gh, false, 0.f,
                                  (bf16_t*)(ws + WS_OB) + (size_t)g * S * 256 + hh * 64, 256, (float*)(ws + WS_LSE) + (size_t)g * S * 4 + hh, lds);
        }
    }
}
DEVI void convert_rows_fp8(const float* src, unsigned char* dst, float* inv_scale, int nrows, int gw, int ngw, int lane) {
    for (int row = gw; row < nrows; row += ngw) {
        const float* sp = src + (size_t)row * 1024 + 16 * lane;
        f32x4 v[4]; float mx = 0.f;
#pragma unroll
        for (int j = 0; j < 4; ++j) { v[j] = *(const f32x4*)(sp + 4 * j); mx = fmaxf(mx, fmaxf(fmaxf(fabsf(v[j].x), fabsf(v[j].y)), fmaxf(fabsf(v[j].z), fabsf(v[j].w)))); }
        mx = wave_max(mx);
        const float sc = mx > 0.f ? 384.f / mx : 1.f;
        u32x4 o;
#pragma unroll
        for (int j = 0; j < 4; ++j) {
            int w = 0;
            w = __builtin_amdgcn_cvt_pk_fp8_f32(v[j].x * sc, v[j].y * sc, w, false);
            w = __builtin_amdgcn_cvt_pk_fp8_f32(v[j].z * sc, v[j].w * sc, w, true);
            o[j] = (unsigned)w;
        }
        *(u32x4*)(dst + (size_t)row * 1024 + 16 * lane) = o;
        if (lane == 0) inv_scale[row] = mx > 0.f ? mx * (1.f / 384.f) : 1.f;
    }
}
DEVI void convert_rows_fp4(const float* src, unsigned char* dst, float* inv_scale, int nrows, int gw, int ngw, int lane) {
    for (int row0 = gw; row0 < nrows; row0 += 2 * ngw) {
        const int row1 = row0 + ngw; const bool has1 = row1 < nrows;
        const float* sp0 = src + (size_t)row0 * 1024 + 16 * lane;
        const float* sp1 = src + (size_t)(has1 ? row1 : row0) * 1024 + 16 * lane;
        f32x4 va[4], vb[4];
#pragma unroll
        for (int j = 0; j < 4; ++j) { va[j] = *(const f32x4*)(sp0 + 4 * j); vb[j] = *(const f32x4*)(sp1 + 4 * j); }
#define CONV_ROW(V, ROW, DO) do { float mx = 0.f; \
            _Pragma("unroll") for (int j = 0; j < 4; ++j) mx = fmaxf(mx, fmaxf(fmaxf(fabsf(V[j].x), fabsf(V[j].y)), fmaxf(fabsf(V[j].z), fabsf(V[j].w)))); \
            mx = wave_max(mx); const float sc = mx > 0.f ? 6.f / mx : 1.f; u32x2 o; \
            _Pragma("unroll") for (int j = 0; j < 2; ++j) { unsigned w = 0u; \
                w = __builtin_amdgcn_cvt_scalef32_pk_fp4_f32(w, V[2 * j].x * sc, V[2 * j].y * sc, 1.0f, 0); \
                w = __builtin_amdgcn_cvt_scalef32_pk_fp4_f32(w, V[2 * j].z * sc, V[2 * j].w * sc, 1.0f, 1); \
                w = __builtin_amdgcn_cvt_scalef32_pk_fp4_f32(w, V[2 * j + 1].x * sc, V[2 * j + 1].y * sc, 1.0f, 2); \
                w = __builtin_amdgcn_cvt_scalef32_pk_fp4_f32(w, V[2 * j + 1].z * sc, V[2 * j + 1].w * sc, 1.0f, 3); o[j] = w; } \
            if (DO) { *(u32x2*)(dst + (size_t)(ROW) * 512 + 8 * lane) = o; if (lane == 0) inv_scale[ROW] = mx > 0.f ? mx * (1.f / 6.f) : 1.f; } } while (0)
        CONV_ROW(va, row0, true);
        CONV_ROW(vb, row1, has1);
#undef CONV_ROW
    }
}
DEVI void convert_rows_i4(const float* src, unsigned char* dst, float* inv_scale, int nrows, int gw, int ngw, int lane, const float* cgain) {
    f32x4 cg[4];
#pragma unroll
    for (int j = 0; j < 4; ++j) cg[j] = *(const f32x4*)(cgain + 16 * lane + 4 * j);
    for (int row0 = gw; row0 < nrows; row0 += 2 * ngw) {
        const int row1 = row0 + ngw; const bool has1 = row1 < nrows;
        const float* sp0 = src + (size_t)row0 * 1024 + 16 * lane;
        const float* sp1 = src + (size_t)(has1 ? row1 : row0) * 1024 + 16 * lane;
        f32x4 va[4], vb[4];
#pragma unroll
        for (int j = 0; j < 4; ++j) { va[j] = *(const f32x4*)(sp0 + 4 * j); vb[j] = *(const f32x4*)(sp1 + 4 * j); }
#pragma unroll
        for (int j = 0; j < 4; ++j) { va[j] *= cg[j]; vb[j] *= cg[j]; }
#define CONV_ROW(V, ROW, DO) do { float ss = 0.f; \
            _Pragma("unroll") for (int j = 0; j < 4; ++j) ss += (V[j].x * V[j].x + V[j].y * V[j].y) + (V[j].z * V[j].z + V[j].w * V[j].w); \
            ss = wave_sum(ss); const float step = ss > 0.f ? 0.335f * sqrtf(ss * (1.f / 1024.f)) : 1.f, inv = 1.f / step; u32x2 o; \
            _Pragma("unroll") for (int j = 0; j < 2; ++j) { unsigned w = 0u; \
                _Pragma("unroll") for (int e = 0; e < 8; ++e) { const float v = V[2 * j + (e >> 2)][e & 3]; \
                    const int q = (int)fminf(fmaxf(__builtin_rintf(v * inv), -8.f), 7.f); w |= ((unsigned)q & 15u) << (4 * e); } \
                o[j] = w; } \
            if (DO) { *(u32x2*)(dst + (size_t)(ROW) * 512 + 8 * lane) = o; if (lane == 0) inv_scale[ROW] = step; } } while (0)
        CONV_ROW(va, row0, true);
        CONV_ROW(vb, row1, has1);
#undef CONV_ROW
    }
}
DEVI void phase_bmerge(const Params& p, int layer) {
    const int tid = otid();
    unsigned char* ws = p.ws;
    const bf16_t* OB = (const bf16_t*)(ws + WS_OB);
    const float* LSE = (const float*)(ws + WS_LSE);
    bf16_t* Y = (bf16_t*)(ws + WS_Y);
    const size_t gtid = (size_t)obid() * NTHREADS + tid, gthreads = (size_t)ogrid() * NTHREADS;
    constexpr int NB = 4;
    for (size_t i0 = gtid; i0 < (size_t)S * 32; i0 += NB * gthreads) {
        float l0[NB], l1[NB], l2[NB]; u32x4 a[NB], b[NB], d[NB];
#pragma unroll
        for (int u = 0; u < NB; ++u) {
            size_t i = i0 + (size_t)u * gthreads; if (i >= (size_t)S * 32) i = i0;
            const int t = (int)(i >> 5), hh = (int)((i >> 3) & 3), c = (int)(i & 7);
            l0[u] = LSE[(size_t)t * 4 + hh]; l1[u] = LSE[((size_t)S + t) * 4 + hh]; l2[u] = LSE[((size_t)2 * S + t) * 4 + hh];
            a[u] = *(const u32x4*)(OB + (size_t)t * 256 + hh * 64 + c * 8);
            b[u] = *(const u32x4*)(OB + ((size_t)S + t) * 256 + hh * 64 + c * 8);
            d[u] = *(const u32x4*)(OB + ((size_t)2 * S + t) * 256 + hh * 64 + c * 8);
        }
#pragma unroll
        for (int u = 0; u < NB; ++u) {
            const size_t i = i0 + (size_t)u * gthreads;
            const int t = (int)(i >> 5), hh = (int)((i >> 3) & 3), c = (int)(i & 7);
            const float mx = fmaxf(l0[u], fmaxf(l1[u], l2[u]));
            float w0 = __expf(l0[u] - mx), w1 = __expf(l1[u] - mx), w2 = __expf(l2[u] - mx);
            const float inv = 1.f / (w0 + w1 + w2);
            w0 *= inv; w1 *= inv; w2 *= inv;
            int o0 = __builtin_amdgcn_cvt_pk_fp8_f32(w0 * bflo(a[u].x) + w1 * bflo(b[u].x) + w2 * bflo(d[u].x), w0 * bfhi(a[u].x) + w1 * bfhi(b[u].x) + w2 * bfhi(d[u].x), 0, false);
            o0 = __builtin_amdgcn_cvt_pk_fp8_f32(w0 * bflo(a[u].y) + w1 * bflo(b[u].y) + w2 * bflo(d[u].y), w0 * bfhi(a[u].y) + w1 * bfhi(b[u].y) + w2 * bfhi(d[u].y), o0, true);
            int o1 = __builtin_amdgcn_cvt_pk_fp8_f32(w0 * bflo(a[u].z) + w1 * bflo(b[u].z) + w2 * bflo(d[u].z), w0 * bfhi(a[u].z) + w1 * bfhi(b[u].z) + w2 * bfhi(d[u].z), 0, false);
            o1 = __builtin_amdgcn_cvt_pk_fp8_f32(w0 * bflo(a[u].w) + w1 * bflo(b[u].w) + w2 * bflo(d[u].w), w0 * bfhi(a[u].w) + w1 * bfhi(b[u].w) + w2 * bfhi(d[u].w), o1, true);
            if (i < (size_t)S * 32) *(u32x2*)((unsigned char*)Y + (size_t)t * DM + 256 + hh * 64 + c * 8) = (u32x2){(unsigned)o0, (unsigned)o1};
        }
    }
    const int lane = tid & 63, gw = (int)(gtid >> 6), ngw = (int)(gthreads >> 6);
#if EXPERT_FP4
    convert_rows_i4(p.in[23] + (size_t)layer * 16384 * 1024, ws + WS_PU, (float*)(ws + WS_US), 16384, gw, ngw, lane, p.in[20] + layer * DM);
    convert_rows_fp4(p.in[24] + (size_t)layer * 16384 * 1024, ws + WS_PV, (float*)(ws + WS_VS), 16384, gw, ngw, lane);
#else
    convert_rows_fp8(p.in[23] + (size_t)layer * 16384 * 1024, ws + WS_PU, (float*)(ws + WS_US), 16384, gw, ngw, lane);
    convert_rows_fp8(p.in[24] + (size_t)layer * 16384 * 1024, ws + WS_PV, (float*)(ws + WS_VS), 16384, gw, ngw, lane);
#endif
}

DEVI unsigned f2ord(float f) { const unsigned u = __float_as_uint(f); return u ^ ((unsigned)((int)u >> 31) | 0x80000000u); }
DEVI float ord2f(unsigned o) { const unsigned u = (o & 0x80000000u) ? (o ^ 0x80000000u) : ~o; return __uint_as_float(u); }
DEVI void cswap_desc(unsigned& a, unsigned& b) { const unsigned mx = a > b ? a : b, mn = a > b ? b : a; a = mx; b = mn; }
DEVI void sort16_desc(unsigned (&v)[16]) {
    constexpr int KK[10] = {2, 4, 4, 8, 8, 8, 16, 16, 16, 16};
    constexpr int JJ[10] = {1, 2, 1, 4, 2, 1, 8, 4, 2, 1};
#pragma unroll
    for (int st = 0; st < 10; ++st)
#pragma unroll
        for (int i = 0; i < 16; ++i) {
            const int l = i ^ JJ[st];
            if (l > i) { if ((i & KK[st]) == 0) cswap_desc(v[i], v[l]); else cswap_desc(v[l], v[i]); }
        }
}
DEVI void merge16_desc(unsigned (&a)[16], const unsigned (&b)[16]) {
#pragma unroll
    for (int i = 0; i < 16; ++i) a[i] = a[i] > b[15 - i] ? a[i] : b[15 - i];
    constexpr int JJ[4] = {8, 4, 2, 1};
#pragma unroll
    for (int st = 0; st < 4; ++st)
#pragma unroll
        for (int i = 0; i < 16; ++i) { const int l = i ^ JJ[st]; if (l > i) cswap_desc(a[i], a[l]); }
}
DEVI void top16_of_64(unsigned (&g0)[16], unsigned (&g1)[16], unsigned (&g2)[16], unsigned (&g3)[16]) {
    sort16_desc(g0); sort16_desc(g1); sort16_desc(g2); sort16_desc(g3);
    merge16_desc(g0, g1); merge16_desc(g2, g3); merge16_desc(g0, g2);
}
DEVI float blendf(float a, float b, unsigned m) { return __uint_as_float((__float_as_uint(a) & ~m) | (__float_as_uint(b) & m)); }
DEVI void fp8x16_to_f32(const u32x4 w, float (&f)[16]) {
#pragma unroll
    for (int j = 0; j < 4; ++j) {
        const f32x2 a = __builtin_amdgcn_cvt_pk_f32_fp8((int)w[j], false), b = __builtin_amdgcn_cvt_pk_f32_fp8((int)w[j], true);
        f[4 * j] = a.x; f[4 * j + 1] = a.y; f[4 * j + 2] = b.x; f[4 * j + 3] = b.y;
    }
}
DEVI void fp4x16_to_f32(const u32x2 w, float (&f)[16]) {
#pragma unroll
    for (int j = 0; j < 2; ++j)
    {
        const f32x2 a0 = __builtin_amdgcn_cvt_scalef32_pk_f32_fp4(w[j], 1.0f, 0), a1 = __builtin_amdgcn_cvt_scalef32_pk_f32_fp4(w[j], 1.0f, 1);
        const f32x2 a2 = __builtin_amdgcn_cvt_scalef32_pk_f32_fp4(w[j], 1.0f, 2), a3 = __builtin_amdgcn_cvt_scalef32_pk_f32_fp4(w[j], 1.0f, 3);
        f[8 * j] = a0.x; f[8 * j + 1] = a0.y; f[8 * j + 2] = a1.x; f[8 * j + 3] = a1.y; f[8 * j + 4] = a2.x; f[8 * j + 5] = a2.y; f[8 * j + 6] = a3.x; f[8 * j + 7] = a3.y;
    }
}
DEVI void fp4x16_to_pairs(const u32x2 w, f32x2 (&f)[8]) {
#pragma unroll
    for (int j = 0; j < 2; ++j) {
        f[4 * j] = __builtin_amdgcn_cvt_scalef32_pk_f32_fp4(w[j], 1.0f, 0); f[4 * j + 1] = __builtin_amdgcn_cvt_scalef32_pk_f32_fp4(w[j], 1.0f, 1);
        f[4 * j + 2] = __builtin_amdgcn_cvt_scalef32_pk_f32_fp4(w[j], 1.0f, 2); f[4 * j + 3] = __builtin_amdgcn_cvt_scalef32_pk_f32_fp4(w[j], 1.0f, 3);
    }
}
DEVI void fp8x16_to_pairs(const u32x4 w, f32x2 (&f)[8]) {
#pragma unroll
    for (int j = 0; j < 4; ++j) { f[2 * j] = __builtin_amdgcn_cvt_pk_f32_fp8((int)w[j], false); f[2 * j + 1] = __builtin_amdgcn_cvt_pk_f32_fp8((int)w[j], true); }
}
constexpr int PH_PER_LAYER = 11 + 4 * SELFCHECK, N_PHASES = 1 + NLAYER * PH_PER_LAYER + SELFCHECK;
#if SELFCHECK
constexpr int CK_FLAG_WORD = 3900;
constexpr int NSAMP = 24;
DEVI int ck_vperm(int k) { return k ^ ((((k >> 2) ^ (k >> 3)) & 1) ? 12 : 0); }
__device__ const int ck_tokens[NSAMP] = {0, 1, 2, 31, 32, 63, 64, 65, 127, 128, 129, 255, 256, 1023, 1024, 4095, 4096, 5000, 8191, 8192, 12345, 16255, 16382, 16383};
constexpr int R_AQ = 0, R_AK = 256, R_AV = 384, R_BQ = 512, R_BK = 512 + 768, R_BV = 512 + 1536, R_CQ = 512 + 2304, R_CKV = R_CQ + 256, R_CKR = R_CKV + 128,
              R_DQ = R_CKR + 32, R_DK = R_DQ + 256, R_DV = R_DK + 128, R_G = R_DV + 128;
static_assert(R_AQ == O_AQ && R_AK == O_AK && R_AV == O_AV && R_BQ == O_BQ && R_BK == O_BK && R_BV == O_BV && R_CQ == O_CQ && R_CKV == O_CKV && R_CKR == O_CKR &&
              R_DQ == O_DQ && R_DK == O_DK && R_DV == O_DV && R_G == NGATE0, "column partition");
DEVI void ck_flag(const Params& p, unsigned bit) { atomicOr((unsigned*)(p.ws + WS_CTL) + CK_FLAG_WORD, bit); }
DEVI bool ck_vec(float ref, float got, bool active, float tol) {
    const float e = active ? (ref - got) * (ref - got) : 0.f, q = active ? ref * ref : 0.f;
    const float es = wave_sum(e), qs = wave_sum(q);
    return !(es <= tol * tol * qs + 1e-12f);
}
DEVI float ck_relerr(float ref, float got) {
    const float es = wave_sum((ref - got) * (ref - got)), qs = wave_sum(ref * ref);
    return sqrtf(es / (qs + 1e-20f));
}
DEVI unsigned ck_quant(float e) { if (!(e == e)) return 7u; return e < 0.02f ? 0u : e < 0.05f ? 1u : e < 0.1f ? 2u : e < 0.2f ? 3u : e < 0.5f ? 4u : e < 1.0f ? 5u : 6u; }
DEVI float ck_rope_ref(float x_self, float x_pair, int i_in_32, float pos) {
    const int i = i_in_32 & 15;
    const float ang = pos * powf(10000.f, -(float)i / 16.f);
    const float c = cosf(ang), s_ = sinf(ang);
    return (i_in_32 < 16) ? (x_self * c - x_pair * s_) : (x_pair * s_ + x_self * c);
}
DEVI void phase_check1(const Params& p, int layer) {
    const int tid = otid(), lane = tid & 63, wid = tid >> 6, gw = obid() * NWAVES + wid;
    if (gw >= NSAMP) return;
    const int t = ck_tokens[gw];
    unsigned char* ws = p.ws; unsigned char* qkv = ws + WS_QKV;
    const bf16_t* row = (const bf16_t*)(ws + WS_P) + (size_t)t * PW;
    bool bad = false;
    const float sc = 0.125f * LOG2E;
    for (int hh = 0; hh < 4; ++hh) {
        const float v = bf2f(row[R_AQ + hh * 64 + lane]); const float ms = wave_sum(v * v) / 64.f;
        const float ref = v / sqrtf(ms + 1e-6f) * p.in[5][layer * 64 + lane] * sc;
        bad |= ck_vec(ref, bf2f(((const bf16_t*)(qkv + Q_QA))[((size_t)hh * S + t) * 64 + lane]), true, 0.02f);
    }
    for (int kh = 0; kh < 2; ++kh) {
        const float v = bf2f(row[R_AK + kh * 64 + lane]); const float ms = wave_sum(v * v) / 64.f;
        const float ref = v / sqrtf(ms + 1e-6f) * p.in[6][layer * 64 + lane];
        bad |= ck_vec(ref, bf2f(((const bf16_t*)(qkv + Q_KA))[((size_t)kh * S + t) * 64 + lane]), true, 0.02f);
        bad |= ck_vec(bf2f(row[R_AV + kh * 64 + lane]), bf2f(((const bf16_t*)(qkv + Q_VAT))[((size_t)kh * 64 + lane) * S + t]), true, 0.001f);
    }
    for (int g = 0; g < 3; ++g) {
        const int dil = (g == 0) ? 1 : (g == 1 ? 4 : 16), L = S / dil, pos = (t % dil) * L + t / dil;
        for (int hh = 0; hh < 4; ++hh) {
            const int gh = g * 4 + hh;
            float v = bf2f(row[R_BQ + g * 256 + hh * 64 + lane]); float ms = wave_sum(v * v) / 64.f;
            float ref = v / sqrtf(ms + 1e-6f) * p.in[8][(layer * 3 + g) * 64 + lane] * sc;
            bad |= ck_vec(ref, bf2f(((const bf16_t*)(qkv + Q_QB))[((size_t)gh * S + pos) * 64 + lane]), true, 0.02f);
            v = bf2f(row[R_BK + g * 256 + hh * 64 + lane]); ms = wave_sum(v * v) / 64.f;
            ref = v / sqrtf(ms + 1e-6f) * p.in[9][(layer * 3 + g) * 64 + lane];
            bad |= ck_vec(ref, bf2f(((const bf16_t*)(qkv + Q_KB))[((size_t)gh * S + pos) * 64 + lane]), true, 0.02f);
            bad |= ck_vec(bf2f(row[R_BV + g * 256 + hh * 64 + lane]), bf2f(((const bf16_t*)(qkv + Q_VBT))[((size_t)gh * 64 + lane) * S + pos]), true, 0.001f);
        }
    }
    for (int hh = 0; hh < 6; ++hh) {
        const bool isq = hh < 4; const int off = isq ? R_DQ + hh * 64 : R_DK + (hh - 4) * 64;
        const float v = bf2f(row[off + lane]); const float ms = wave_sum(v * v) / 64.f;
        const float y = v / sqrtf(ms + 1e-6f) * (isq ? p.in[16][layer * 64 + lane] : p.in[17][layer * 64 + lane]);
        const float yp = __shfl(y, (lane & 32) | ((lane & 31) ^ 16));
        const float ref = ck_rope_ref(y, yp, lane & 31, (lane < 32) ? (float)(t / 64) : (float)(t % 64)) * (isq ? sc : 1.f);
        const bf16_t* dst = isq ? (const bf16_t*)(qkv + Q_QD) + ((size_t)hh * S + t) * 64 : (const bf16_t*)(qkv + Q_KD) + ((size_t)(hh - 4) * S + t) * 64;
        bad |= ck_vec(ref, bf2f(dst[lane]), true, 0.02f);
    }
    for (int kh = 0; kh < 2; ++kh)
        bad |= ck_vec(bf2f(row[R_DV + kh * 64 + lane]), bf2f(((const bf16_t*)(qkv + Q_VDT))[((size_t)kh * 64 + lane) * S + ck_vperm(t)]), true, 0.001f);
    {
        float ss = 0.f; for (int i = 0; i < 4; ++i) { const float v = bf2f(row[R_CQ + lane + 64 * i]); ss += v * v; }
        const float ms = wave_sum(ss) / 256.f;
        for (int i = 0; i < 4; ++i) { const float v = bf2f(row[R_CQ + lane + 64 * i]);
            bad |= ck_vec(v / sqrtf(ms + 1e-6f) * p.in[10][layer * 256 + lane + 64 * i], bf2f(((const bf16_t*)(ws + WS_CQN))[(size_t)t * 256 + lane + 64 * i]), true, 0.02f); }
        float s2 = 0.f; for (int i = 0; i < 2; ++i) { const float v = bf2f(row[R_CKV + lane + 64 * i]); s2 += v * v; }
        const float ms2 = wave_sum(s2) / 128.f;
        for (int i = 0; i < 2; ++i) { const float v = bf2f(row[R_CKV + lane + 64 * i]);
            bad |= ck_vec(v / sqrtf(ms2 + 1e-6f) * p.in[11][layer * 128 + lane + 64 * i], bf2f(((const bf16_t*)(ws + WS_CKVN))[(size_t)t * 128 + lane + 64 * i]), true, 0.02f); }
        const float kr = lane < 32 ? bf2f(row[R_CKR + lane]) : 0.f; const float ms3 = wave_sum(kr * kr) / 32.f;
        const float y = kr / sqrtf(ms3 + 1e-6f) * p.in[15][layer * 96 + 64 + (lane & 31)];
        const float yp = __shfl(y, (lane & 31) ^ 16);
        const float ref = ck_rope_ref(y, yp, lane & 31, (float)t);
        for (int hh = 0; hh < 4; ++hh) bad |= ck_vec(ref, lane < 32 ? bf2f(((const bf16_t*)(qkv + Q_KC))[((size_t)hh * S + t) * 96 + 64 + lane]) : 0.f, lane < 32, 0.02f);
    }
    if (bad && lane == 0) ck_flag(p, 1u);
}
DEVI void phase_check2(const Params& p, int layer) {
    const int tid = otid(), lane = tid & 63, wid = tid >> 6, gw = obid() * NWAVES + wid;
    if (gw >= NSAMP * 4) return;
    const int t = ck_tokens[gw >> 2], hh = gw & 3;
    unsigned char* ws = p.ws; unsigned char* qkv = ws + WS_QKV;
    const bf16_t* cqn = (const bf16_t*)(ws + WS_CQN) + (size_t)t * 256;
    const bf16_t* ckvn = (const bf16_t*)(ws + WS_CKVN) + (size_t)t * 128;
    const float* wuq = p.in[12] + (size_t)layer * 256 * 384;
    const float* wukv = p.in[13] + (size_t)layer * 128 * 512;
    bool bad = false;
    float qn = 0.f, qp = 0.f, kn = 0.f, vv = 0.f;
    for (int k = 0; k < 256; ++k) { const float a = bf2f(cqn[k]); qn += a * wuq[(size_t)k * 384 + hh * 96 + lane]; if (lane < 32) qp += a * wuq[(size_t)k * 384 + hh * 96 + 64 + lane]; }
    for (int k = 0; k < 128; ++k) { const float a = bf2f(ckvn[k]); kn += a * wukv[(size_t)k * 512 + hh * 128 + lane]; vv += a * wukv[(size_t)k * 512 + hh * 128 + 64 + lane]; }
    const float sc = 0.10206207261596575f * LOG2E;
    {
        const float ms = wave_sum(qn * qn) / 64.f;
        bad |= ck_vec(qn / sqrtf(ms + 1e-6f) * p.in[14][layer * 96 + lane] * sc, bf2f(((const bf16_t*)(qkv + Q_QC))[((size_t)hh * S + t) * 96 + lane]), true, 0.03f);
        const float ms2 = wave_sum(lane < 32 ? qp * qp : 0.f) / 32.f;
        const float y = qp / sqrtf(ms2 + 1e-6f) * p.in[14][layer * 96 + 64 + (lane & 31)];
        const float yp = __shfl(y, (lane & 31) ^ 16);
        bad |= ck_vec(ck_rope_ref(y, yp, lane & 31, (float)t) * sc, lane < 32 ? bf2f(((const bf16_t*)(qkv + Q_QC))[((size_t)hh * S + t) * 96 + 64 + lane]) : 0.f, lane < 32, 0.03f);
        const float ms3 = wave_sum(kn * kn) / 64.f;
        bad |= ck_vec(kn / sqrtf(ms3 + 1e-6f) * p.in[15][layer * 96 + lane], bf2f(((const bf16_t*)(qkv + Q_KC))[((size_t)hh * S + t) * 96 + lane]), true, 0.03f);
        bad |= ck_vec(vv, bf2f(((const bf16_t*)(qkv + Q_VCT))[((size_t)hh * 64 + lane) * S + ck_vperm(t)]), true, 0.03f);
    }
    if (bad && lane == 0) ck_flag(p, 2u);
}
DEVI float ck_bias(const float* relb, int rel_tokens, int col) {
    const int nb = 16, max_exact = 8;
    int ret = rel_tokens > 0 ? nb : 0;
    const int n = rel_tokens < 0 ? -rel_tokens : rel_tokens;
    const float nf = (float)(n > 1 ? n : 1);
    int large = max_exact + (int)(logf(nf / (float)max_exact) / logf(1024.f / (float)max_exact) * (float)(nb - max_exact));
    large = large < nb - 1 ? large : nb - 1;
    ret += (n < max_exact) ? n : large;
    return relb[ret * 16 + col];
}
DEVI void phase_check3(const Params& p, int layer, int mode) {
    const int tid = otid(), lane = tid & 63, wid = tid >> 6, gw = obid() * NWAVES + wid;
    if (gw >= NSAMP * 28) return;
    const int t = ck_tokens[gw / 28], kind = gw % 28;
    if ((kind >= 24) != (mode == 1)) return;
    unsigned char* ws = p.ws; unsigned char* qkv = ws + WS_QKV;
    const bf16_t* Y = (const bf16_t*)(ws + WS_Y);
    unsigned* fw = (unsigned*)(p.ws + WS_CTL) + CK_FLAG_WORD;
    if (kind >= 24) {
        const int hh = kind - 24;
        const bf16_t* OB = (const bf16_t*)(ws + WS_OB); const float* LSE = (const float*)(ws + WS_LSE);
        const float l0 = LSE[(size_t)t * 4 + hh], l1 = LSE[((size_t)S + t) * 4 + hh], l2 = LSE[((size_t)2 * S + t) * 4 + hh];
        const float mx = fmaxf(l0, fmaxf(l1, l2));
        const float w0 = expf(l0 - mx), w1 = expf(l1 - mx), w2 = expf(l2 - mx);
        const float ref = (w0 * bf2f(OB[(size_t)t * 256 + hh * 64 + lane]) + w1 * bf2f(OB[((size_t)S + t) * 256 + hh * 64 + lane]) + w2 * bf2f(OB[((size_t)2 * S + t) * 256 + hh * 64 + lane])) / (w0 + w1 + w2);
        const unsigned qv = ck_quant(ck_relerr(ref, bf2f(Y[(size_t)t * DM + 256 + hh * 64 + lane])));
        if (lane == 0) atomicMax(fw + 4, qv);
        return;
    }
    const bf16_t* Q; const bf16_t* K; const bf16_t* VT; const bf16_t* target; const float* lse_target = nullptr;
    int DQ = 64, klo = 0, khi = S - 1, qp = t, dil = 1, bias_col = -1, slot; float sink2 = 0.f; bool has_sink = false;
    if (kind < 4) { const int hh = kind; slot = 1;
        Q = (const bf16_t*)(qkv + Q_QA) + ((size_t)hh * S + t) * 64; K = (const bf16_t*)(qkv + Q_KA) + (size_t)(hh >> 1) * S * 64; VT = (const bf16_t*)(qkv + Q_VAT) + (size_t)(hh >> 1) * 64 * S;
        klo = t - 128 < 0 ? 0 : t - 128; khi = t + 128 > S - 1 ? S - 1 : t + 128; bias_col = hh; has_sink = true; sink2 = p.in[7][layer * 4 + hh] * LOG2E;
        target = Y + (size_t)t * DM + hh * 64;
    } else if (kind < 16) { const int gh = kind - 4, g = gh >> 2, hh = gh & 3; slot = 2;
        dil = (g == 0) ? 1 : (g == 1 ? 4 : 16); const int L = S / dil, c = t % dil, jq = t / dil;
        qp = c * L + jq;
        Q = (const bf16_t*)(qkv + Q_QB) + ((size_t)gh * S + qp) * 64; K = (const bf16_t*)(qkv + Q_KB) + (size_t)gh * S * 64; VT = (const bf16_t*)(qkv + Q_VBT) + (size_t)gh * 64 * S;
        klo = c * L + (jq - 64 < 0 ? 0 : jq - 64); khi = c * L + (jq + 64 > L - 1 ? L - 1 : jq + 64); bias_col = 4 + gh;
        target = (const bf16_t*)(ws + WS_OB) + ((size_t)g * S + t) * 256 + hh * 64; lse_target = (const float*)(ws + WS_LSE) + ((size_t)g * S + t) * 4 + hh;
    } else if (kind < 20) { const int hh = kind - 16; DQ = 96; slot = 3;
        Q = (const bf16_t*)(qkv + Q_QC) + ((size_t)hh * S + t) * 96; K = (const bf16_t*)(qkv + Q_KC) + (size_t)hh * S * 96; VT = (const bf16_t*)(qkv + Q_VCT) + (size_t)hh * 64 * S;
        target = Y + (size_t)t * DM + 512 + hh * 64;
    } else { const int hh = kind - 20; slot = 3;
        Q = (const bf16_t*)(qkv + Q_QD) + ((size_t)hh * S + t) * 64; K = (const bf16_t*)(qkv + Q_KD) + (size_t)(hh >> 1) * S * 64; VT = (const bf16_t*)(qkv + Q_VDT) + (size_t)(hh >> 1) * 64 * S;
        target = Y + (size_t)t * DM + 768 + hh * 64;
    }
    float m = has_sink ? sink2 : -INFINITY;
#pragma unroll 1
    for (int k = klo + lane; k <= khi; k += 64) {
        float d = 0.f;
#pragma unroll 4
        for (int x = 0; x < DQ; ++x) d += bf2f(Q[x]) * bf2f(K[(size_t)k * DQ + x]);
        if (bias_col >= 0) d += ck_bias(p.in[1], (k - qp) * dil, bias_col) * LOG2E;
        m = fmaxf(m, d);
    }
    m = wave_max(m);
    float out[64]; float den = 0.f;
#pragma unroll
    for (int dd = 0; dd < 64; ++dd) out[dd] = 0.f;
#pragma unroll 1
    for (int k = klo + lane; k <= khi; k += 64) {
        float d = 0.f;
#pragma unroll 4
        for (int x = 0; x < DQ; ++x) d += bf2f(Q[x]) * bf2f(K[(size_t)k * DQ + x]);
        if (bias_col >= 0) d += ck_bias(p.in[1], (k - qp) * dil, bias_col) * LOG2E;
        const float pk = exp2f(d - m); den += pk;
#pragma unroll
        for (int dd = 0; dd < 64; ++dd) out[dd] += pk * bf2f(VT[(size_t)dd * S + (kind >= 16 ? ck_vperm(k) : k)]);
    }
    den = wave_sum(den) + (has_sink ? exp2f(sink2 - m) : 0.f);
    float mine = 0.f;
#pragma unroll
    for (int dd = 0; dd < 64; ++dd) { const float v = wave_sum(out[dd]) / den; if (lane == dd) mine = v; }
    unsigned qv = ck_quant(ck_relerr(mine, bf2f(target[lane])));
    if (lse_target) { const float lref = (m + log2f(den)) * 0.6931471805599453f; if (!(fabsf(lref - *lse_target) < 0.02f)) qv = qv < 5u ? 5u : qv; }
    if (lane == 0) atomicMax(fw + slot, qv);
    {
        const float tg = bf2f(target[lane]);
        unsigned nb = 0u;
        if (__any(!(mine == mine))) nb |= 1u;
        if (__any(!(tg == tg))) nb |= 2u;
        if (!(den > 0.f) || !(den < 1e30f)) nb |= 4u;
        if (!(m > -1e30f) || !(m < 1e30f)) nb |= 8u;
        if (lane == 0 && (slot == 1 || slot == 2)) atomicOr(fw + 4 + slot, nb);
    }
}
DEVI void phase_check_final(const Params& p) {
    const unsigned* fw = (unsigned*)(p.ws + WS_CTL) + CK_FLAG_WORD;
    unsigned fa = __hip_atomic_load(fw + 1, __ATOMIC_RELAXED, __HIP_MEMORY_SCOPE_AGENT), fb = __hip_atomic_load(fw + 2, __ATOMIC_RELAXED, __HIP_MEMORY_SCOPE_AGENT);
    const unsigned fd = __hip_atomic_load(fw + 3, __ATOMIC_RELAXED, __HIP_MEMORY_SCOPE_AGENT), fm = __hip_atomic_load(fw + 4, __ATOMIC_RELAXED, __HIP_MEMORY_SCOPE_AGENT), f0 = __hip_atomic_load(fw, __ATOMIC_RELAXED, __HIP_MEMORY_SCOPE_AGENT);
    unsigned flag = fa | (fb << 3);
    if (fd > 1u || fm > 1u || f0 != 0u) flag = 100u + (fd > 1u ? 1u : 0u) + (fm > 1u ? 2u : 0u) + (f0 ? 4u : 0u);
    if (flag > 127u) flag = 127u;
    const size_t n = (size_t)flag * 128 * DM;
    for (size_t i = (size_t)obid() * NTHREADS + otid(); i < n; i += (size_t)ogrid() * NTHREADS) p.out[i] = 0.f;
}
#endif

DEVI void route_tile(const bf16_t* PQ, const bf16_t* KEYS_, int tile, int hd, LAS unsigned char* slot, LAS int* idxl, LAS float* gatl, int r, int hi) {
    const int t = tile * 32 + r;
    int koff = r * 64 + hi * 8; asm volatile("" : "+v"(koff));
    const bf16_t* KEYS = KEYS_ + koff;
    {
        unsigned s[2][16];
#pragma unroll
        for (int c = 0; c < 2; ++c) {
            const int hc = hd * 2 + c;
            bf16x8 qf[4];
#pragma unroll
            for (int ks = 0; ks < 4; ++ks) qf[ks] = *(const bf16x8*)(PQ + (size_t)t * DM + hc * 64 + ks * 16 + hi * 8);
            unsigned g[4][16];
            bf16x8 kfa[4][4];
#pragma unroll
            for (int kb = 0; kb < 4; ++kb)
#pragma unroll
                for (int ks = 0; ks < 4; ++ks) kfa[kb][ks] = *(const bf16x8*)(KEYS + ((size_t)hc * 128 + kb * 32) * 64 + ks * 16);
            __builtin_amdgcn_sched_barrier(0);
#pragma unroll
            for (int kb = 0; kb < 4; ++kb) {
                f32x16 acc;
#pragma unroll
                for (int q = 0; q < 16; ++q) acc[q] = 0.f;
#pragma unroll
                for (int ks = 0; ks < 4; ++ks) acc = __builtin_amdgcn_mfma_f32_32x32x16_bf16(kfa[kb][ks], qf[ks], acc, 0, 0, 0);
                {
#pragma unroll
                for (int q = 0; q < 16; ++q) {
                    const unsigned low = 127u - (unsigned)(kb * 32 + (q & 3) + 8 * (q >> 2));
                    g[kb][q] = (f2ord(acc[q]) & ~127u) | low;
                }
                }
            }
            top16_of_64(g[0], g[1], g[2], g[3]);
            unsigned lo_[16], hi_[16];
#pragma unroll
            for (int i = 0; i < 16; ++i) {
                const unsigned v = g[0][i] ^ (unsigned)(hi << 2);
                auto rr = __builtin_amdgcn_permlane32_swap(v, v, false, false);
                lo_[i] = rr[0]; hi_[i] = rr[1];
            }
            merge16_desc(lo_, hi_);
#pragma unroll
            for (int i = 0; i < 16; ++i) s[c][i] = lo_[i];
        }
        float f0[16], f1[16];
#pragma unroll
        for (int i = 0; i < 16; ++i) {
            slot[i * 64] = (unsigned char)(127u - (s[0][i] & 127u));
            slot[(16 + i) * 64] = (unsigned char)(127u - (s[1][i] & 127u));
            f0[i] = ord2f(s[0][i] & ~127u); f1[i] = ord2f(s[1][i] & ~127u);
        }
        unsigned cd[4][16];
        {
#define CAND(i, j) ((f2ord(f0[i] + f1[j]) & ~255u) | (unsigned)(255 - ((i) * 16 + (j))))
            cd[0][0] = CAND(0, 0);
            cd[0][1] = CAND(0, 1);
            cd[0][2] = CAND(0, 2);
            cd[0][3] = CAND(0, 3);
            cd[0][4] = CAND(0, 4);
            cd[0][5] = CAND(0, 5);
            cd[0][6] = CAND(0, 6);
            cd[0][7] = CAND(0, 7);
            cd[0][8] = CAND(0, 8);
            cd[0][9] = CAND(0, 9);
            cd[0][10] = CAND(0, 10);
            cd[0][11] = CAND(0, 11);
            cd[0][12] = CAND(0, 12);
            cd[0][13] = CAND(0, 13);
            cd[0][14] = CAND(0, 14);
            cd[0][15] = CAND(0, 15);
            cd[1][0] = CAND(1, 0);
            cd[1][1] = CAND(1, 1);
            cd[1][2] = CAND(1, 2);
            cd[1][3] = CAND(1, 3);
            cd[1][4] = CAND(1, 4);
            cd[1][5] = CAND(1, 5);
            cd[1][6] = CAND(1, 6);
            cd[1][7] = CAND(1, 7);
            cd[1][8] = CAND(2, 0);
            cd[1][9] = CAND(2, 1);
            cd[1][10] = CAND(2, 2);
            cd[1][11] = CAND(2, 3);
            cd[1][12] = CAND(2, 4);
            cd[1][13] = CAND(3, 0);
            cd[1][14] = CAND(3, 1);
            cd[1][15] = CAND(3, 2);
            cd[2][0] = CAND(3, 3);
            cd[2][1] = CAND(4, 0);
            cd[2][2] = CAND(4, 1);
            cd[2][3] = CAND(4, 2);
            cd[2][4] = CAND(5, 0);
            cd[2][5] = CAND(5, 1);
            cd[2][6] = CAND(6, 0);
            cd[2][7] = CAND(6, 1);
            cd[2][8] = CAND(7, 0);
            cd[2][9] = CAND(7, 1);
            cd[2][10] = CAND(8, 0);
            cd[2][11] = CAND(9, 0);
            cd[2][12] = CAND(10, 0);
            cd[2][13] = CAND(11, 0);
            cd[2][14] = CAND(12, 0);
            cd[2][15] = CAND(13, 0);
            cd[3][0] = CAND(14, 0);
            cd[3][1] = CAND(15, 0);
            cd[3][2] = 0u;
            cd[3][3] = 0u;
            cd[3][4] = 0u;
            cd[3][5] = 0u;
            cd[3][6] = 0u;
            cd[3][7] = 0u;
            cd[3][8] = 0u;
            cd[3][9] = 0u;
            cd[3][10] = 0u;
            cd[3][11] = 0u;
            cd[3][12] = 0u;
            cd[3][13] = 0u;
            cd[3][14] = 0u;
            cd[3][15] = 0u;
#undef CAND
        }
        top16_of_64(cd[0], cd[1], cd[2], cd[3]);
        float val[16], e[16]; float sum = 0.f;
#pragma unroll
        for (int k = 0; k < 16; ++k) { val[k] = ord2f(cd[0][k] & ~255u); e[k] = __expf(val[k] - val[0]); sum += e[k]; }
        const float inv = 1.f / sum;
        asm volatile("s_waitcnt lgkmcnt(0)" ::: "memory");
        int id[8]; float gt[8];
#pragma unroll
        for (int k = 0; k < 8; ++k) {
            const unsigned mh = (unsigned)(-hi);
            const unsigned key = (cd[0][8 + k] & mh) | (cd[0][k] & ~mh);
            const float ek = __uint_as_float((__float_as_uint(e[8 + k]) & mh) | (__float_as_uint(e[k]) & ~mh));
            const unsigned code = 255u - (key & 255u);
            const unsigned i0 = slot[(code >> 4) * 64], i1 = slot[(16 + (code & 15)) * 64];
            id[k] = (int)(i0 * 128u + i1); gt[k] = ek * inv;
        }
        LAS int* ip = idxl + r * 128 + hd * 16 + hi * 8;
        LAS float* gp = gatl + r * 128 + hd * 16 + hi * 8;
        *(LAS u32x4*)(ip) = (u32x4){(unsigned)id[0], (unsigned)id[1], (unsigned)id[2], (unsigned)id[3]}; *(LAS u32x4*)(ip + 4) = (u32x4){(unsigned)id[4], (unsigned)id[5], (unsigned)id[6], (unsigned)id[7]};
        *(LAS f32x4*)(gp) = (f32x4){gt[0], gt[1], gt[2], gt[3]}; *(LAS f32x4*)(gp + 4) = (f32x4){gt[4], gt[5], gt[6], gt[7]};
        asm volatile("s_waitcnt lgkmcnt(0)" ::: "memory");
    }
}
DEVI void phase_peer(const Params& p, int layer, const bf16_t* hres, float* hout, const float* next_gain, lchar* lds) {
    const int tid = otid(), lane = tid & 63, wid = tid >> 6, r = lane & 31, hi = lane >> 5;
    const bf16_t* PQ = (const bf16_t*)(p.ws + WS_PQ);
    const bf16_t* KEYS = (const bf16_t*)(p.ws + WS_KEYS) + (size_t)layer * 16 * 128 * 64;
    bf16_t* HN = (bf16_t*)(p.ws + WS_HN);
    const unsigned char* PU = p.ws + WS_PU;
    const unsigned char* PV = p.ws + WS_PV;
    const float* US = (const float*)(p.ws + WS_US);
    const float* VS = (const float*)(p.ws + WS_VS);
    LAS unsigned char* slot = (LAS unsigned char*)(lds + wid * 2048) + lane;
    LAS int* idxl = (LAS int*)(lds + 16384);
    LAS float* gatl = (LAS float*)(lds + 32768);
    const unsigned m5 = (unsigned)(-((lane >> 5) & 1)), m4 = (unsigned)(-((lane >> 4) & 1)), m3 = (unsigned)(-((lane >> 3) & 1));
#if EXPERT_FP4
    constexpr int EG = 16;
    const unsigned m2 = (unsigned)(-((lane >> 2) & 1));
    const int je = 2 * (((lane >> 4) & 1) * 4 + ((lane >> 3) & 1) * 2 + ((lane >> 2) & 1)) + ((lane >> 5) & 1);
#else
    constexpr int EG = 8;
    const int je = ((lane >> 5) & 1) * 4 + ((lane >> 4) & 1) * 2 + ((lane >> 3) & 1);
#endif
    for (int tile = obid(); tile < 512; tile += ogrid()) {
        __syncthreads();
        route_tile(PQ, KEYS, tile, wid, slot, idxl, gatl, r, hi);
        __builtin_amdgcn_sched_barrier(0);
        __syncthreads();
        __builtin_amdgcn_sched_barrier(0);
#pragma unroll 1
        for (int tt = 0; tt < 4; ++tt) {
            const int row = wid * 4 + tt, t = tile * 32 + row;
#if EXPERT_FP4
            unsigned xhw[4], xlw[4]; float xs;
            {
                const bf16_t* xp = hres + (size_t)t * DM + 32 * (lane & 31);
                const u32x4 xr0 = *(const u32x4*)(xp), xr1 = *(const u32x4*)(xp + 8), xr2 = *(const u32x4*)(xp + 16), xr3 = *(const u32x4*)(xp + 24);
                const unsigned xw[16] = {xr0.x, xr0.y, xr0.z, xr0.w, xr1.x, xr1.y, xr1.z, xr1.w, xr2.x, xr2.y, xr2.z, xr2.w, xr3.x, xr3.y, xr3.z, xr3.w};
                float xv[32];
#pragma unroll
                for (int c = 0; c < 16; ++c) { xv[2 * c] = bflo(xw[c]); xv[2 * c + 1] = bfhi(xw[c]); }
                float mx = 0.f;
#pragma unroll
                for (int c = 0; c < 32; ++c) mx = fmaxf(mx, fabsf(xv[c]));
                mx = wave_max(mx);
                xs = mx * (1.f / 119.f) * ((const float*)(p.ws + WS_HN + MiB))[t];
                const float inv = mx > 0.f ? 119.f / mx : 0.f;
#pragma unroll
                for (int d = 0; d < 4; ++d) {
                    unsigned wh = 0u, wl = 0u;
#pragma unroll
                    for (int e = 0; e < 8; ++e) {
                        const int q = (int)__builtin_rintf(xv[8 * d + e] * inv);
                        const int ql = ((q + 8) & 15) - 8, qh = (q - ql) >> 4;
                        wl |= ((unsigned)ql & 15u) << (4 * e); wh |= ((unsigned)qh & 15u) << (4 * e);
                    }
                    xhw[d] = wh; xlw[d] = wl;
                }
            }
#else
            const u32x4 xa = *(const u32x4*)(HN + (size_t)t * DM + 16 * lane), xb = *(const u32x4*)(HN + (size_t)t * DM + 16 * lane + 8);
            const f32x2 x2[8] = {{bflo(xa.x), bfhi(xa.x)}, {bflo(xa.y), bfhi(xa.y)}, {bflo(xa.z), bfhi(xa.z)}, {bflo(xa.w), bfhi(xa.w)},
                                 {bflo(xb.x), bfhi(xb.x)}, {bflo(xb.y), bfhi(xb.y)}, {bflo(xb.z), bfhi(xb.z)}, {bflo(xb.w), bfhi(xb.w)}};
#endif
            const int e_lo = idxl[row * 128 + lane], e_hi = idxl[row * 128 + 64 + lane];
            const float g_lo = gatl[row * 128 + lane], g_hi = gatl[row * 128 + 64 + lane];
#if EXPERT_FP4
            f32x16 c0;
    #pragma unroll
            for (int i = 0; i < 16; ++i) c0[i] = 0.f;
            const int colj = lane & 31;
            unsigned bmask[4];
    #pragma unroll
            for (int w = 0; w < 4; ++w) bmask[w] = (((lane >> 5) == (colj >> 4)) && (w == ((colj >> 2) & 3))) ? (0xFFu << (8 * (colj & 3))) : 0u;
            const bool upper = lane >= 32;
            const unsigned rowoff = 16u * (unsigned)(lane & 31);
    #pragma unroll 1
            for (int e0 = 0; e0 < 128; e0 += 16) {
                const int esel = (e0 < 64) ? e_lo : e_hi;
                const float gsel = (e0 < 64) ? g_lo : g_hi;
                u32x4 uq[8], vq[8];
    #pragma unroll
                for (int i = 0; i < 8; ++i) {
                    const int ex0 = __builtin_amdgcn_readlane(esel, (e0 + 2 * i) & 63), ex1 = __builtin_amdgcn_readlane(esel, (e0 + 2 * i + 1) & 63);
                    const unsigned off = (unsigned)(upper ? ex1 : ex0) * 512u + rowoff;
                    uq[i] = *(const u32x4*)(PU + off);
                    vq[i] = *(const u32x4*)(PV + off);
                }
                const int my_e = bperm(esel, (e0 + je) & 63);
                const float my_g = bpermf(gsel, (e0 + je) & 63);
                const float my_us = US[my_e], my_vs = VS[my_e];
                float dt[8];
    #pragma unroll
                for (int i = 0; i < 8; ++i) {
                    int ah = 0, al = 0;
    #pragma unroll
                    for (int d = 0; d < 4; ++d) { ah = __builtin_amdgcn_sdot8((int)uq[i][d], (int)xhw[d], ah, false); al = __builtin_amdgcn_sdot8((int)uq[i][d], (int)xlw[d], al, false); }
                    dt[i] = (float)((ah << 4) + al);
                }
                float d4[4], d2[2];
    #pragma unroll
                for (int i = 0; i < 4; ++i) d4[i] = blendf(dt[i], dt[i + 4], m4) + swz_xor16(blendf(dt[i + 4], dt[i], m4));
    #pragma unroll
                for (int i = 0; i < 2; ++i) d2[i] = blendf(d4[i], d4[i + 2], m3) + dppf<0x128>(blendf(d4[i + 2], d4[i], m3));
                float d1 = blendf(d2[0], d2[1], m2) + swz_xor4(blendf(d2[1], d2[0], m2));
                d1 += dppf<0x4E>(d1); d1 += dppf<0xB1>(d1);
                const float dd = d1 * (my_us * xs);
                const float a = 0.5f * dd * (1.f + erff(dd * 0.7071067811865476f)) * my_g * my_vs;
                const int a8 = __builtin_amdgcn_cvt_pk_fp8_f32(a * 128.f, 0.f, 0, false) & 0xff;
    #pragma unroll
                for (int i = 0; i < 8; ++i) {
                    const int src0 = ((i >> 2) & 1) * 16 + ((i >> 1) & 1) * 8 + (i & 1) * 4;
                    const unsigned rep0 = (unsigned)__builtin_amdgcn_readlane(a8, src0) * 0x01010101u, rep1 = (unsigned)__builtin_amdgcn_readlane(a8, src0 + 32) * 0x01010101u;
                    i32x8 bop;
    #pragma unroll
                    for (int v = 0; v < 8; ++v) bop[v] = (int)((v < 4 ? rep0 : rep1) & bmask[v & 3]);
                    const i32x8 aop = {(int)vq[i].x, (int)vq[i].y, (int)vq[i].z, (int)vq[i].w, 0, 0, 0, 0};
                    c0 = __builtin_amdgcn_mfma_scale_f32_32x32x64_f8f6f4(aop, bop, c0, 4, 0, 0, 0, 0, 0);
                }
            }
            f32x2 acc2[8];
            {
                LAS float* strip = (LAS float*)(lds + 65536 + wid * 4096);
    #pragma unroll
                for (int rg = 0; rg < 16; ++rg) strip[32 * ((rg & 3) + 8 * (rg >> 2) + 4 * (lane >> 5)) + colj] = c0[rg];
                asm volatile("s_waitcnt lgkmcnt(0)" ::: "memory");
    #pragma unroll
                for (int i = 0; i < 4; ++i) {
                    const f32x4 v = *(const LAS f32x4*)(strip + 16 * lane + 4 * i);
                    acc2[2 * i] = (f32x2){v.x * (1.f / 128.f), v.y * (1.f / 128.f)}; acc2[2 * i + 1] = (f32x2){v.z * (1.f / 128.f), v.w * (1.f / 128.f)};
                }
                asm volatile("s_waitcnt lgkmcnt(0)" ::: "memory");
            }
#else
            f32x2 acc2[8];
    #pragma unroll
            for (int i = 0; i < 8; ++i) acc2[i] = (f32x2){0.f, 0.f};
    #pragma unroll 1
            for (int e0 = 0; e0 < 128; e0 += EG) {
                const int esel = (e0 < 64) ? e_lo : e_hi;
                const float gsel = (e0 < 64) ? g_lo : g_hi;
    #if EXPERT_FP4
                u32x2 uw[EG], vw[EG];
    #pragma unroll
                for (int j = 0; j < EG; ++j) {
                    const int ex = __builtin_amdgcn_readlane(esel, (e0 + j) & 63);
                    uw[j] = *(const u32x2*)(PU + (size_t)ex * 512 + 8 * lane);
                    vw[j] = *(const u32x2*)(PV + (size_t)ex * 512 + 8 * lane);
                }
    #define EXP_DECODE fp4x16_to_pairs
    #else
                u32x4 uw[EG], vw[EG];
    #pragma unroll
                for (int j = 0; j < EG; ++j) {
                    const int ex = __builtin_amdgcn_readlane(esel, (e0 + j) & 63);
                    uw[j] = *(const u32x4*)(PU + (size_t)ex * 1024 + 16 * lane);
                    vw[j] = *(const u32x4*)(PV + (size_t)ex * 1024 + 16 * lane);
                }
    #define EXP_DECODE fp8x16_to_pairs
    #endif
                const int my_e = bperm(esel, (e0 + je) & 63);
                const float my_g = bpermf(gsel, (e0 + je) & 63);
                const float my_us = US[my_e], my_vs = VS[my_e];
                float dt[EG];
    #pragma unroll
                for (int j = 0; j < EG; ++j) {
    #if EXPERT_FP4
                    int ah = __builtin_amdgcn_sdot8((int)uw[j].x, (int)xhw[0], 0, false); ah = __builtin_amdgcn_sdot8((int)uw[j].y, (int)xhw[1], ah, false);
                    int al = __builtin_amdgcn_sdot8((int)uw[j].x, (int)xlw[0], 0, false); al = __builtin_amdgcn_sdot8((int)uw[j].y, (int)xlw[1], al, false);
                    dt[j] = (float)((ah << 4) + al);
    #else
                    f32x2 f[8]; EXP_DECODE(uw[j], f);
                    f32x2 d2 = f[0] * x2[0];
    #pragma unroll
                    for (int i = 1; i < 8; ++i) d2 += f[i] * x2[i];
                    dt[j] = d2.x + d2.y;
    #endif
                }
                float d4[4], d2[2];
    #if EXPERT_FP4
                float d8[8];
    #pragma unroll
                for (int i = 0; i < 8; ++i) {
                    const float snd = blendf(dt[i + 8], dt[i], m5);
                    auto rr = __builtin_amdgcn_permlane32_swap(__float_as_uint(snd), __float_as_uint(snd), false, false);
                    d8[i] = blendf(dt[i], dt[i + 8], m5) + blendf(__uint_as_float(rr[1]), __uint_as_float(rr[0]), m5);
                }
    #pragma unroll
                for (int i = 0; i < 4; ++i) d4[i] = blendf(d8[i], d8[i + 4], m4) + swz_xor16(blendf(d8[i + 4], d8[i], m4));
    #pragma unroll
                for (int i = 0; i < 2; ++i) d2[i] = blendf(d4[i], d4[i + 2], m3) + dppf<0x128>(blendf(d4[i + 2], d4[i], m3));
                float d1 = blendf(d2[0], d2[1], m2) + swz_xor4(blendf(d2[1], d2[0], m2));
                d1 += dppf<0x4E>(d1); d1 += dppf<0xB1>(d1);
    #else
    #pragma unroll
                for (int i = 0; i < 4; ++i) {
                    const float snd = blendf(dt[i + 4], dt[i], m5);
                    auto rr = __builtin_amdgcn_permlane32_swap(__float_as_uint(snd), __float_as_uint(snd), false, false);
                    d4[i] = blendf(dt[i], dt[i + 4], m5) + blendf(__uint_as_float(rr[1]), __uint_as_float(rr[0]), m5);
                }
    #pragma unroll
                for (int i = 0; i < 2; ++i) d2[i] = blendf(d4[i], d4[i + 2], m4) + swz_xor16(blendf(d4[i + 2], d4[i], m4));
                float d1 = blendf(d2[0], d2[1], m3) + dppf<0x128>(blendf(d2[1], d2[0], m3));
                d1 += swz_xor4(d1); d1 += dppf<0x4E>(d1); d1 += dppf<0xB1>(d1);
    #endif
    #if EXPERT_FP4
                const float dd = d1 * (my_us * xs);
    #else
                const float dd = d1 * my_us;
    #endif
                const float a = 0.5f * dd * (1.f + erff(dd * 0.7071067811865476f)) * my_g * my_vs;
    #pragma unroll
                for (int j = 0; j < EG; ++j) {
    #if EXPERT_FP4
                    const int src = ((j >> 3) & 1) * 32 + ((j >> 2) & 1) * 16 + ((j >> 1) & 1) * 8 + (j & 1) * 4;
    #else
                    const int src = ((j >> 2) & 1) * 32 + ((j >> 1) & 1) * 16 + (j & 1) * 8;
    #endif
                    const float aj = __uint_as_float(__builtin_amdgcn_readlane(__float_as_uint(a), src));
                    f32x2 f[8]; EXP_DECODE(vw[j], f);
                    const f32x2 aj2 = {aj, aj};
    #pragma unroll
                    for (int i = 0; i < 8; ++i) acc2[i] += aj2 * f[i];
                }
            }
#endif
            float* hr = hout + (size_t)t * DM + 16 * lane;
#if ATTN_PROBE == 9
            { const float fsc = 1.f + (float)((const unsigned*)(p.ws + WS_CTL))[3996];
              _Pragma("unroll") for (int i = 0; i < 8; ++i) acc2[i] = acc2[i] * (f32x2){1.f, 1.f} + (f32x2){0.f, 0.f};
              if (layer == 1) { _Pragma("unroll") for (int i = 0; i < 8; ++i) acc2[i] = acc2[i] * (f32x2){fsc, fsc}; } }
#endif
            f32x4 hv[4]; float ss = 0.f;
            {
                const u32x4 r0 = *(const u32x4*)(hres + (size_t)t * DM + 16 * lane), r1 = *(const u32x4*)(hres + (size_t)t * DM + 16 * lane + 8);
                hv[0] = (f32x4){bflo(r0.x), bfhi(r0.x), bflo(r0.y), bfhi(r0.y)}; hv[1] = (f32x4){bflo(r0.z), bfhi(r0.z), bflo(r0.w), bfhi(r0.w)};
                hv[2] = (f32x4){bflo(r1.x), bfhi(r1.x), bflo(r1.y), bfhi(r1.y)}; hv[3] = (f32x4){bflo(r1.z), bfhi(r1.z), bflo(r1.w), bfhi(r1.w)};
            }
    #pragma unroll
            for (int j = 0; j < 4; ++j) hv[j] += (f32x4){acc2[2 * j].x, acc2[2 * j].y, acc2[2 * j + 1].x, acc2[2 * j + 1].y};
            if (next_gain) {
                bf16_t* hb = (bf16_t*)hout + (size_t)t * DM + 16 * lane;
                *(u32x4*)hb = (u32x4){pk2(hv[0].x, hv[0].y), pk2(hv[0].z, hv[0].w), pk2(hv[1].x, hv[1].y), pk2(hv[1].z, hv[1].w)};
                *(u32x4*)(hb + 8) = (u32x4){pk2(hv[2].x, hv[2].y), pk2(hv[2].z, hv[2].w), pk2(hv[3].x, hv[3].y), pk2(hv[3].z, hv[3].w)};
            } else {
    #pragma unroll
                for (int j = 0; j < 4; ++j) *(f32x4*)(hr + 4 * j) = hv[j];
            }
    #pragma unroll
            for (int j = 0; j < 4; ++j) {
                ss += (hv[j].x * hv[j].x + hv[j].y * hv[j].y) + (hv[j].z * hv[j].z + hv[j].w * hv[j].w);
            }
            if (next_gain) {
                const float rstd = rsqrtf(wave_sum(ss) * (1.f / DM) + EPS);
                u32x4 o0;
                const f32x4 g0 = *(const f32x4*)(next_gain + 16 * lane), g1 = *(const f32x4*)(next_gain + 16 * lane + 4), g2 = *(const f32x4*)(next_gain + 16 * lane + 8), g3 = *(const f32x4*)(next_gain + 16 * lane + 12);
#define P8(A, B, C, D) ({ int w_ = __builtin_amdgcn_cvt_pk_fp8_f32(A, B, 0, false); (unsigned)__builtin_amdgcn_cvt_pk_fp8_f32(C, D, w_, true); })
                o0.x = P8(hv[0].x * rstd * g0.x, hv[0].y * rstd * g0.y, hv[0].z * rstd * g0.z, hv[0].w * rstd * g0.w);
                o0.y = P8(hv[1].x * rstd * g1.x, hv[1].y * rstd * g1.y, hv[1].z * rstd * g1.z, hv[1].w * rstd * g1.w);
                o0.z = P8(hv[2].x * rstd * g2.x, hv[2].y * rstd * g2.y, hv[2].z * rstd * g2.z, hv[2].w * rstd * g2.w);
                o0.w = P8(hv[3].x * rstd * g3.x, hv[3].y * rstd * g3.y, hv[3].z * rstd * g3.z, hv[3].w * rstd * g3.w);
#undef P8
                *(u32x4*)(p.ws + WS_HN8 + (size_t)t * DM + 16 * lane) = o0;
            }
        }
    }
}
#define XB_TMO      128
#define XB_XCNT(j)  (256  + 64 * (j))
#define XB_XSUB(j)  (1280 + 64 * (j))
#define XB_XGEN(j)  (2304 + 64 * (j))
#define XB_TOP      3328
#define XB_TOPGEN   3392
#define XCD_BAR_WORDS 3456
#define XB_SPIN_CAP (1u << 18)
DEVI unsigned xb_ld(unsigned* p)              { return __hip_atomic_load(p, __ATOMIC_RELAXED, __HIP_MEMORY_SCOPE_AGENT); }
DEVI unsigned xb_add(unsigned* p, unsigned v) { return __hip_atomic_fetch_add(p, v, __ATOMIC_RELAXED, __HIP_MEMORY_SCOPE_AGENT); }
DEVI unsigned xb_xcc_id() { return (unsigned)__builtin_amdgcn_s_getreg((3 << 11) | 20) & 0xFu; }
#define XB_SPIN(cond, bar) do { unsigned _sp = 0; while (cond) { __builtin_amdgcn_s_sleep(1); \
    if ((++_sp & 255u) == 0u) { if (xb_ld(&(bar)[XB_TMO])) break; if (_sp > XB_SPIN_CAP) { atomicAdd(&(bar)[XB_TMO], 1u); break; } } } } while (0)
struct XcdBarrier { unsigned* bar; unsigned x; volatile LAS unsigned* st; };
DEVI XcdBarrier xcd_barrier_post(unsigned* bar, volatile LAS unsigned* st) {
    XcdBarrier b; b.bar = bar; b.x = xb_xcc_id(); b.st = st;
    if (otid() == 0) (void)xb_add(&bar[XB_XCNT(b.x)], 1u);
    return b;
}
DEVI void xcd_barrier_complete(unsigned* bar, unsigned x, unsigned& nloc, unsigned& nx) {
    const unsigned G = gridDim.x * gridDim.y * gridDim.z;
    unsigned sum, cnt, mine, sp = 0u;
    for (;;) {
        sum = 0u; cnt = 0u; mine = 0u;
#pragma unroll
        for (unsigned j = 0; j < 16; ++j) { const unsigned c = xb_ld(&bar[XB_XCNT(j)]); sum += c; cnt += (c > 0u) ? 1u : 0u; mine = (j == x) ? c : mine; }
        if (sum == G) break;
        __builtin_amdgcn_s_sleep(1);
        if ((++sp & 255u) == 0u) { if (xb_ld(&bar[XB_TMO])) break; if (sp > XB_SPIN_CAP) { atomicAdd(&bar[XB_TMO], 1u); break; } }
    }
    nloc = mine > 0u ? mine : 1u; nx = cnt > 0u ? cnt : 1u;
}
DEVI void xcd_barrier(const XcdBarrier& b) {
    asm volatile("s_waitcnt vmcnt(0)" ::: "memory");
    __syncthreads();
    if (otid() == 0) {
        unsigned* bar = b.bar;
        __builtin_amdgcn_s_waitcnt(0);
        unsigned nloc = b.st[0], nx = b.st[1];
        if (nloc == 0u) { xcd_barrier_complete(bar, b.x, nloc, nx); b.st[0] = nloc; b.st[1] = nx; }
        const unsigned old = xb_add(&bar[XB_XSUB(b.x)], 1u);
        const unsigned gen = old / nloc;
        if (old + 1u == (gen + 1u) * nloc) {
            __builtin_amdgcn_fence(__ATOMIC_RELEASE, "agent");
            asm volatile("s_waitcnt vmcnt(0)" ::: "memory");
            const unsigned og = xb_add(&bar[XB_TOP], 1u);
            const unsigned tg = og / nx;
            if (og + 1u == (tg + 1u) * nx) xb_add(&bar[XB_TOPGEN], 1u);
            else XB_SPIN(xb_ld(&bar[XB_TOPGEN]) == tg, bar);
            __builtin_amdgcn_fence(__ATOMIC_ACQUIRE, "agent");
            xb_add(&bar[XB_XGEN(b.x)], 1u);
            asm volatile("s_waitcnt vmcnt(0)" ::: "memory");
        } else {
            XB_SPIN(xb_ld(&bar[XB_XGEN(b.x)]) == gen, bar);
            __builtin_amdgcn_fence(__ATOMIC_ACQUIRE, "agent");
            asm volatile("s_waitcnt vmcnt(0)" ::: "memory");
        }
    }
    __syncthreads();
}
constexpr int LDS_ST_OFF = LDS_BYTES - 16;

typedef const __attribute__((address_space(4))) Params* kparams_t;
#define KP() ({ kparams_t q_ = (kparams_t)__builtin_amdgcn_kernarg_segment_ptr(); asm volatile("" : "+s"(q_)); q_; })
#define KTEST(HID, B1, B2) if (bad == 12) { int fails = 0; \
                _Pragma("unroll") for (int q = 0; q < 4; ++q) _Pragma("unroll") for (int n = 0; n < 8; ++n) { \
                    i32x8 av = {0, 0, 0, 0, 0, 0, 0, 0}, bv = {0, 0, 0, 0, 0, 0, 0, 0}; \
                    av[q] = 0x2 << (4 * n); \
                    bv[(B1) >> 2] |= 0x38 << (8 * ((B1) & 3)); if ((B2) != (B1)) bv[(B2) >> 2] |= 0x38 << (8 * ((B2) & 3)); \
                    f32x16 cz; _Pragma("unroll") for (int i = 0; i < 16; ++i) cz[i] = 0.f; \
                    cz = __builtin_amdgcn_mfma_scale_f32_32x32x64_f8f6f4(av, bv, cz, 4, 0, 0, 0, 0, 0); \
                    bool ok = true; _Pragma("unroll") for (int i = 0; i < 16; ++i) ok = ok && (cz[i] == 2.f); \
                    if (__any(!ok)) fails += 1; } \
                if (fails == 0) bad = (HID); }

#define KVAL(Q, N, BB, W) { i32x8 av = {0, 0, 0, 0, 0, 0, 0, 0}, bv = {0, 0, 0, 0, 0, 0, 0, 0}; av[Q] = 0x2 << (4 * (N)); bv[(BB) >> 2] = 0x38 << (8 * ((BB) & 3)); \
    f32x16 cz; _Pragma("unroll") for (int i = 0; i < 16; ++i) cz[i] = 0.f; \
    cz = __builtin_amdgcn_mfma_scale_f32_32x32x64_f8f6f4(av, bv, cz, 4, 0, 0, 0, 0, 0); \
    const float v0 = __builtin_amdgcn_readfirstlane(cz[0]); code += (W) * (v0 == 0.f ? 0 : (v0 == 1.f ? 1 : (v0 == 2.f ? 2 : 3))); }

template <int ONLY> __global__ void __launch_bounds__(NTHREADS) fwd_kernel(Params p_) {
#if defined(__HIP_DEVICE_COMPILE__)
    extern __shared__ __attribute__((aligned(16))) unsigned char lds_raw[];
    lchar* lds = (lchar*)lds_raw;
    const int ph_lo = p_.ph_lo, ph_hi = p_.ph_hi;
    int ph = 0;
    if ((threadIdx.x & 63) == 0) ((volatile LAS unsigned char*)(WTAB_OFF))[(unsigned)__builtin_amdgcn_s_getreg((5 << 11) | 4) & 63u] = (unsigned char)(threadIdx.x >> 6);
#if MULTI_LAUNCH
    __syncthreads();
#endif
#if MULTI_LAUNCH
#define GRIDSYNC() do { } while (0)
#else
    XcdBarrier xbar; xbar.bar = (unsigned*)(p_.ws + WS_CTL); xbar.x = 0; xbar.st = (volatile LAS unsigned*)(lds + LDS_ST_OFF);
    if (threadIdx.x < 4) ((volatile LAS unsigned*)(lds + LDS_ST_OFF))[threadIdx.x] = 0u;
    if (blockIdx.x == 0) for (int i = threadIdx.x; i < 4096; i += NTHREADS) __hip_atomic_store(xbar.bar + i, 0u, __ATOMIC_RELAXED, __HIP_MEMORY_SCOPE_AGENT);
    __syncthreads();
    bool first_seam = true;
#define GRIDSYNC() do { if (ph + 1 < ph_hi) { if (first_seam) { cg::this_grid().sync(); xbar = xcd_barrier_post((unsigned*)(p_.ws + WS_CTL), (volatile LAS unsigned*)(lds + LDS_ST_OFF)); first_seam = false; } else xcd_barrier(xbar); } } while (0)
#endif
#define PHASE(KS, ...) do { if ((ONLY < 0 || ONLY == (KS)) && ph_lo <= ph && ph < ph_hi) { for (int rep = ((KS) == REPEAT_PHASE ? 0 : 1); rep < 2; ++rep) { const Params p = *KP(); unsigned char* ws = p.ws; __VA_ARGS__; GRIDSYNC(); } } ++ph; } while (0)
#if ATTN_PROBE == 9
    PHASE(0, { phase_prep(p, lds); phase_rownorm<true>(p.in[0], p.in[2], (bf16_t*)(ws + WS_HN8));
        if (obid() == 0 && otid() < 64) {
            int bad = 12;
            {
                int code = 0;
                KVAL(2, 0, 0, 1)
                KVAL(1, 0, 0, 4)
                KVAL(0, 0, 16, 16)
                bad = 1 + code;
            }
            if (otid() == 0) ((unsigned*)(p.ws + WS_CTL))[3996] = (unsigned)bad;
        } });
#else
    PHASE(0, { phase_prep(p, lds); phase_rownorm<true>(p.in[0], p.in[2], (bf16_t*)(ws + WS_HN8)); });
#endif
#pragma unroll 1
    for (int layer = 0; layer < NLAYER; ++layer) {
        PHASE(2, { Pg8Epi8<EpiInproj8> E{EpiInproj8{(bf16_t*)(ws + WS_G), (bf16_t*)(ws + WS_P), p.in[4] + layer * GW}};
                pg8::Gemm g{(const bf16_t*)(ws + WS_HN8), (const bf16_t*)(ws + WS_WIN + (size_t)layer * INP * DM), S, INP, DM / 2};
                pg8::StaticOrder so; so.init(S, INP, ogrid(), obid());
                pg8::gemm_phase<Pg8Epi8<EpiInproj8>, pg8::StaticOrder, true, true, true>((LAS unsigned char*)lds, g, so, E); });
        PHASE(3, phase_post1(p, layer, lds));
#if SELFCHECK
        PHASE(15, phase_check1(p, layer));
#endif
        PHASE(4, { EpiBf16 e1{(bf16_t*)(ws + WS_CQRAW), 384};
                gemm_stream((const bf16_t*)(ws + WS_CQN), 256, (const bf16_t*)(ws + WS_WUQ) + (size_t)layer * 384 * 256, 256, 256, 64, 3, e1, lds);
                EpiBf16 e2{(bf16_t*)(ws + WS_CKVRAW), 512};
                gemm_stream((const bf16_t*)(ws + WS_CKVN), 128, (const bf16_t*)(ws + WS_WUKV) + (size_t)layer * 512 * 128, 128, 128, 64, 4, e2, lds); });
        PHASE(5, phase_post2(p, layer, lds));
#if SELFCHECK
        PHASE(16, phase_check2(p, layer));
#endif
        PHASE(6, phase_attention(p, layer, lds));
#if SELFCHECK
        PHASE(17, phase_check3(p, layer, 0));
#endif
        PHASE(7, phase_bmerge(p, layer));
#if SELFCHECK
        PHASE(18, phase_check3(p, layer, 1));
#endif
        PHASE(8, phase_merge((const bf16_t*)(ws + WS_Y), (const bf16_t*)(ws + WS_WBR + (size_t)layer * 4 * 1024 * 256), (const bf16_t*)(ws + WS_G), (bf16_t*)(ws + WS_MERGED), lds));
        PHASE(9, { if (layer != 0) { EpiResidualBB e{(const bf16_t*)p.out, (bf16_t*)(ws + WS_G), 1.f / WIN_SCALE, (float*)(ws + WS_HN)};
                gemm_phase<2, EpiResidualBB, true>((const bf16_t*)(ws + WS_MERGED), DM / 2, (const bf16_t*)(ws + WS_WOUT + (size_t)layer * DM * DM), DM / 2, DM / 2, 64, 4, e, lds); } else {
                EpiResidualB e{p.in[0], (bf16_t*)(ws + WS_G), 1.f / WIN_SCALE, (float*)(ws + WS_HN)};
                gemm_phase<2, EpiResidualB, true>((const bf16_t*)(ws + WS_MERGED), DM / 2, (const bf16_t*)(ws + WS_WOUT + (size_t)layer * DM * DM), DM / 2, DM / 2, 64, 4, e, lds); } });
        PHASE(11, { EpiBf16S e{(bf16_t*)(ws + WS_PQ), DM, (const float*)(ws + WS_HN), (float*)(ws + WS_HN + MiB)};
                gemm_phase<2>((const bf16_t*)(ws + WS_G), DM, (const bf16_t*)(ws + WS_WPQ) + (size_t)layer * DM * DM, DM, DM, 64, 4, e, lds); });
        PHASE(14, phase_peer(p, layer, (const bf16_t*)(ws + WS_G), rep == 0 ? (float*)(ws + WS_G + ((size_t)32 << 20)) : p.out, (layer + 1 < NLAYER && rep != 0) ? p.in[2] + (layer + 1) * DM : nullptr, lds));
    }
#if SELFCHECK
    PHASE(19, phase_check_final(p));
#endif
#undef PHASE
#undef GRIDSYNC
#endif
}

typedef void (*phase_fn)(Params);
#if MULTI_LAUNCH
static phase_fn phase_kernels[20] = {fwd_kernel<0>, fwd_kernel<1>, fwd_kernel<2>, fwd_kernel<3>, fwd_kernel<4>, fwd_kernel<5>, fwd_kernel<6>, fwd_kernel<7>,
                                     fwd_kernel<8>, fwd_kernel<9>, fwd_kernel<10>, fwd_kernel<11>, fwd_kernel<12>, fwd_kernel<13>, fwd_kernel<14>,
                                     fwd_kernel<15>, fwd_kernel<16>, fwd_kernel<17>, fwd_kernel<18>, fwd_kernel<19>};
#endif
extern "C" void kernel_launch(void* const* d_in, const int* in_sizes, int n_in, void* d_out, int out_size, void* d_ws, size_t ws_size, hipStream_t stream) {
    static int grid = 0;
    if (grid == 0) {
        if (n_in != 25 || ws_size < WS_END) { fprintf(stderr, "kernel_launch: unexpected n_in %d or ws_size %zu\n", n_in, ws_size); grid = -1; return; }
        int dev = 0, cus = 0, per_cu = 0;
        (void)hipGetDevice(&dev);
        (void)hipDeviceGetAttribute(&cus, hipDeviceAttributeMultiprocessorCount, dev);
#if MULTI_LAUNCH
        for (int k = 0; k < 20; ++k) (void)hipFuncSetAttribute((const void*)phase_kernels[k], hipFuncAttributeMaxDynamicSharedMemorySize, LDS_BYTES);
        per_cu = 1;
#else
        (void)hipFuncSetAttribute((const void*)fwd_kernel<-1>, hipFuncAttributeMaxDynamicSharedMemorySize, LDS_BYTES);
        (void)hipOccupancyMaxActiveBlocksPerMultiprocessor(&per_cu, (const void*)fwd_kernel<-1>, NTHREADS, LDS_BYTES);
#endif
        if (per_cu < 1) per_cu = 1;
        grid = cus * 1;
        (void)hipGetLastError();
    }
    if (grid < 0) return;
    Params p{};
    for (int i = 0; i < 25; ++i) p.in[i] = (const float*)d_in[i];
    p.out = (float*)d_out; p.ws = (unsigned char*)d_ws;
#if MULTI_LAUNCH
    for (int ph = 0; ph < N_PHASES; ++ph) {
        p.ph_lo = ph; p.ph_hi = ph + 1;
#if SELFCHECK
        static const int ks_layer[15] = {2, 3, 15, 4, 5, 16, 6, 17, 7, 18, 8, 9, 10, 11, 14};
        const int ks = (ph == 0) ? 0 : (ph == N_PHASES - 1 ? 19 : ks_layer[(ph - 1) % PH_PER_LAYER]);
#else
        static const int ks_layer[11] = {2, 3, 4, 5, 6, 7, 8, 9, 10, 11, 14};
        const int ks = (ph == 0) ? 0 : ks_layer[(ph - 1) % PH_PER_LAYER];
#endif
        void* args[] = {&p};
        (void)hipLaunchKernel((const void*)phase_kernels[ks], dim3(grid), dim3(NTHREADS), args, LDS_BYTES, stream);
    }
#else
    p.ph_lo = 0; p.ph_hi = N_PHASES;
    void* args[] = {&p};
    hipError_t e = hipLaunchCooperativeKernel((const void*)fwd_kernel<-1>, dim3(grid), dim3(NTHREADS), args, LDS_BYTES, stream);
    if (e != hipSuccess) fprintf(stderr, "cooperative launch failed: %s (grid %d)\n", hipGetErrorString(e), grid);
#endif
}
```
